# Optimizing an MI355X kernel written in HIP

```python
import jax, jax.numpy as jnp
from jax import lax
import numpy as np

D_MODEL = 1024
BATCH = 4
SEQ = 8192
DEPTH = 4

N_CONV_LAYERS = DEPTH // 2
N_ATTN_LAYERS = DEPTH - N_CONV_LAYERS
CONV_WIDTH = 3
N_HEADS = 16
HEAD_DIM = D_MODEL // N_HEADS
Q_BLOCK = 128
N_EXPERTS = 32
TOP_K = 4
D_EXPERT = D_MODEL
SWIGLU_LIMIT = 7.0
SWIGLU_ALPHA = 1.702
EXPERT_BLOCK = 128
DEEPNORM_ALPHA = (2.0 * DEPTH) ** 0.25
DEEPNORM_BETA = (8.0 * DEPTH) ** -0.25
LN_EPS = 1e-5
ADA_SCALE = 0.1
FORGET_BIAS_INIT = 3.0

kernel_name = "yoco_shortconv_fox_moe_deepnorm"


def layer_norm(x, g, b):
    xf = x.astype(jnp.float32)
    mu = jnp.mean(xf, axis=-1, keepdims=True)
    var = jnp.mean(jnp.square(xf - mu), axis=-1, keepdims=True)
    y = (xf - mu) * lax.rsqrt(var + LN_EPS) * g.astype(jnp.float32) + b.astype(jnp.float32)
    return y.astype(x.dtype)


def ada_params(cond, w, b):
    return jnp.split(cond @ w + b, 3, axis=-1)


def modulate(x, shift, scale):
    return x * (1 + scale[:, None, :]) + shift[:, None, :]


def deepnorm_residual(x, sub, gate, g, b):
    return layer_norm(DEEPNORM_ALPHA * x + (1 + gate[:, None, :]) * sub, g, b)


def short_conv_mixer(h, w_in, w_conv, w_out):
    gate_c, gate_b, u = jnp.split(h @ w_in, 3, axis=-1)
    z = gate_c * u
    z = lax.conv_general_dilated(
        z, w_conv[:, None, :].astype(z.dtype), window_strides=(1,),
        padding=[(CONV_WIDTH - 1, 0)], dimension_numbers=("NWC", "WIO", "NWC"),
        feature_group_count=D_MODEL)
    return (gate_b * z) @ w_out


def shared_kv(x, cond, kv_ada_w, kv_ada_b, w_kvf, b_f):
    bsz, seq, _ = x.shape
    shift, scale = jnp.split(cond @ kv_ada_w + kv_ada_b, 2, axis=-1)
    kvf = modulate(x, shift, scale) @ w_kvf
    k = kvf[..., :D_MODEL].reshape(bsz, seq, N_HEADS, HEAD_DIM).transpose(0, 2, 1, 3)
    v = kvf[..., D_MODEL:2 * D_MODEL].reshape(bsz, seq, N_HEADS, HEAD_DIM).transpose(0, 2, 1, 3)
    log_f = jax.nn.log_sigmoid(kvf[..., 2 * D_MODEL:].astype(jnp.float32) + b_f.astype(jnp.float32))
    log_f_cum = jnp.cumsum(log_f, axis=1).transpose(0, 2, 1)
    return k, v, log_f_cum


def forgetting_attention(h, w_q, w_o, k, v, log_f_cum):
    bsz, seq, _ = h.shape
    nb = seq // Q_BLOCK
    q = (h @ w_q).reshape(bsz, nb, Q_BLOCK, N_HEADS, HEAD_DIM).transpose(1, 0, 3, 2, 4)
    dq = log_f_cum.reshape(bsz, N_HEADS, nb, Q_BLOCK).transpose(2, 0, 1, 3)
    k_pos = jnp.arange(seq)
    scale = HEAD_DIM ** -0.5

    def block(args):
        qb, dqb, i = args
        q_pos = i * Q_BLOCK + jnp.arange(Q_BLOCK)
        s = jnp.einsum('bhqd,bhkd->bhqk', qb, k, preferred_element_type=jnp.float32) * scale
        s = s + (dqb[..., :, None] - log_f_cum[..., None, :])
        s = jnp.where(q_pos[:, None] >= k_pos[None, :], s, -jnp.inf)
        p = jax.nn.softmax(s, axis=-1)
        return jnp.einsum('bhqk,bhkd->bhqd', p.astype(v.dtype), v)

    o = lax.map(block, (q, dq, jnp.arange(nb)))
    o = o.transpose(1, 0, 3, 2, 4).reshape(bsz, seq, D_MODEL)
    return o @ w_o


def routed_moe(h, w_r, b_r, w_gu, b_gu, w_down, b_down):
    n_tok = h.shape[0]
    n_assign = n_tok * TOP_K
    logits = jnp.dot(h, w_r, preferred_element_type=jnp.float32) + b_r.astype(jnp.float32)
    top_val, top_idx = lax.top_k(logits, TOP_K)
    top_w = jax.nn.softmax(top_val, axis=-1)
    flat_e = top_idx.reshape(-1)
    flat_tok = jnp.arange(n_assign, dtype=jnp.int32) // TOP_K
    order = jnp.argsort(flat_e, stable=True)
    sorted_e = flat_e[order]
    counts = jnp.bincount(flat_e, length=N_EXPERTS)
    padded = (counts + EXPERT_BLOCK - 1) // EXPERT_BLOCK * EXPERT_BLOCK
    padded_end = jnp.cumsum(padded)
    padded_start = padded_end - padded
    group_start = jnp.cumsum(counts) - counts
    dest = padded_start[sorted_e] + jnp.arange(n_assign, dtype=jnp.int32) - group_start[sorted_e]
    n_blocks = -(-n_assign // EXPERT_BLOCK) + N_EXPERTS
    n_slots = n_blocks * EXPERT_BLOCK
    slot_tok = jnp.full((n_slots,), n_tok, jnp.int32).at[dest].set(flat_tok[order])
    slot_w = jnp.zeros((n_slots,), jnp.float32).at[dest].set(top_w.reshape(-1)[order])
    block_expert = jnp.minimum(
        jnp.searchsorted(padded_end, jnp.arange(n_blocks) * EXPERT_BLOCK, side='right'), N_EXPERTS - 1)
    h_pad = jnp.concatenate([h, jnp.zeros((1, h.shape[1]), h.dtype)], axis=0)

    def expert_block(args):
        tok, e, wt = args
        gu = h_pad[tok] @ w_gu[e] + b_gu[e]
        g = jnp.minimum(gu[:, :D_EXPERT], SWIGLU_LIMIT)
        u = jnp.clip(gu[:, D_EXPERT:], -SWIGLU_LIMIT, SWIGLU_LIMIT)
        a = g * jax.nn.sigmoid(SWIGLU_ALPHA * g) * (u + 1)
        y = a @ w_down[e] + b_down[e]
        return y * wt[:, None].astype(y.dtype)

    y = lax.map(expert_block, (slot_tok.reshape(n_blocks, EXPERT_BLOCK), block_expert,
                               slot_w.reshape(n_blocks, EXPERT_BLOCK)))
    return jax.ops.segment_sum(y.reshape(n_slots, -1), slot_tok, num_segments=n_tok + 1)[:n_tok]


def setup_inputs(seed: int = 0) -> dict:
    key = jax.random.key(seed)
    ks = jax.random.split(key, 24)
    D, H, E, F = D_MODEL, N_HEADS, N_EXPERTS, D_EXPERT
    nrm = lambda k, shape, s: jax.random.normal(k, shape, jnp.float32) * s
    w_kvf = jnp.concatenate([
        nrm(ks[6], (D, D), D ** -0.5),
        nrm(ks[7], (D, D), D ** -0.5 * DEEPNORM_BETA),
        nrm(ks[8], (D, H), D ** -0.5)], axis=1)
    return {
        "x": nrm(ks[0], (BATCH, SEQ, D), 1.0),
        "c": nrm(ks[1], (BATCH, D), 1.0),
        "conv_w_in": nrm(ks[2], (N_CONV_LAYERS, D, 3 * D), D ** -0.5),
        "conv_w": nrm(ks[3], (N_CONV_LAYERS, CONV_WIDTH, D), CONV_WIDTH ** -0.5),
        "conv_w_out": nrm(ks[4], (N_CONV_LAYERS, D, D), D ** -0.5 * DEEPNORM_BETA),
        "kv_ada_w": nrm(ks[5], (D, 2 * D), ADA_SCALE * D ** -0.5),
        "kv_ada_b": nrm(ks[9], (2 * D,), 0.01),
        "w_kvf": w_kvf,
        "b_f": FORGET_BIAS_INIT + nrm(ks[10], (H,), 0.1),
        "attn_w_q": nrm(ks[11], (N_ATTN_LAYERS, D, D), D ** -0.5),
        "attn_w_o": nrm(ks[12], (N_ATTN_LAYERS, D, D), D ** -0.5 * DEEPNORM_BETA),
        "ada_w": nrm(ks[13], (DEPTH, 2, D, 3 * D), ADA_SCALE * D ** -0.5),
        "ada_b": nrm(ks[14], (DEPTH, 2, 3 * D), 0.01),
        "ln_g": 1.0 + nrm(ks[15], (DEPTH, 2, D), 0.02),
        "ln_b": nrm(ks[16], (DEPTH, 2, D), 0.02),
        "router_w": nrm(ks[17], (DEPTH, D, E), D ** -0.5),
        "router_b": nrm(ks[18], (DEPTH, E), 0.01),
        "exp_w_gu": nrm(ks[19], (DEPTH, E, D, 2 * F), D ** -0.5),
        "exp_b_gu": nrm(ks[20], (DEPTH, E, 2 * F), 0.01),
        "exp_w_down": nrm(ks[21], (DEPTH, E, F, D), F ** -0.5 * DEEPNORM_BETA),
        "exp_b_down": nrm(ks[22], (DEPTH, E, D), 0.01),
    }


def reference(x, c, conv_w_in, conv_w, conv_w_out, kv_ada_w, kv_ada_b, w_kvf, b_f,
              attn_w_q, attn_w_o, ada_w, ada_b, ln_g, ln_b, router_w, router_b,
              exp_w_gu, exp_b_gu, exp_w_down, exp_b_down):
    cond = jax.nn.silu(c)
    k = v = log_f_cum = None
    for l in range(DEPTH):
        shift, scale, gate = ada_params(cond, ada_w[l, 0], ada_b[l, 0])
        h = modulate(x, shift, scale)
        if l < N_CONV_LAYERS:
            sub = short_conv_mixer(h, conv_w_in[l], conv_w[l], conv_w_out[l])
        else:
            j = l - N_CONV_LAYERS
            sub = forgetting_attention(h, attn_w_q[j], attn_w_o[j], k, v, log_f_cum)
        x = deepnorm_residual(x, sub, gate, ln_g[l, 0], ln_b[l, 0])
        shift, scale, gate = ada_params(cond, ada_w[l, 1], ada_b[l, 1])
        h = modulate(x, shift, scale)
        sub = routed_moe(h.reshape(-1, D_MODEL), router_w[l], router_b[l], exp_w_gu[l],
                         exp_b_gu[l], exp_w_down[l], exp_b_down[l]).reshape(x.shape)
        x = deepnorm_residual(x, sub, gate, ln_g[l, 1], ln_b[l, 1])
        if l == N_CONV_LAYERS - 1:
            k, v, log_f_cum = shared_kv(x, cond, kv_ada_w, kv_ada_b, w_kvf, b_f)
    return x
```

```cpp
#include <hip/hip_runtime.h>
#include <cstdio>
#include <cstdint>
namespace pg8 {
#define PG8_LAS __attribute__((address_space(3)))
typedef unsigned short bf16_t;
typedef short bf16x8 __attribute__((ext_vector_type(8)));
typedef float f32x4 __attribute__((ext_vector_type(4)));
typedef unsigned u32x4 __attribute__((ext_vector_type(4)));
constexpr int BM = 256, BK = 64, HALF = 128, HTB = HALF * BK * 2  , STAGE_BYTES = 8 * HTB, NXCD = 8, WGM = 8;

__host__ __device__ __forceinline__ int lds_byte(int r, int c) { const int st = (r >> 4) * 2 + (c >> 5), rr = r & 15, cc = c & 31, ob = rr * 64 + cc * 2; return st * 1024 + (ob ^ (((ob >> 9) & 1) << 5)); }
__host__ __device__ __forceinline__ void stage_rc(int b, int& R, int& C) { const int st = b / 1024, sb = b % 1024, swz = sb ^ (((sb >> 9) & 1) << 5); R = (st >> 1) * 16 + swz / 64; C = (st & 1) * 32 + (swz % 64) / 2; }
__host__ __device__ __forceinline__ int perm32(int rho) { const int n = rho >> 4, i = rho & 15; return 8 * (i >> 2) + 4 * n + (i & 3); }

struct Unit { int pm, pn, e; };
struct Gemm { const bf16_t* A; const bf16_t* Bt; int M, N, K; size_t bstride; const int* rowidx; };

struct StaticOrder {
    int nM, nN, nwg, G, c;
    __host__ __device__ void init(int M, int N, int G_, int c_) { nM = M / BM; nN = N / BM; nwg = nM * nN; G = G_; c = c_; }
    __host__ __device__ bool next(int i, Unit& u) const {
        const long L = (long)i * G + c; if (L >= nwg) return false;
        int wgid = (int)L; { const int q = nwg / NXCD, r = nwg % NXCD, xcd = wgid % NXCD, off = wgid / NXCD; wgid = (xcd < r ? xcd * (q + 1) : r * (q + 1) + (xcd - r) * q) + off; }
        const int nig = WGM * nN, gid = wgid / nig, fm = gid * WGM, gsz = (nM - fm) < WGM ? (nM - fm) : WGM;
        u.pm = fm + ((wgid % nig) % gsz); u.pn = (wgid % nig) / gsz; u.e = 0; return true;
    }
};
struct MoeOrder {
    int u0, u1, sh; const PG8_LAS int* tile_e;
    __device__ __forceinline__ bool next(int i, Unit& u) const { const int x = u0 + i; if (x >= u1) return false; u.pm = x >> sh; u.pn = x & ((1 << sh) - 1); u.e = tile_e[u.pm]; return true; }
};

__device__ __forceinline__ unsigned cvt_pk_bf16(float lo, float hi) { unsigned r; asm volatile("v_cvt_pk_bf16_f32 %0, %1, %2" : "=v"(r) : "v"(lo), "v"(hi)); return r; }

struct EpiBf16 {
    static constexpr bool PERM = true;
    bf16_t* O; int ldc; const float* bias; int bias_estride; int split_cols; size_t split_stride; float scale0;
    __device__ __forceinline__ void operator()(const f32x4 (&acc)[2][2][4][2], const Unit& u, int wr, int wc, int fr, int fq) const {
        const int row0 = u.pm * BM + wr * 64 + fr; int colt = u.pn * BM; bf16_t* base = O;
        float sc = 1.f; if (split_cols) { const int t = colt / split_cols; base += (size_t)t * split_stride; colt -= t * split_cols; if (t == 0) sc = scale0; }
        const int col0 = colt + wc * 32 + 8 * fq, bcol0 = u.pn * BM + wc * 32 + 8 * fq;
        const float* bp = bias ? bias + (size_t)u.e * bias_estride : nullptr;
        f32x4 bv[2][2];
#pragma unroll
        for (int bj = 0; bj < 2; ++bj)
#pragma unroll
            for (int n = 0; n < 2; ++n) bv[bj][n] = bp ? *(const f32x4*)(bp + bcol0 + bj * HALF + 4 * n) : (f32x4){0.f, 0.f, 0.f, 0.f};
#pragma unroll
        for (int ai = 0; ai < 2; ++ai)
#pragma unroll
            for (int m = 0; m < 4; ++m) { bf16_t* rowp = base + (size_t)(row0 + ai * HALF + m * 16) * ldc + col0;
#pragma unroll
                for (int bj = 0; bj < 2; ++bj) { f32x4 v0 = acc[ai][bj][m][0] + bv[bj][0], v1 = acc[ai][bj][m][1] + bv[bj][1];
                    v0 = v0 * sc; v1 = v1 * sc; u32x4 w; w.x = cvt_pk_bf16(v0[0], v0[1]); w.y = cvt_pk_bf16(v0[2], v0[3]); w.z = cvt_pk_bf16(v1[0], v1[1]); w.w = cvt_pk_bf16(v1[2], v1[3]);
                    *(u32x4*)(rowp + bj * HALF) = w; } }
    }
};
struct EpiConvIn {
    static constexpr bool PERM = true;
    bf16_t* Z; bf16_t* GB;
    __device__ __forceinline__ void operator()(const f32x4 (&acc)[2][2][4][2], const Unit& u, int wr, int wc, int fr, int fq) const {
        const int row0 = u.pm * BM + wr * 64 + fr;
        if (u.pn < 8) {
            const int col0 = u.pn * HALF + wc * 32 + 8 * fq;
#pragma unroll
            for (int ai = 0; ai < 2; ++ai)
#pragma unroll
                for (int m = 0; m < 4; ++m) { bf16_t* rowp = Z + (size_t)(row0 + ai * HALF + m * 16) * 1024 + col0;
                    const f32x4 v0 = acc[ai][0][m][0] * acc[ai][1][m][0], v1 = acc[ai][0][m][1] * acc[ai][1][m][1];
                    u32x4 w; w.x = cvt_pk_bf16(v0[0], v0[1]); w.y = cvt_pk_bf16(v0[2], v0[3]); w.z = cvt_pk_bf16(v1[0], v1[1]); w.w = cvt_pk_bf16(v1[2], v1[3]);
                    *(u32x4*)rowp = w; }
        } else {
            const int col0 = (u.pn - 8) * BM + wc * 32 + 8 * fq;
#pragma unroll
            for (int ai = 0; ai < 2; ++ai)
#pragma unroll
                for (int m = 0; m < 4; ++m) { bf16_t* rowp = GB + (size_t)(row0 + ai * HALF + m * 16) * 1024 + col0;
#pragma unroll
                    for (int bj = 0; bj < 2; ++bj) { const f32x4 v0 = acc[ai][bj][m][0], v1 = acc[ai][bj][m][1];
                        u32x4 w; w.x = cvt_pk_bf16(v0[0], v0[1]); w.y = cvt_pk_bf16(v0[2], v0[3]); w.z = cvt_pk_bf16(v1[0], v1[1]); w.w = cvt_pk_bf16(v1[2], v1[3]);
                        *(u32x4*)(rowp + bj * HALF) = w; } }
        }
    }
};
struct EpiSwiGLU {
    static constexpr bool PERM = true;
    bf16_t* O; const float* bgu;
    __device__ __forceinline__ void operator()(const f32x4 (&acc)[2][2][4][2], const Unit& u, int wr, int wc, int fr, int fq) const {
        const int row0 = u.pm * BM + wr * 64 + fr, col0 = u.pn * HALF + wc * 32 + 8 * fq;
        const float* bp = bgu + (size_t)u.e * 2048 + col0;
        f32x4 bg[2], bu[2];
#pragma unroll
        for (int n = 0; n < 2; ++n) { bg[n] = *(const f32x4*)(bp + 4 * n); bu[n] = *(const f32x4*)(bp + 1024 + 4 * n); }
#pragma unroll
        for (int ai = 0; ai < 2; ++ai)
#pragma unroll
            for (int m = 0; m < 4; ++m) { bf16_t* rowp = O + (size_t)(row0 + ai * HALF + m * 16) * 1024 + col0;
                f32x4 r[2];
#pragma unroll
                for (int n = 0; n < 2; ++n) { const f32x4 gv = acc[ai][0][m][n] + bg[n], uv = acc[ai][1][m][n] + bu[n];
#pragma unroll
                    for (int j = 0; j < 4; ++j) { const float g = __builtin_fminf(gv[j], 7.0f), uu = __builtin_fminf(__builtin_fmaxf(uv[j], -7.0f), 7.0f);
                        const float ex = __builtin_amdgcn_exp2f(g * (-1.702f * 1.4426950408889634f)); r[n][j] = g * (uu + 1.0f) * __builtin_amdgcn_rcpf(1.0f + ex); } }
                u32x4 w; w.x = cvt_pk_bf16(r[0][0], r[0][1]); w.y = cvt_pk_bf16(r[0][2], r[0][3]); w.z = cvt_pk_bf16(r[1][0], r[1][1]); w.w = cvt_pk_bf16(r[1][2], r[1][3]);
                *(u32x4*)rowp = w; }
    }
};

__device__ __forceinline__ void load4_sync(const int* p0, const int* p1, const int* p2, const int* p3, int& a, int& b, int& c, int& d) {
    asm volatile("global_load_dword %0, %4, off\n\tglobal_load_dword %1, %5, off\n\tglobal_load_dword %2, %6, off\n\tglobal_load_dword %3, %7, off\n\ts_waitcnt vmcnt(0)"
                 : "=&v"(a), "=&v"(b), "=&v"(c), "=&v"(d) : "v"(p0), "v"(p1), "v"(p2), "v"(p3) : "memory");
}

template <class Epi, class Sched, bool ALIGN_EPI, bool GATHER>
__device__ __forceinline__ void gemm_phase(PG8_LAS unsigned char* lds, const Gemm g, const Sched& S, const Epi& E, const int wid_in) {
    int lane_ = (int)__builtin_amdgcn_mbcnt_hi(~0u, __builtin_amdgcn_mbcnt_lo(~0u, 0u)); asm volatile("" : "+v"(lane_));
    const int wid = __builtin_amdgcn_readfirstlane(wid_in), lane = lane_, tid = wid * 64 + lane, wr = wid >> 2, wc = wid & 3, fr = lane & 15, fq = lane >> 4;
    const int K = g.K, nt = K / BK;
    unsigned voffA[2], voffB[2];
#pragma unroll
    for (int i = 0; i < 2; ++i) { int R, C; stage_rc(tid * 16 + i * 8192, R, C); const int Rb = Epi::PERM ? ((R & ~31) + perm32(R & 31)) : R;
        voffA[i] = (unsigned)(R * K + C) * 2u; voffB[i] = (unsigned)(Rb * K + C) * 2u; }
    const size_t kstep = (size_t)(BK * 2);
    const size_t hstep = (size_t)HALF * K * 2;
    const size_t tstep = 2 * hstep;
    const unsigned ldsw = (unsigned)wid * 1024u;
    const int aoff = lds_byte(wr * 64 + fr, fq * 8), boff = lds_byte(wc * 32 + fr, fq * 8);
#define PG8_SA(b, h) (((b) * 2 + (h)) * HTB)
#define PG8_SB(b, h) ((4 + (b) * 2 + (h)) * HTB)
#define PG8_STAGE(bufoff, gbase, voff) do { _Pragma("unroll") for (int _i = 0; _i < 2; ++_i) \
        __builtin_amdgcn_global_load_lds((const unsigned*)((const char*)(gbase) + (voff)[_i]), (PG8_LAS unsigned*)(lds + (bufoff) + ldsw + _i * 8192), 16, 0, 0); } while (0)
#define PG8_STAGE_A(bufoff, base, h, nx) do { if constexpr (GATHER) { unsigned _v[2]; _v[0] = (nx) ? gAn[h][0] : gA[h][0]; _v[1] = (nx) ? gAn[h][1] : gA[h][1]; PG8_STAGE(bufoff, base, _v); } \
        else { PG8_STAGE(bufoff, (base) + (h) * hstep, voffA); } } while (0)
#define PG8_LDA(dst, b, h) do { _Pragma("unroll") for (int m = 0; m < 4; ++m) _Pragma("unroll") for (int k = 0; k < 2; ++k) dst[m][k] = *(const PG8_LAS bf16x8*)(lds + PG8_SA(b, h) + aoff + m * 2048 + k * 1024); } while (0)
#define PG8_LDB(dst, b, h) do { _Pragma("unroll") for (int n = 0; n < 2; ++n) _Pragma("unroll") for (int k = 0; k < 2; ++k) dst[n][k] = *(const PG8_LAS bf16x8*)(lds + PG8_SB(b, h) + boff + n * 2048 + k * 1024); } while (0)
#define PG8_MMA(ai, bj, At, Bt) do { __builtin_amdgcn_s_setprio(1); _Pragma("unroll") for (int m = 0; m < 4; ++m) _Pragma("unroll") for (int n = 0; n < 2; ++n) _Pragma("unroll") for (int k = 0; k < 2; ++k) \
        acc[ai][bj][m][n] = __builtin_amdgcn_mfma_f32_16x16x32_bf16(Bt[n][k], At[m][k], acc[ai][bj][m][n], 0, 0, 0); __builtin_amdgcn_s_setprio(0); } while (0)
#define PG8_WAIT_V(n) asm volatile("s_waitcnt vmcnt(" #n ")" ::: "memory")
#define PG8_WAIT_L(n) asm volatile("s_waitcnt lgkmcnt(" #n ")" ::: "memory")
#define PG8_BAR __builtin_amdgcn_s_barrier()
#define PG8_SCHED __builtin_amdgcn_sched_barrier(0)
    Unit cur, nxt; int ui = 0;
    if (!S.next(0, cur)) return;
#define PG8_UNI(u_) do { u_.pm = __builtin_amdgcn_readfirstlane(u_.pm); u_.pn = __builtin_amdgcn_readfirstlane(u_.pn); u_.e = __builtin_amdgcn_readfirstlane(u_.e); } while (0)
    PG8_UNI(cur);
    unsigned gA[2][2], gAn[2][2];
#define PG8_GLOAD(dst, pm_) do { const int* _ri = g.rowidx + (size_t)(pm_) * BM; int _t0, _t1, _t2, _t3, _R0, _C0, _R1, _C1; const int _tid = wid * 64 + (int)__builtin_amdgcn_mbcnt_hi(~0u, __builtin_amdgcn_mbcnt_lo(~0u, 0u)); stage_rc(_tid * 16, _R0, _C0); stage_rc(_tid * 16 + 8192, _R1, _C1); \
        load4_sync(_ri + _R0, _ri + _R1, _ri + HALF + _R0, _ri + HALF + _R1, _t0, _t1, _t2, _t3); \
        dst[0][0] = (unsigned)_t0 * (unsigned)(K * 2) + (unsigned)_C0 * 2u; dst[0][1] = (unsigned)_t1 * (unsigned)(K * 2) + (unsigned)_C1 * 2u; \
        dst[1][0] = (unsigned)_t2 * (unsigned)(K * 2) + (unsigned)_C0 * 2u; dst[1][1] = (unsigned)_t3 * (unsigned)(K * 2) + (unsigned)_C1 * 2u; } while (0)
    if constexpr (GATHER) { PG8_GLOAD(gA, cur.pm); gAn[0][0] = gA[0][0]; gAn[0][1] = gA[0][1]; gAn[1][0] = gA[1][0]; gAn[1][1] = gA[1][1]; }
    else { gA[0][0] = gA[0][1] = gA[1][0] = gA[1][1] = 0u; gAn[0][0] = gAn[0][1] = gAn[1][0] = gAn[1][1] = 0u; }
    f32x4 acc[2][2][4][2];
#pragma unroll
    for (int a = 0; a < 2; ++a)
#pragma unroll
        for (int b = 0; b < 2; ++b)
#pragma unroll
            for (int m = 0; m < 4; ++m)
#pragma unroll
                for (int n = 0; n < 2; ++n) acc[a][b][m][n] = (f32x4){0.f, 0.f, 0.f, 0.f};
    bf16x8 At[4][2], B0[2][2], B1[2][2];
    const char* cA = GATHER ? (const char*)g.A : (const char*)g.A + (size_t)cur.pm * tstep;
    const char* cB = (const char*)g.Bt + (size_t)cur.e * g.bstride + (size_t)cur.pn * tstep;
    PG8_STAGE(PG8_SB(0, 0), cB, voffB); PG8_STAGE(PG8_SB(0, 1), cB + hstep, voffB); PG8_STAGE_A(PG8_SA(0, 0), cA, 0, false); PG8_STAGE_A(PG8_SA(0, 1), cA, 1, false);
    if (wr == 1) PG8_BAR;
    PG8_WAIT_V(2); PG8_BAR;
    PG8_STAGE(PG8_SB(1, 0), cB + kstep, voffB); PG8_STAGE_A(PG8_SA(1, 0), cA + kstep, 0, false); PG8_STAGE(PG8_SB(1, 1), cB + hstep + kstep, voffB);
    PG8_WAIT_V(6); PG8_BAR;
    for (;;) {
        const bool has_next = S.next(ui + 1, nxt); PG8_UNI(nxt);
        if constexpr (GATHER) { if (has_next && nxt.pm != cur.pm) { PG8_GLOAD(gAn, nxt.pm); } }
        const char* nA = (has_next && !GATHER) ? (const char*)g.A + (size_t)nxt.pm * tstep : cA;
        const char* nB = has_next ? (const char*)g.Bt + (size_t)nxt.e * g.bstride + (size_t)nxt.pn * tstep : cB;
        for (int t = 0; t < nt; t += 2) {
            const bool last = (t == nt - 2);
            const bool nx = last && has_next;
            const char* a1 = cA + (size_t)(t + 1) * kstep;
            const char* a2 = last ? nA : cA + (size_t)(t + 2) * kstep; const char* b2 = last ? nB : cB + (size_t)(t + 2) * kstep;
            const char* a3 = a2 + kstep; const char* b3 = b2 + kstep;
            PG8_LDB(B0, 0, 0); PG8_LDB(B1, 0, 1); PG8_SCHED; PG8_LDA(At, 0, 0); PG8_STAGE_A(PG8_SA(1, 1), a1, 1, false);
            PG8_WAIT_V(8); PG8_WAIT_L(0); PG8_BAR; PG8_MMA(0, 0, At, B0); PG8_MMA(0, 1, At, B1); PG8_BAR; PG8_SCHED;
            PG8_LDA(At, 0, 1); PG8_STAGE(PG8_SB(0, 0), b2, voffB); PG8_STAGE(PG8_SB(0, 1), b2 + hstep, voffB); PG8_STAGE_A(PG8_SA(0, 0), a2, 0, nx);
            PG8_WAIT_V(8); PG8_WAIT_L(0); PG8_BAR; PG8_MMA(1, 0, At, B0); PG8_MMA(1, 1, At, B1); PG8_BAR; PG8_SCHED;
            PG8_LDB(B0, 1, 0); PG8_LDB(B1, 1, 1); PG8_SCHED; PG8_LDA(At, 1, 0); PG8_STAGE_A(PG8_SA(0, 1), a2, 1, nx);
            PG8_WAIT_V(8); PG8_WAIT_L(0); PG8_BAR; PG8_MMA(0, 0, At, B0); PG8_MMA(0, 1, At, B1); PG8_BAR; PG8_SCHED;
            PG8_LDA(At, 1, 1); PG8_STAGE(PG8_SB(1, 0), b3, voffB); PG8_STAGE(PG8_SB(1, 1), b3 + hstep, voffB); PG8_STAGE_A(PG8_SA(1, 0), a3, 0, nx);
            PG8_WAIT_V(8); PG8_WAIT_L(0); PG8_BAR; PG8_MMA(1, 0, At, B0); PG8_MMA(1, 1, At, B1); PG8_BAR; PG8_SCHED;
        }
        if constexpr (ALIGN_EPI) { if (wr == 0) PG8_BAR; }
        E(acc, cur, wr, wc, fr, fq);
        if (!has_next) break;
#pragma unroll
        for (int a = 0; a < 2; ++a)
#pragma unroll
            for (int b = 0; b < 2; ++b)
#pragma unroll
                for (int m = 0; m < 4; ++m)
#pragma unroll
                    for (int n = 0; n < 2; ++n) acc[a][b][m][n] = (f32x4){0.f, 0.f, 0.f, 0.f};
        cur = nxt; cA = nA; cB = nB; ++ui;
        if constexpr (GATHER) { gA[0][0] = gAn[0][0]; gA[0][1] = gAn[0][1]; gA[1][0] = gAn[1][0]; gA[1][1] = gAn[1][1]; }
        if constexpr (ALIGN_EPI) { if (wr == 1) PG8_BAR; }
    }
    PG8_WAIT_V(0);
    if constexpr (!ALIGN_EPI) { if (wr == 0) PG8_BAR; }
    PG8_BAR;
#undef PG8_SA
#undef PG8_SB
#undef PG8_STAGE
#undef PG8_STAGE_A
#undef PG8_GLOAD
#undef PG8_UNI
#undef PG8_LDA
#undef PG8_LDB
#undef PG8_MMA
#undef PG8_WAIT_V
#undef PG8_WAIT_L
#undef PG8_BAR
#undef PG8_SCHED
}
}
#include <hip/hip_bf16.h>
#include <cmath>
namespace attn_body {
using bf16=__hip_bfloat16;
using bf16x8=__attribute__((ext_vector_type(8)))short;
using s16x4=__attribute__((ext_vector_type(4)))short;
using f32x16=__attribute__((ext_vector_type(16)))float;
using u32x4=__attribute__((ext_vector_type(4)))unsigned;
constexpr int BATCH=4,NHEAD=16,SEQ=8192,D=64,DM=NHEAD*D;
constexpr int NW=8,QBLK=32,QB=QBLK*NW,KVBLK=64,NQB=SEQ/QB;
constexpr int ATTN_PITCH=DM, ATTN_UNIT_ROWS=QB;
__device__ __forceinline__ int crow(int r,int hi){return (r&3)+8*(r>>2)+4*hi;}
#define SBAR() __builtin_amdgcn_sched_barrier(0)
__device__ __forceinline__ void cmask(f32x16&p0,f32x16&p1,int jb,int qrel,int hi){
  const float NEG=-INFINITY; int kb=64*jb+4*hi;
  #pragma unroll
  for(int r=0;r<16;++r){int kv=kb+(r&3)+8*(r>>2); if(kv>qrel)p0[r]=NEG; if(kv+32>qrel)p1[r]=NEG;}
}

constexpr int NSLOT=3, SLOTB=8192;
constexpr int LDS_K=0, LDS_V=NSLOT*SLOTB, LDS_WS=2*NSLOT*SLOTB, LDS_OST=LDS_WS+NW*64*4, LDS_CS=LDS_OST+NW*4096, LDS_BYTES=LDS_CS+SEQ*4;
constexpr float C2=0.125f*1.4426950408889634f;
__device__ __forceinline__ void glds16(const void*gsrc,unsigned lds_dst){unsigned keep;
  asm volatile("s_mov_b32 %0, m0\n\ts_mov_b32 m0, %2\n\ts_nop 0\n\tglobal_load_lds_dwordx4 %1, off\n\ts_mov_b32 m0, %0":"=&s"(keep):"v"(gsrc),"s"(lds_dst):"memory");}
__device__ __forceinline__ float max3f(float a,float b,float c){float r;asm("v_max3_f32 %0, %1, %2, %3":"=v"(r):"v"(a),"v"(b),"v"(c));return r;}
__device__ __forceinline__ float max2f(float a,float b){float r;asm("v_max_f32_e32 %0, %1, %2":"=v"(r):"v"(a),"v"(b));return r;}
__device__ __forceinline__ float fadd_s(float a,float b){float r;asm("v_add_f32_e32 %0, %1, %2":"=v"(r):"v"(a),"v"(b));return r;}
__device__ __forceinline__ float fsub_s(float a,float b){float r;asm("v_sub_f32_e32 %0, %1, %2":"=v"(r):"v"(a),"v"(b));return r;}
typedef float f32x2_t __attribute__((ext_vector_type(2))); typedef __bf16 bf16x2_t __attribute__((ext_vector_type(2)));
__device__ __forceinline__ unsigned cvtpk_s(float lo,float hi){f32x2_t v={lo,hi};bf16x2_t b=__builtin_convertvector(v,bf16x2_t);return __builtin_bit_cast(unsigned,b);}
#define WAIT_BAR(N) asm volatile("s_waitcnt vmcnt(" #N ") lgkmcnt(0)\n\ts_barrier":::"memory")

__device__ __forceinline__ void qkt(f32x16&p0,f32x16&p1,const char*Kslot,const bf16x8*qr,int r32,int hi){
  const char*kb=Kslot+hi*1024+r32*16;
  #pragma unroll
  for(int d0=0;d0<4;++d0){
    const bf16x8 b0=*reinterpret_cast<const bf16x8*>(kb+d0*2048);
    const bf16x8 b1=*reinterpret_cast<const bf16x8*>(kb+d0*2048+512);
    {p0=__builtin_amdgcn_mfma_f32_32x32x16_bf16(b0,qr[d0],p0,0,0,0);p1=__builtin_amdgcn_mfma_f32_32x32x16_bf16(b1,qr[d0],p1,0,0,0);}}
}
typedef __attribute__((address_space(3))) const char* lds_cptr;
typedef short v4i16_t __attribute__((ext_vector_type(4)));
__device__ __forceinline__ void kload8(bf16x8*kf,lds_cptr kp){
  kf[0]=*(const __attribute__((address_space(3))) bf16x8*)(kp);      kf[1]=*(const __attribute__((address_space(3))) bf16x8*)(kp+512);
  kf[2]=*(const __attribute__((address_space(3))) bf16x8*)(kp+2048); kf[3]=*(const __attribute__((address_space(3))) bf16x8*)(kp+2560);
  kf[4]=*(const __attribute__((address_space(3))) bf16x8*)(kp+4096); kf[5]=*(const __attribute__((address_space(3))) bf16x8*)(kp+4608);
  kf[6]=*(const __attribute__((address_space(3))) bf16x8*)(kp+6144); kf[7]=*(const __attribute__((address_space(3))) bf16x8*)(kp+6656);
}
__device__ __forceinline__ void kload2(bf16x8*kf,lds_cptr kp,int j){ kf[2*j]=*(const __attribute__((address_space(3))) bf16x8*)(kp+j*2048); kf[2*j+1]=*(const __attribute__((address_space(3))) bf16x8*)(kp+j*2048+512); }
__device__ __forceinline__ s16x4 vtr(lds_cptr p){ return __builtin_bit_cast(s16x4,__builtin_amdgcn_ds_read_tr16_b64_v4i16((__attribute__((address_space(3))) v4i16_t*)p)); }
__device__ __forceinline__ float rowmax(const f32x16&p0,const f32x16&p1){
  float a=max3f(p0[0],p0[1],p1[0]),b=max3f(p0[2],p0[3],p1[1]);a=max3f(a,p1[2],p1[3]);
  #pragma unroll
  for(int r=4;r<16;r+=4){a=max3f(a,p0[r],p0[r+1]);b=max3f(b,p0[r+2],p0[r+3]);a=max3f(a,p1[r],p1[r+1]);b=max3f(b,p1[r+2],p1[r+3]);}
  const float m=max2f(a,b);
  auto rr=__builtin_amdgcn_permlane32_swap(__float_as_uint(m),__float_as_uint(m),false,false);
  return max2f(__uint_as_float(rr[0]),__uint_as_float(rr[1]));
}
__device__ __forceinline__ void pv(f32x16*o,int vb,bf16x8 pa0,bf16x8 pa1,bf16x8 pa2,bf16x8 pa3){
  #pragma unroll
  for(int d0=0;d0<2;++d0){s16x4 lo[4],hi[4];
    #pragma unroll
    for(int ks=0;ks<4;++ks){
      asm volatile("ds_read_b64_tr_b16 %0,%1 offset:%c2":"=&v"(lo[ks]):"v"(vb),"i"(d0*4096+ks*1024):"memory");
      asm volatile("ds_read_b64_tr_b16 %0,%1 offset:%c2":"=&v"(hi[ks]):"v"(vb),"i"(d0*4096+ks*1024+512):"memory");}
    asm volatile("s_waitcnt lgkmcnt(0)":::"memory");SBAR();
    #define PK(k) (bf16x8){lo[k][0],lo[k][1],lo[k][2],lo[k][3],hi[k][0],hi[k][1],hi[k][2],hi[k][3]}
    o[d0]=__builtin_amdgcn_mfma_f32_32x32x16_bf16(pa0,PK(0),o[d0],0,0,0);
    o[d0]=__builtin_amdgcn_mfma_f32_32x32x16_bf16(pa1,PK(1),o[d0],0,0,0);
    o[d0]=__builtin_amdgcn_mfma_f32_32x32x16_bf16(pa2,PK(2),o[d0],0,0,0);
    o[d0]=__builtin_amdgcn_mfma_f32_32x32x16_bf16(pa3,PK(3),o[d0],0,0,0);
    #undef PK
  }
}

#ifndef ATTN_STORE16
#define ATTN_STORE16(p,v) (*(u32x4*)(p)=(v))
#endif
template<int THRL> __device__ __forceinline__ void attn_unit(int b,int h,int qb,const bf16*Q,const bf16*__restrict__ K,const bf16*__restrict__ V,bf16*O,const float*__restrict__ CS,char*shm,const int wid_in){
  int lane_=(int)__builtin_amdgcn_mbcnt_hi(~0u,__builtin_amdgcn_mbcnt_lo(~0u,0u)); asm volatile("":"+v"(lane_));
  const int wid=__builtin_amdgcn_readfirstlane(wid_in),lane=lane_,tid=wid*64+lane,r32=lane&31,hi=lane>>5;
  const long rowbase=(long)b*SEQ; const int q0=qb*QB;
  const bf16*Qw=Q+(rowbase+q0+wid*QBLK)*DM+h*D;
  const bf16*Kh=K+rowbase*DM+h*D,*Vh=V+rowbase*DM+h*D;
  const unsigned lds0=(unsigned)(uintptr_t)shm;
  float*wsf=(float*)(shm+LDS_WS)+wid*64;
  const bf16*ksrc=Kh+(long)lane*DM+wid*8;
  const bf16*vsrc=Vh+(long)(16*(wid&3)+(lane>>2))*DM+(wid>>2)*32+(lane&3)*8;
  const unsigned kdst=lds0+LDS_K+wid*1024, vdst=lds0+LDS_V+wid*1024;
  #define DMA_K(t,slot) glds16(ksrc+(long)(t)*KVBLK*DM,(unsigned)__builtin_amdgcn_readfirstlane(kdst+(slot)))
  #define DMA_V(t,slot) glds16(vsrc+(long)(t)*KVBLK*DM,(unsigned)__builtin_amdgcn_readfirstlane(vdst+(slot)))
  const int vb0=(int)(lds0+LDS_V)+((lane>>4)&1)*32+(lane&3)*8+(4*hi+((lane&15)>>2))*64;
  const char*Kbase=shm+LDS_K; bf16x8 kf[8];
  const lds_cptr shm3=(lds_cptr)shm; const lds_cptr kp0=shm3+LDS_K+hi*1024+r32*16; const lds_cptr vp0=shm3+LDS_V+((lane>>4)&1)*32+(lane&3)*8+(4*hi+((lane&15)>>2))*64;
  const int NT=(q0+QB)/KVBLK;
  typedef float f32x4v __attribute__((ext_vector_type(4)));
  const float*csrc=CS+(long)(b*NHEAD+h)*SEQ;
  float rowoff=csrc[q0+wid*QBLK+r32];
  { __attribute__((address_space(3))) f32x4v*cl=(__attribute__((address_space(3))) f32x4v*)(shm3+LDS_CS);
    for(int i_=tid;i_<NT*16;i_+=NW*64){ const f32x4v v_=*(const f32x4v*)(csrc+4*i_); cl[i_]=v_; } }
  const __attribute__((address_space(3))) float*csl=(const __attribute__((address_space(3))) float*)(shm3+LDS_CS)+4*hi;
  #define BIAS(C0,C1,t) do{ const __attribute__((address_space(3))) f32x4v*p_=(const __attribute__((address_space(3))) f32x4v*)(csl+(t)*64); \
    _Pragma("unroll") for(int g_=0;g_<4;++g_){ const f32x4v a_=p_[2*g_], b_=p_[2*g_+8]; \
      C0[4*g_+0]=rowoff-a_[0]; C0[4*g_+1]=rowoff-a_[1]; C0[4*g_+2]=rowoff-a_[2]; C0[4*g_+3]=rowoff-a_[3]; \
      C1[4*g_+0]=rowoff-b_[0]; C1[4*g_+1]=rowoff-b_[1]; C1[4*g_+2]=rowoff-b_[2]; C1[4*g_+3]=rowoff-b_[3]; } }while(0)
  DMA_K(0,0);DMA_V(0,0);DMA_K(1,SLOTB);
  bf16x8 qr[4];
  #pragma unroll
  for(int d0=0;d0<4;++d0)qr[d0]=*reinterpret_cast<const bf16x8*>(&Qw[(long)r32*DM+d0*16+hi*8]);
  float l_reg=0.f;f32x16 o[2];o[0]=f32x16{};o[1]=f32x16{};
  const int qrel=wid*QBLK+r32;
  #define CMASK(P0,P1,t) do{int jb_=(t)-(NT-4); if(jb_>=0)cmask(P0,P1,jb_,qrel,hi);}while(0)
  bool resc=false;
  #define START(P0,P1) do{ const float rm=rowmax(P0,P1); resc=false; \
    { const float dl=rm; rowoff=fsub_s(rowoff,dl); \
      _Pragma("unroll") for(int r=0;r<16;++r){P0[r]=fsub_s(P0[r],dl);P1[r]=fsub_s(P1[r],dl);} \
      } \
    _Pragma("unroll") for(int r=0;r<16;++r)P0[r]=__builtin_amdgcn_exp2f(P0[r]); }while(0)
  #define RESC() do{ if(resc){ asm volatile("s_waitcnt lgkmcnt(0)":::"memory"); \
      _Pragma("unroll") for(int d_=0;d_<2;++d_) _Pragma("unroll") for(int r=0;r<16;++r)o[d_][r]*=wsf[crow(r,hi)]; } }while(0)
  f32x16 pA0,pA1,pB0,pB1;
  int sl_prev=0,sl_cur=0,sl_next=SLOTB;
  #define ROT() do{sl_prev=sl_cur;sl_cur=sl_next;sl_next=(sl_next==(NSLOT-1)*SLOTB)?0:sl_next+SLOTB;}while(0)
  DMA_K(2,2*SLOTB);
  WAIT_BAR(3);
  BIAS(pA0,pA1,0); qkt(pA0,pA1,Kbase,qr,r32,hi);asm volatile("s_nop 15\n\ts_nop 7":"+v"(pA0),"+v"(pA1));CMASK(pA0,pA1,0);
  START(pA0,pA1);
  _Pragma("unroll") for(int r=0;r<16;++r)pA1[r]=__builtin_amdgcn_exp2f(pA1[r]);
  WAIT_BAR(0);
  DMA_K(3,0);DMA_V(1,SLOTB);
  ROT();
  kload8(kf,kp0+sl_cur);
  WAIT_BAR(2);
  s16x4 vlo[8],vhi[8]; u32x4 pw0,pw1,pw2,pw3;
  #define PKW(P,B) cvtpk_s(P[B],P[B+1])
  #define PAF(k) __builtin_bit_cast(bf16x8,pw##k)
  #define VFR(i) (bf16x8){vlo[i][0],vlo[i][1],vlo[i][2],vlo[i][3],vhi[i][0],vhi[i][1],vhi[i][2],vhi[i][3]}
  #define PIN(x) asm volatile("":"+v"(x))
  #define MX3(a,b,c) __builtin_fmaxf(__builtin_fmaxf((a),(b)),(c))
  #define GAPA(MF,A0,A1,A2,A3,W0,W1,PW) do{ MF; sacc+=A0; sacc+=A1; sacc+=A2; sacc+=A3; PIN(sacc); W0; W1; PIN(PW); SBAR(); }while(0)
  #define EX(v) __builtin_amdgcn_exp2f(v)
  #define GAPB(MF,X,B) do{ MF; X[B]=EX(X[B]); X[B+1]=EX(X[B+1]); X[B+2]=EX(X[B+2]); X[B+3]=EX(X[B+3]); PIN(X); SBAR(); }while(0)
  #define VRD(i) do{ vlo[i]=vtr(vp_+(((i)>>2)*4096+((i)&3)*1024)); vhi[i]=vtr(vp_+(((i)>>2)*4096+((i)&3)*1024+512)); }while(0)
  #define KRD(G,j) do{ if(G){ kload2(kf,kp0+sl_next,j); SBAR(); } }while(0)
  #define STEP(C0,C1,P0,P1,t,GK,GV,GL) do{ SBAR(); BIAS(C0,C1,t); SBAR(); \
    const lds_cptr vp_=vp0+sl_prev; \
    VRD(0); SBAR(); float sacc=(P0[0]+P0[1]); \
    GAPA(C0=__builtin_amdgcn_mfma_f32_32x32x16_bf16(kf[0],qr[0],C0,0,0,0), P0[2],P0[3],P0[4],P0[5],     pw0[0]=PKW(P0,0), pw0[1]=PKW(P0,2), pw0); \
    VRD(4); SBAR(); GAPA(C1=__builtin_amdgcn_mfma_f32_32x32x16_bf16(kf[1],qr[0],C1,0,0,0), P0[6],P0[7],P0[8],P0[9],     pw0[2]=PKW(P0,4), pw0[3]=PKW(P0,6), pw0); \
    VRD(1); SBAR(); GAPA(C0=__builtin_amdgcn_mfma_f32_32x32x16_bf16(kf[2],qr[1],C0,0,0,0),   P0[10],P0[11],P0[12],P0[13], pw1[0]=PKW(P0,8), pw1[1]=PKW(P0,10), pw1); \
    VRD(5); SBAR(); GAPA(C1=__builtin_amdgcn_mfma_f32_32x32x16_bf16(kf[3],qr[1],C1,0,0,0),   P0[14],P0[15],P1[0],P1[1],   pw1[2]=PKW(P0,12),pw1[3]=PKW(P0,14), pw1); \
    VRD(2); SBAR(); GAPA(C0=__builtin_amdgcn_mfma_f32_32x32x16_bf16(kf[4],qr[2],C0,0,0,0),   P1[2],P1[3],P1[4],P1[5],     pw2[0]=PKW(P1,0), pw2[1]=PKW(P1,2), pw2); \
    VRD(6); SBAR(); GAPA(C1=__builtin_amdgcn_mfma_f32_32x32x16_bf16(kf[5],qr[2],C1,0,0,0),   P1[6],P1[7],P1[8],P1[9],     pw2[2]=PKW(P1,4), pw2[3]=PKW(P1,6), pw2); \
    VRD(3); SBAR(); GAPA(C0=__builtin_amdgcn_mfma_f32_32x32x16_bf16(kf[6],qr[3],C0,0,0,0),   P1[10],P1[11],P1[12],P1[13], pw3[0]=PKW(P1,8), pw3[1]=PKW(P1,10), pw3); \
    VRD(7); SBAR(); GAPA(C1=__builtin_amdgcn_mfma_f32_32x32x16_bf16(kf[7],qr[3],C1,0,0,0),   P1[14],P1[15],0.f,0.f,       pw3[2]=PKW(P1,12),pw3[3]=PKW(P1,14), pw3); \
    l_reg+=sacc; \
    if(GK){DMA_K((t)+3,sl_cur);} if(GV){DMA_V((t)+1,sl_next);} \
    CMASK(C0,C1,t); \
    { float a=MX3(C0[0],C0[1],C1[0]),b=MX3(C0[2],C0[3],C1[1]); a=MX3(a,C1[2],C1[3]); \
      _Pragma("unroll") for(int r=4;r<16;r+=4){a=MX3(a,C0[r],C0[r+1]);b=MX3(b,C0[r+2],C0[r+3]);a=MX3(a,C1[r],C1[r+1]);b=MX3(b,C1[r+2],C1[r+3]);} \
      float rm=__builtin_fmaxf(a,b); { auto rr=__builtin_amdgcn_permlane32_swap(__float_as_uint(rm),__float_as_uint(rm),false,false); rm=__builtin_fmaxf(__uint_as_float(rr[0]),__uint_as_float(rr[1])); } \
      resc=false; \
      if(__builtin_expect(__any(rm>(float)THRL),0)){ const float dl=__builtin_fmaxf(rm,0.f); rowoff-=dl; \
        _Pragma("unroll") for(int r=0;r<16;++r){C0[r]-=dl;C1[r]-=dl;} \
        const float f=__builtin_amdgcn_exp2f(-dl); l_reg*=f; if(hi==0)wsf[r32]=f; resc=true; } } \
    SBAR(); \
    GAPB(o[0]=__builtin_amdgcn_mfma_f32_32x32x16_bf16(PAF(0),VFR(0),o[0],0,0,0), C0,0); \
    GAPB(o[1]=__builtin_amdgcn_mfma_f32_32x32x16_bf16(PAF(0),VFR(4),o[1],0,0,0), C0,4); \
    KRD(GL,0); GAPB(o[0]=__builtin_amdgcn_mfma_f32_32x32x16_bf16(PAF(1),VFR(1),o[0],0,0,0), C0,8); \
    KRD(GL,1); GAPB(o[1]=__builtin_amdgcn_mfma_f32_32x32x16_bf16(PAF(1),VFR(5),o[1],0,0,0), C0,12); \
    KRD(GL,2); GAPB(o[0]=__builtin_amdgcn_mfma_f32_32x32x16_bf16(PAF(2),VFR(2),o[0],0,0,0), C1,0); \
    KRD(GL,3); GAPB(o[1]=__builtin_amdgcn_mfma_f32_32x32x16_bf16(PAF(2),VFR(6),o[1],0,0,0), C1,4); \
    GAPB(o[0]=__builtin_amdgcn_mfma_f32_32x32x16_bf16(PAF(3),VFR(3),o[0],0,0,0), C1,8); \
    GAPB(o[1]=__builtin_amdgcn_mfma_f32_32x32x16_bf16(PAF(3),VFR(7),o[1],0,0,0), C1,12); \
    }while(0)
  int t=1;
  #undef CMASK
  #define CMASK(P0,P1,t) do{}while(0)
  for(;t+5<NT;t+=2){
    STEP(pB0,pB1,pA0,pA1,t,true,true,true);     WAIT_BAR(2); RESC(); ROT();
    STEP(pA0,pA1,pB0,pB1,t+1,true,true,true);   WAIT_BAR(2); RESC(); ROT();
  }
  #undef CMASK
  #define CMASK(P0,P1,t) do{int jb_=(t)-(NT-4); if(jb_>=0)cmask(P0,P1,jb_,qrel,hi);}while(0)
  #define ENDW(tt) do{ if((tt)+3<NT){WAIT_BAR(2);} else if((tt)+2<NT){WAIT_BAR(1);} else {WAIT_BAR(0);} }while(0)
  for(;t+1<NT;t+=2){
    STEP(pB0,pB1,pA0,pA1,t,(t+3<NT),(t+1<NT),(t+1<NT));       ENDW(t);   RESC(); ROT();
    STEP(pA0,pA1,pB0,pB1,t+1,(t+4<NT),(t+2<NT),(t+2<NT));     ENDW(t+1); RESC(); ROT();
  }
  STEP(pB0,pB1,pA0,pA1,NT-1,false,false,false); RESC();
  { float sacc=pB0[0]+pB0[1]; _Pragma("unroll") for(int r=2;r<16;++r)sacc+=pB0[r]; _Pragma("unroll") for(int r=0;r<16;++r)sacc+=pB1[r]; l_reg+=sacc;
    pw0=(u32x4){PKW(pB0,0),PKW(pB0,2),PKW(pB0,4),PKW(pB0,6)};pw1=(u32x4){PKW(pB0,8),PKW(pB0,10),PKW(pB0,12),PKW(pB0,14)};pw2=(u32x4){PKW(pB1,0),PKW(pB1,2),PKW(pB1,4),PKW(pB1,6)};pw3=(u32x4){PKW(pB1,8),PKW(pB1,10),PKW(pB1,12),PKW(pB1,14)};
    SBAR(); pv(o,vb0+sl_cur,PAF(0),PAF(1),PAF(2),PAF(3)); }
  #undef PKW
  #undef PAF
  #undef VFR
  #undef PIN
  #undef MX3
  #undef GAPA
  #undef GAPB
  #undef EX
  #undef VRD
  #undef KRD
  #undef STEP
  #undef ENDW
  {auto rr=__builtin_amdgcn_permlane32_swap(__float_as_uint(l_reg),__float_as_uint(l_reg),false,false);l_reg=__uint_as_float(rr[0])+__uint_as_float(rr[1]);}
  if(hi==0)wsf[32+r32]=l_reg;asm volatile("s_waitcnt lgkmcnt(0)":::"memory");
  float rli[16];
  #pragma unroll
  for(int r=0;r<16;++r)rli[r]=__builtin_amdgcn_rcpf(wsf[32+crow(r,hi)]);
  bf16*Ow=O+(rowbase+q0+wid*QBLK)*DM+h*D;
  { bf16*stg=(bf16*)(shm+LDS_OST)+wid*2048;
    #pragma unroll
    for(int r=0;r<16;++r){const int orow=crow(r,hi);
      #pragma unroll
      for(int d0=0;d0<2;++d0)stg[orow*64+d0*32+r32]=__float2bfloat16(o[d0][r]*rli[r]);}
    asm volatile("s_waitcnt lgkmcnt(0)":::"memory");
    #pragma unroll
    for(int i=0;i<4;++i){const int row=i*8+(lane>>3),ch=lane&7; const u32x4 v=*(const u32x4*)(stg+row*64+ch*8); ATTN_STORE16(Ow+(long)row*DM+ch*8,v);} }
  asm volatile("s_waitcnt lgkmcnt(0)\n\ts_barrier":::"memory");
  #undef BIAS
  #undef DMA_K
  #undef DMA_V
  #undef CMASK
  #undef START
  #undef RESC
  #undef ROT
}
constexpr int ATTN_LDS_BYTES=LDS_BYTES;
struct AttnTensors { const bf16* Q; const bf16* K; const bf16* V; bf16* O; const float* CS; };
struct AttnUnit { int bh; int qb; };
struct StaticOrder {
  int vcu, G;
  __device__ __forceinline__ explicit StaticOrder(int grid,int block):vcu((grid%8==0)?(block%8)*(grid/8)+block/8:block),G(grid){}
  __device__ __forceinline__ bool next(int i,AttnUnit&u)const{ const int ci=vcu+(i>>2)*G; if(ci>=BATCH*NHEAD*8)return false; const int s=ci&7, ii=i&3; u.bh=ci>>3; u.qb=(ii==0)?s:(ii==1)?15-s:(ii==2)?16+s:31-s; return true; }
  __device__ __forceinline__ void a_ready(const AttnUnit&)const{}
  __device__ __forceinline__ void done(const AttnUnit&)const{}
};
template<class Sched,int THRL=8> __device__ __forceinline__ void attn_phase(char*lds,const AttnTensors&T,const Sched&S,const int wid){
  AttnUnit u;
  for(int i=0;S.next(i,u);++i){ S.a_ready(u); u.bh=__builtin_amdgcn_readfirstlane(u.bh); u.qb=__builtin_amdgcn_readfirstlane(u.qb); attn_unit<THRL>(u.bh/NHEAD,u.bh%NHEAD,u.qb,T.Q,T.K,T.V,T.O,T.CS,lds,wid); S.done(u); }
}
#undef SBAR
#undef WAIT_BAR
}

constexpr int NWAVES = 8;
constexpr int BATCH = 4, SEQ = 8192, T = BATCH * SEQ, D = 1024, NH = 16, NE = 32, TOPK = 4, FF = 1024, DEPTH = 4;
constexpr int NGROUP = T / 128;
constexpr int NTILE_MAX = (T * TOPK) / 256 + NE;
constexpr int NSLOT_MAX = NTILE_MAX * 256;
constexpr float LN_EPS = 1e-5f;
constexpr float DN_ALPHA = 1.6817928305074290f;
constexpr float LOG2E = 1.4426950408889634f;
constexpr size_t MiB = 1u << 20;
constexpr size_t WS_CTL = 0, CTL_ZERO_BYTES = 1 * MiB;
constexpr size_t WS_MOD = 1 * MiB, WS_KVMOD = 1 * MiB + 512 * 1024;
constexpr size_t WS_WRT = 2 * MiB, WS_WFT = 2 * MiB + 512 * 1024;
constexpr size_t WS_BLKCNT = 3 * MiB, WS_TILES = 3 * MiB + 64 * 1024;
constexpr size_t WS_LOGF = 4 * MiB, WS_CS = 6 * MiB;
constexpr size_t WS_TKI = 8 * MiB, WS_TKW = 9 * MiB, WS_SLOTOF = 10 * MiB, WS_SLOTTOK = 11 * MiB;
constexpr size_t WS_WCI = 12 * MiB, WS_WCO = 24 * MiB, WS_WKV = 28 * MiB, WS_WQ = 32 * MiB, WS_WO = 36 * MiB;
constexpr size_t WS_WGU = 64 * MiB, WS_WD = 576 * MiB;
constexpr size_t WS_X = 832 * MiB, WS_HB = 960 * MiB, WS_HKV = 1024 * MiB, WS_ZB = 1088 * MiB, WS_GB = 1152 * MiB, WS_YB = 1216 * MiB, WS_SUB = 1280 * MiB;
constexpr size_t WS_Q = 1344 * MiB, WS_K = 1408 * MiB, WS_V = 1472 * MiB, WS_A1 = 1536 * MiB, WS_Y2 = 1808 * MiB, WS_END = 2080 * MiB;
static_assert(WS_A1 + (size_t)NSLOT_MAX * 1024 * 2 <= WS_Y2 && WS_Y2 + (size_t)NSLOT_MAX * 1024 * 2 <= WS_END, "d_ws map");
constexpr int CW_BAR = 4096;
constexpr int MAX_BAR_REGIONS = 64;
constexpr int RING_OFF = 0, RING_BYTES = 131072;
constexpr int LDSCTL_OFF = RING_BYTES, MISC_OFF = LDSCTL_OFF + 320;
constexpr int HIST_OFF = LDSCTL_OFF + 512;
constexpr int TILE_OFF = LDSCTL_OFF + 1024;
constexpr int SLOTW_OFF = LDSCTL_OFF + 4096;
constexpr int PTRS_OFF = LDSCTL_OFF + 8192;
constexpr int LDS_BYTES = 147456;

#define GAS __attribute__((address_space(1)))
#define LAS __attribute__((address_space(3)))
typedef unsigned short bf16;
typedef unsigned v4u __attribute__((ext_vector_type(4)));
typedef float f32x4 __attribute__((ext_vector_type(4)));
typedef short bf16x8 __attribute__((ext_vector_type(8)));
typedef GAS unsigned gu32;
typedef GAS unsigned long long gu64;
#define RLX_AGENT __ATOMIC_RELAXED, __HIP_MEMORY_SCOPE_AGENT
#define LDS_WAIT() asm volatile("s_waitcnt lgkmcnt(0)" ::: "memory")
#define VM_WAIT() asm volatile("s_waitcnt vmcnt(0)" ::: "memory")
__device__ __forceinline__ unsigned long long rt() { return __builtin_amdgcn_s_memrealtime(); }
__device__ __forceinline__ unsigned f2bf(float f) { unsigned u = __builtin_bit_cast(unsigned, f); return (u + 0x7fffu + ((u >> 16) & 1u)) >> 16; }
__device__ __forceinline__ unsigned pk2(float lo, float hi) { return f2bf(lo) | (f2bf(hi) << 16); }

#define XB_TMO      128
#define XB_XCNT(j)  (256  + 64 * (j))
#define XB_XSUB(j)  (1280 + 64 * (j))
#define XB_XGEN(j)  (2304 + 64 * (j))
#define XB_TOP      3328
#define XB_TOPGEN   3392
#define XCD_BAR_WORDS 3456
#define XB_SPIN_CAP (1u << 18)

__device__ __forceinline__ unsigned xb_ld(unsigned* p)              { return __hip_atomic_load(p, __ATOMIC_RELAXED, __HIP_MEMORY_SCOPE_AGENT); }
__device__ __forceinline__ unsigned xb_add(unsigned* p, unsigned v) { return __hip_atomic_fetch_add(p, v, __ATOMIC_RELAXED, __HIP_MEMORY_SCOPE_AGENT); }
__device__ __forceinline__ unsigned xb_xcc_id() { return (unsigned)__builtin_amdgcn_s_getreg((3 << 11) | 20) & 0xFu; }
#define XB_SPIN(cond, bar) do { unsigned _sp = 0; while (cond) { __builtin_amdgcn_s_sleep(1); \
    if ((++_sp & 255u) == 0u) { if (xb_ld(&(bar)[XB_TMO])) break; if (_sp > XB_SPIN_CAP) { atomicAdd(&(bar)[XB_TMO], 1u); break; } } } } while (0)

struct XcdBarrier {
    unsigned* bar; unsigned x;
    volatile LAS unsigned* st;
};

__device__ __forceinline__ XcdBarrier xcd_barrier_post(unsigned* bar, volatile LAS unsigned* st) {
    XcdBarrier b; b.bar = bar; b.x = xb_xcc_id(); b.st = st;
    if (threadIdx.x == 0) (void)xb_add(&bar[XB_XCNT(b.x)], 1u);
    return b;
}
__device__ __forceinline__ void xcd_barrier_complete(unsigned* bar, unsigned x, unsigned& nloc, unsigned& nx) {
    const unsigned G = gridDim.x * gridDim.y * gridDim.z;
    unsigned sum, cnt, mine, sp = 0u;
    for (;;) {
        sum = 0u; cnt = 0u; mine = 0u;
#pragma unroll
        for (unsigned j = 0; j < 16; ++j) { const unsigned c = xb_ld(&bar[XB_XCNT(j)]); sum += c; cnt += (c > 0u) ? 1u : 0u; mine = (j == x) ? c : mine; }
        if (sum == G) break;
        __builtin_amdgcn_s_sleep(1);
        if ((++sp & 255u) == 0u) { if (xb_ld(&bar[XB_TMO])) break; if (sp > XB_SPIN_CAP) { atomicAdd(&bar[XB_TMO], 1u); break; } }
    }
    nloc = mine > 0u ? mine : 1u; nx = cnt > 0u ? cnt : 1u;
}

__device__ __forceinline__ void xcd_barrier(const XcdBarrier& b, const bool leader_thread) {
    asm volatile("s_waitcnt vmcnt(0)" ::: "memory");
    __syncthreads();
    if (leader_thread) {
        unsigned* bar = b.bar;
        __builtin_amdgcn_s_waitcnt(0);
        unsigned nloc = b.st[0], nx = b.st[1];
        if (nloc == 0u) { xcd_barrier_complete(bar, b.x, nloc, nx); b.st[0] = nloc; b.st[1] = nx; }
        const unsigned old = xb_add(&bar[XB_XSUB(b.x)], 1u);
        const unsigned gen = old / nloc;
        if (old + 1u == (gen + 1u) * nloc) {
            __builtin_amdgcn_fence(__ATOMIC_RELEASE, "agent");
            asm volatile("s_waitcnt vmcnt(0)" ::: "memory");
            const unsigned og = xb_add(&bar[XB_TOP], 1u);
            const unsigned tg = og / nx;
            if (og + 1u == (tg + 1u) * nx) xb_add(&bar[XB_TOPGEN], 1u);
            else XB_SPIN(xb_ld(&bar[XB_TOPGEN]) == tg, bar);
            __builtin_amdgcn_fence(__ATOMIC_ACQUIRE, "agent");
            xb_add(&bar[XB_XGEN(b.x)], 1u);
            asm volatile("s_waitcnt vmcnt(0)" ::: "memory");
        } else {
            XB_SPIN(xb_ld(&bar[XB_XGEN(b.x)]) == gen, bar);
            __builtin_amdgcn_fence(__ATOMIC_ACQUIRE, "agent");
            asm volatile("s_waitcnt vmcnt(0)" ::: "memory");
        }
    }
    __syncthreads();
}


static_assert(CW_BAR + MAX_BAR_REGIONS * XCD_BAR_WORDS <= (int)(CTL_ZERO_BYTES / 4), "barrier regions inside the memset region");
typedef float f32x2 __attribute__((ext_vector_type(2)));
typedef unsigned u32x2 __attribute__((ext_vector_type(2)));
typedef int i32x4 __attribute__((ext_vector_type(4)));

struct Frame {
    LAS unsigned char* lds;
    volatile LAS unsigned* MISC;
    int tid, lane, wave, vcu, G;
    unsigned char* ws;
};
enum { I_X = 0, I_C, I_CONV_W_IN, I_CONV_W, I_CONV_W_OUT, I_KV_ADA_W, I_KV_ADA_B, I_W_KVF, I_B_F, I_ATTN_W_Q, I_ATTN_W_O, I_ADA_W, I_ADA_B, I_LN_G, I_LN_B, I_ROUTER_W, I_ROUTER_B, I_EXP_W_GU, I_EXP_B_GU, I_EXP_W_DOWN, I_EXP_B_DOWN, I_OUT, I_NPTR };
__device__ __forceinline__ const float* inp(const Frame& F, int i) {
    const unsigned long long v = ((const LAS unsigned long long*)(F.lds + PTRS_OFF))[i];
    const unsigned lo = __builtin_amdgcn_readfirstlane((unsigned)v), hi = __builtin_amdgcn_readfirstlane((unsigned)(v >> 32));
    return (const float*)(((unsigned long long)hi << 32) | lo);
}
template <class Tp> __device__ __forceinline__ Tp* wsp(const Frame& F, size_t off) { return (Tp*)(F.ws + off); }
__device__ __forceinline__ float wave_sum(float v) {
#pragma unroll
    for (int o = 1; o < 64; o <<= 1) v += __shfl_xor(v, o);
    return v;
}
__device__ __forceinline__ f32x4 bf4_to_f32(u32x2 w) { f32x4 r; r.x = __builtin_bit_cast(float, w.x << 16); r.y = __builtin_bit_cast(float, w.x & 0xffff0000u); r.z = __builtin_bit_cast(float, w.y << 16); r.w = __builtin_bit_cast(float, w.y & 0xffff0000u); return r; }
__device__ __forceinline__ u32x2 f32_to_bf4(f32x4 v) { u32x2 r; r.x = pg8::cvt_pk_bf16(v.x, v.y); r.y = pg8::cvt_pk_bf16(v.z, v.w); return r; }

template <int N, int M> struct LaneRed {
    static __device__ __forceinline__ float run(float* r, int lane) {
        if constexpr (N > 1) {
            const bool up = (lane & M) != 0;
#pragma unroll
            for (int e = 0; e < N / 2; ++e) { const float keep = up ? r[e + N / 2] : r[e], send = up ? r[e] : r[e + N / 2]; r[e] = keep + __shfl_xor(send, M); }
            return LaneRed<N / 2, M / 2>::run(r, lane);
        } else {
            float v = r[0];
#pragma unroll
            for (int m = M; m >= 1; m >>= 1) v += __shfl_xor(v, m);
            return v;
        }
    }
};

__device__ __forceinline__ void p0_transpose_item(const float* W, int ldw, int K, bf16* WT, int k0, int n0, int drow, LAS float* scr, int lane) {
#pragma unroll 8
    for (int i = 0; i < 32; ++i) { const int kk = 2 * i + (lane >> 5); scr[kk * 33 + (lane & 31)] = W[(size_t)(k0 + kk) * ldw + n0 + (lane & 31)]; }
    LDS_WAIT(); asm volatile("" ::: "memory");
    const int c = lane & 7;
#pragma unroll
    for (int j = 0; j < 4; ++j) { const int n = (lane >> 3) + 8 * j; const LAS float* s = scr + (8 * c) * 33 + n;
        v4u o; o.x = pk2(s[0 * 33], s[1 * 33]); o.y = pk2(s[2 * 33], s[3 * 33]); o.z = pk2(s[4 * 33], s[5 * 33]); o.w = pk2(s[6 * 33], s[7 * 33]);
        *(GAS v4u*)(WT + (size_t)(drow + n) * K + k0 + 8 * c) = o; }
    LDS_WAIT(); asm volatile("" ::: "memory");
}
__device__ __forceinline__ int glu_row(int n0, int half) { const int isu = n0 >= half ? 1 : 0, np = n0 - isu * half; return 256 * (np >> 7) + 128 * isu + (np & 127); }

__device__ __forceinline__ void ph_prologue(Frame& F) {
    const int tid = F.tid, lane = F.lane, wave = F.wave;
    LAS float* condT = (LAS float*)(F.lds);
    LAS float* part = (LAS float*)(F.lds + 16384);
    const float* cin = inp(F, I_C); const float* ada_w = inp(F, I_ADA_W); const float* ada_b = inp(F, I_ADA_B); const float* kv_ada_w = inp(F, I_KV_ADA_W); const float* kv_ada_b = inp(F, I_KV_ADA_B);
    for (int i = tid; i < BATCH * D; i += NWAVES * 64) { const int b = i >> 10, k = i & 1023; const float cv = cin[i]; condT[k * 4 + b] = cv / (1.0f + expf(-cv)); }
    __syncthreads();
    float* MOD = wsp<float>(F, WS_MOD); float* KVMOD = wsp<float>(F, WS_KVMOD);
    for (int tk = blockIdx.x; tk < 208; tk += F.G) {
        const int c0 = tk * 128; const float* W; int ldw, col; const float* bias; float* dst; int dstld;
        if (c0 < 24576) { const int m = c0 / 3072; col = c0 - m * 3072; W = ada_w + (size_t)m * 1024 * 3072; ldw = 3072; bias = ada_b + m * 3072; dst = MOD + (size_t)m * 4 * 3072; dstld = 3072; }
        else { col = c0 - 24576; W = kv_ada_w; ldw = 2048; bias = kv_ada_b; dst = KVMOD; dstld = 2048; }
        float a0[4] = {0.f, 0.f, 0.f, 0.f}, a1[4] = {0.f, 0.f, 0.f, 0.f};
        const float* wp = W + (size_t)(wave * 128) * ldw + col + 2 * lane;
#pragma unroll 8
        for (int kk = 0; kk < 128; ++kk) { const f32x2 w2 = *(const f32x2*)(wp + (size_t)kk * ldw); const f32x4 c4 = *(const LAS f32x4*)(condT + (wave * 128 + kk) * 4);
#pragma unroll
            for (int b = 0; b < 4; ++b) { a0[b] += c4[b] * w2.x; a1[b] += c4[b] * w2.y; } }
#pragma unroll
        for (int b = 0; b < 4; ++b) { part[(wave * 4 + b) * 128 + 2 * lane] = a0[b]; part[(wave * 4 + b) * 128 + 2 * lane + 1] = a1[b]; }
        __syncthreads();
        { const int b = tid >> 7, cc = tid & 127; float s = bias[col + cc];
#pragma unroll
            for (int w = 0; w < 8; ++w) s += part[(w * 4 + b) * 128 + cc];
            dst[(size_t)b * dstld + col + cc] = s; }
        __syncthreads();
    }
    __syncthreads();
    {   const int gt = (F.vcu * NWAVES + wave) * 64 + lane, NGT = F.G * NWAVES * 64;
        float* WRT = wsp<float>(F, WS_WRT); float* WFT = wsp<float>(F, WS_WFT); const float* router_w = inp(F, I_ROUTER_W); const float* w_kvf = inp(F, I_W_KVF);
        for (int i = gt; i < DEPTH * NE * D; i += NGT) { const int l = i >> 15, e = (i >> 10) & 31, k = i & 1023; WRT[i] = router_w[((size_t)l * D + k) * NE + e]; }
        for (int i = gt; i < NH * D; i += NGT) { const int h = i >> 10, k = i & 1023; WFT[i] = w_kvf[(size_t)k * 2064 + 2048 + h]; }
    }
    LAS float* scr = (LAS float*)(F.lds + RING_OFF + wave * 16384);
    const int gw = F.vcu * NWAVES + wave, NGW = F.G * NWAVES;
    constexpr int I_CI = 2 * 16 * 96, I_CO = 2 * 16 * 32, I_KV = 16 * 64, I_Q = 2 * 16 * 32, I_O = 2 * 16 * 32, I_GU = 128 * 16 * 64, I_DN = 128 * 16 * 32;
    constexpr int NITEMS = I_CI + I_CO + I_KV + I_Q + I_O + I_GU + I_DN;
    for (int it = gw; it < NITEMS; it += NGW) {
        int r = it;
        if (r < I_CI) { const int mtx = r / (16 * 96), q = r % (16 * 96), kb = q / 96, nb = q % 96, n0 = nb * 32;
            int drow; if (n0 < 1024) drow = 256 * (n0 >> 7) + (n0 & 127); else if (n0 < 2048) drow = 2048 + (n0 - 1024); else { const int np = n0 - 2048; drow = 256 * (np >> 7) + 128 + (np & 127); }
            p0_transpose_item(inp(F, I_CONV_W_IN) + (size_t)mtx * D * 3072, 3072, D, wsp<bf16>(F, WS_WCI) + (size_t)mtx * 3072 * D, kb * 64, n0, drow, scr, lane); continue; } r -= I_CI;
        if (r < I_CO) { const int mtx = r / 512, q = r % 512, kb = q / 32, nb = q % 32;
            p0_transpose_item(inp(F, I_CONV_W_OUT) + (size_t)mtx * D * D, D, D, wsp<bf16>(F, WS_WCO) + (size_t)mtx * D * D, kb * 64, nb * 32, nb * 32, scr, lane); continue; } r -= I_CO;
        if (r < I_KV) { const int kb = r / 64, nb = r % 64;
            p0_transpose_item(inp(F, I_W_KVF), 2064, D, wsp<bf16>(F, WS_WKV), kb * 64, nb * 32, nb * 32, scr, lane); continue; } r -= I_KV;
        if (r < I_Q) { const int mtx = r / 512, q = r % 512, kb = q / 32, nb = q % 32;
            p0_transpose_item(inp(F, I_ATTN_W_Q) + (size_t)mtx * D * D, D, D, wsp<bf16>(F, WS_WQ) + (size_t)mtx * D * D, kb * 64, nb * 32, nb * 32, scr, lane); continue; } r -= I_Q;
        if (r < I_O) { const int mtx = r / 512, q = r % 512, kb = q / 32, nb = q % 32;
            p0_transpose_item(inp(F, I_ATTN_W_O) + (size_t)mtx * D * D, D, D, wsp<bf16>(F, WS_WO) + (size_t)mtx * D * D, kb * 64, nb * 32, nb * 32, scr, lane); continue; } r -= I_O;
        if (r < I_GU) { const int mtx = r >> 10, q = r & 1023, kb = q >> 6, nb = q & 63, n0 = nb * 32;
            p0_transpose_item(inp(F, I_EXP_W_GU) + (size_t)mtx * D * 2048, 2048, D, wsp<bf16>(F, WS_WGU) + (size_t)mtx * 2048 * D, kb * 64, n0, glu_row(n0, 1024), scr, lane); continue; } r -= I_GU;
        { const int mtx = r >> 9, q = r & 511, kb = q >> 5, nb = q & 31;
            p0_transpose_item(inp(F, I_EXP_W_DOWN) + (size_t)mtx * FF * D, D, FF, wsp<bf16>(F, WS_WD) + (size_t)mtx * D * FF, kb * 64, nb * 32, nb * 32, scr, lane); }
    }
}

__device__ __forceinline__ void ph_mod0(Frame& F) {
    const float* MOD = wsp<float>(F, WS_MOD); bf16* HB = wsp<bf16>(F, WS_HB); const float* xin = inp(F, I_X);
    const int gw = F.vcu * NWAVES + F.wave, NGW = F.G * NWAVES, lane = F.lane;
    for (int row0 = gw * 16; row0 < T; row0 += NGW * 16) {
        const int b = row0 >> 13; const float* mp = MOD + (size_t)b * 3072;
        f32x4 sh[4], sc[4];
#pragma unroll
        for (int j = 0; j < 4; ++j) { sh[j] = *(const f32x4*)(mp + 4 * lane + 256 * j); sc[j] = *(const f32x4*)(mp + 1024 + 4 * lane + 256 * j) + 1.0f; }
        for (int i = 0; i < 16; ++i) { const size_t ro = (size_t)(row0 + i) * D;
#pragma unroll
            for (int j = 0; j < 4; ++j) { const f32x4 xv = *(const f32x4*)(xin + ro + 4 * lane + 256 * j); *(u32x2*)(HB + ro + 4 * lane + 256 * j) = f32_to_bf4(xv * sc[j] + sh[j]); } }
    }
}

__device__ __forceinline__ void ph_conv(Frame& F, int l) {
    const bf16* ZB = wsp<bf16>(F, WS_ZB); const bf16* GB = wsp<bf16>(F, WS_GB); bf16* YB = wsp<bf16>(F, WS_YB);
    const float* cw = inp(F, I_CONV_W) + (size_t)l * 3 * D;
    const int gw = F.vcu * NWAVES + F.wave, NGW = F.G * NWAVES, lane = F.lane;
    for (int task = gw; task < (T / 16) * 2; task += NGW) {
        const int row0 = (task >> 1) * 16, ch = (task & 1) * 512 + lane * 8;
        f32x4 w0[2], w1[2], w2[2];
#pragma unroll
        for (int q = 0; q < 2; ++q) { w0[q] = *(const f32x4*)(cw + ch + 4 * q); w1[q] = *(const f32x4*)(cw + D + ch + 4 * q); w2[q] = *(const f32x4*)(cw + 2 * D + ch + 4 * q); }
        f32x4 zm2[2], zm1[2];
        if ((row0 & (SEQ - 1)) == 0) { zm2[0] = zm2[1] = zm1[0] = zm1[1] = (f32x4){0.f, 0.f, 0.f, 0.f}; }
        else { const v4u a = *(const v4u*)(ZB + (size_t)(row0 - 2) * D + ch), b = *(const v4u*)(ZB + (size_t)(row0 - 1) * D + ch);
            zm2[0] = bf4_to_f32((u32x2){a.x, a.y}); zm2[1] = bf4_to_f32((u32x2){a.z, a.w}); zm1[0] = bf4_to_f32((u32x2){b.x, b.y}); zm1[1] = bf4_to_f32((u32x2){b.z, b.w}); }
#pragma unroll 4
        for (int i = 0; i < 16; ++i) { const size_t o = (size_t)(row0 + i) * D + ch;
            const v4u zz = *(const v4u*)(ZB + o), gg = *(const v4u*)(GB + o);
            f32x4 z[2], g[2]; z[0] = bf4_to_f32((u32x2){zz.x, zz.y}); z[1] = bf4_to_f32((u32x2){zz.z, zz.w}); g[0] = bf4_to_f32((u32x2){gg.x, gg.y}); g[1] = bf4_to_f32((u32x2){gg.z, gg.w});
            f32x4 y[2];
#pragma unroll
            for (int q = 0; q < 2; ++q) { y[q] = g[q] * (w0[q] * zm2[q] + w1[q] * zm1[q] + w2[q] * z[q]); zm2[q] = zm1[q]; zm1[q] = z[q]; }
            const u32x2 p0 = f32_to_bf4(y[0]), p1 = f32_to_bf4(y[1]);
            *(v4u*)(YB + o) = (v4u){p0.x, p0.y, p1.x, p1.y}; }
    }
}

__device__ __forceinline__ void ld16(const float* p, f32x4 (&v)[4], int lane) {
#pragma unroll
    for (int j = 0; j < 4; ++j) v[j] = *(const f32x4*)(p + 4 * lane + 256 * j);
}
template <int MODE> __device__ __forceinline__ void ph_ln(Frame& F, int l, const float* xin, float* xout, unsigned poison) {
    const int tid = F.tid, lane = F.lane, wave = F.wave;
    const float* MOD = wsp<float>(F, WS_MOD);
    bf16* HB = wsp<bf16>(F, WS_HB);
    LAS f32x4* WL = (LAS f32x4*)(F.lds);
    LAS int* hist = (LAS int*)(F.lds + HIST_OFF);
    const bool has_next = (MODE == 0) || (l < 3);
    const bool do_kv = (MODE == 1) && (l == 1);
    if (MODE == 0) { const f32x4* src = (const f32x4*)(wsp<float>(F, WS_WRT) + (size_t)l * NE * D); for (int i = tid; i < NE * D / 4; i += NWAVES * 64) WL[i] = src[i]; if (tid < 32) hist[tid] = 0; }
    else if (do_kv) { const f32x4* src = (const f32x4*)wsp<float>(F, WS_WFT); for (int i = tid; i < NH * D / 4; i += NWAVES * 64) WL[i] = src[i]; }
    __syncthreads();
    const float* lgp = inp(F, I_LN_G) + (size_t)(l * 2 + MODE) * D; const float* lbp = inp(F, I_LN_B) + (size_t)(l * 2 + MODE) * D;
    const float* router_b = inp(F, I_ROUTER_B) + l * NE; const float* b_f = inp(F, I_B_F);
    const int nm = (MODE == 0) ? (l * 2 + 1) : ((l + 1) * 2);
    const bf16* SUB = wsp<bf16>(F, WS_SUB); const bf16* Y2 = wsp<bf16>(F, WS_Y2);
    const int* slot_of = wsp<int>(F, WS_SLOTOF); float* tkw = wsp<float>(F, WS_TKW); int* tki = wsp<int>(F, WS_TKI);
    const float qnan = __builtin_nanf("");
    for (int g = F.vcu; g < NGROUP; g += F.G) {
        const int row0 = g * 128 + wave * 16, b = row0 >> 13;
        f32x4 g1[4], lg[4], lb[4], msc[4], msh[4];
        ld16(MOD + ((size_t)(l * 2 + MODE) * 4 + b) * 3072 + 2048, g1, lane); ld16(lgp, lg, lane); ld16(lbp, lb, lane);
#pragma unroll
        for (int j = 0; j < 4; ++j) g1[j] = g1[j] + 1.0f;
#if defined(YK_EXP) && (YK_EXP & 128)
        if (MODE == 1) { for (int j = 0; j < 4; ++j) g1[j] = (f32x4){1.f, 1.f, 1.f, 1.f}; }
#endif
        if (has_next) { ld16(MOD + ((size_t)nm * 4 + b) * 3072, msh, lane); ld16(MOD + ((size_t)nm * 4 + b) * 3072 + 1024, msc, lane);
#pragma unroll
            for (int j = 0; j < 4; ++j) msc[j] = msc[j] + 1.0f; }
        else {
#pragma unroll
            for (int j = 0; j < 4; ++j) { msc[j] = (f32x4){0.f, 0.f, 0.f, 0.f}; msh[j] = msc[j]; } }
        i32x4 so_all = (i32x4){0, 0, 0, 0}; f32x4 tw_all = (f32x4){0.f, 0.f, 0.f, 0.f};
        if (MODE == 1) { const int rr = row0 + (lane & 15); so_all = *(const i32x4*)(slot_of + (size_t)rr * 4); tw_all = *(const f32x4*)(tkw + (size_t)rr * 4); }
        for (int i = 0; i < 16; ++i) {
            const int row = row0 + i; const size_t ro = (size_t)row * D;
            f32x4 v[4]; ld16(xin + ro, v, lane);
            if (MODE == 0) {
#pragma unroll
                for (int j = 0; j < 4; ++j) { const u32x2 sv = *(const u32x2*)(SUB + ro + 4 * lane + 256 * j); f32x4 sf = bf4_to_f32(sv);
#if defined(YK_EXP) && (YK_EXP & 2)
                    if (l >= 2) sf = sf * 0.0f;
#endif
#if defined(YK_EXP) && (YK_EXP & 4)
                    if (l < 2) sf = sf * 0.0f;
#endif
#if defined(YK_EXP) && (YK_EXP & 16)
                    if (l < 2) sf = sf * 2.0f;
#endif
#if defined(YK_EXP) && (YK_EXP & 64)
                    sf = sf * 0.5946f;
#endif
                    v[j] = v[j] * DN_ALPHA + g1[j] * sf; }
            } else {
                int so[4]; float tw[4];
                so[0] = __builtin_amdgcn_readlane(so_all.x, i); so[1] = __builtin_amdgcn_readlane(so_all.y, i); so[2] = __builtin_amdgcn_readlane(so_all.z, i); so[3] = __builtin_amdgcn_readlane(so_all.w, i);
                { const float t0 = tw_all.x, t1 = tw_all.y, t2 = tw_all.z, t3 = tw_all.w;
                  tw[0] = __int_as_float(__builtin_amdgcn_readlane(__float_as_int(t0), i)); tw[1] = __int_as_float(__builtin_amdgcn_readlane(__float_as_int(t1), i));
                  tw[2] = __int_as_float(__builtin_amdgcn_readlane(__float_as_int(t2), i)); tw[3] = __int_as_float(__builtin_amdgcn_readlane(__float_as_int(t3), i)); }
                u32x2 yv[4][4];
#pragma unroll
                for (int k = 0; k < 4; ++k)
#pragma unroll
                    for (int j = 0; j < 4; ++j) yv[k][j] = *(const u32x2*)(Y2 + (size_t)so[k] * D + 4 * lane + 256 * j);
#pragma unroll
                for (int j = 0; j < 4; ++j) { f32x4 s = bf4_to_f32(yv[0][j]) * tw[0]; s = s + bf4_to_f32(yv[1][j]) * tw[1]; s = s + bf4_to_f32(yv[2][j]) * tw[2]; s = s + bf4_to_f32(yv[3][j]) * tw[3];
#if defined(YK_EXP) && (YK_EXP & 1)
                    s = s * 0.0f;
#endif
#if defined(YK_EXP) && (YK_EXP & 8)
                    s = s * 2.0f;
#endif
#if defined(YK_EXP) && (YK_EXP & 32)
                    s = s * 0.5946f;
#endif
                    v[j] = v[j] * DN_ALPHA + g1[j] * s; }
            }
            float s1 = 0.f;
#pragma unroll
            for (int j = 0; j < 4; ++j) s1 += (v[j].x + v[j].y) + (v[j].z + v[j].w);
            const float mean = wave_sum(s1) * (1.0f / D); float s2 = 0.f;
#pragma unroll
            for (int j = 0; j < 4; ++j) { v[j] = v[j] - mean; s2 += (v[j].x * v[j].x + v[j].y * v[j].y) + (v[j].z * v[j].z + v[j].w * v[j].w); }
            const float rstd = 1.0f / sqrtf(wave_sum(s2) * (1.0f / D) + LN_EPS);
            f32x4 hv[4];
#pragma unroll
            for (int j = 0; j < 4; ++j) { f32x4 xo = v[j] * rstd * lg[j] + lb[j]; v[j] = xo; if (poison) xo = (f32x4){qnan, qnan, qnan, qnan};
                *(f32x4*)(xout + ro + 4 * lane + 256 * j) = xo; hv[j] = v[j] * msc[j] + msh[j]; }
            if (has_next) {
#pragma unroll
                for (int j = 0; j < 4; ++j) *(u32x2*)(HB + ro + 4 * lane + 256 * j) = f32_to_bf4(hv[j]);
            }
            if (MODE == 0) {
                float lvh[2];
#pragma unroll
                for (int hf = 0; hf < 2; ++hf) {
                    f32x2 a2[16];
#pragma unroll
                    for (int e = 0; e < 16; ++e) { a2[e] = (f32x2){0.f, 0.f};
#pragma unroll
                        for (int j = 0; j < 4; ++j) { const f32x4 w = WL[(hf * 16 + e) * 256 + lane + 64 * j]; a2[e] += (f32x2){hv[j].x, hv[j].y} * (f32x2){w.x, w.y}; a2[e] += (f32x2){hv[j].z, hv[j].w} * (f32x2){w.z, w.w}; } }
                    float r[16];
#pragma unroll
                    for (int e = 0; e < 16; ++e) r[e] = a2[e].x + a2[e].y;
                    lvh[hf] = LaneRed<16, 32>::run(r, lane);
                }
                const int e_me = lane >> 1;
                float lv; { const int src = 4 * (e_me & 15); const float s0 = __shfl(lvh[0], src), s1 = __shfl(lvh[1], src); lv = ((lane >> 5) ? s1 : s0) + router_b[e_me]; }
                float tv[4]; int ti[4];
#pragma unroll
                for (int k = 0; k < 4; ++k) { float m = lv; int mi = e_me;
#pragma unroll
                    for (int off = 1; off < 64; off <<= 1) { const float om = __shfl_xor(m, off); const int oi = __shfl_xor(mi, off); const bool take = (om > m) || (om == m && oi < mi); m = take ? om : m; mi = take ? oi : mi; }
                    tv[k] = m; ti[k] = mi; if (e_me == mi) lv = -INFINITY; }
                const float e1 = expf(tv[1] - tv[0]), e2 = expf(tv[2] - tv[0]), e3 = expf(tv[3] - tv[0]); const float inv = 1.0f / (1.0f + e1 + e2 + e3);
                if (lane == 0) { *(i32x4*)(tki + (size_t)row * 4) = (i32x4){ti[0], ti[1], ti[2], ti[3]}; *(f32x4*)(tkw + (size_t)row * 4) = (f32x4){inv, e1 * inv, e2 * inv, e3 * inv}; }
                if (lane < 4) { const int ee = lane == 0 ? ti[0] : lane == 1 ? ti[1] : lane == 2 ? ti[2] : ti[3]; __hip_atomic_fetch_add(hist + ee, 1, __ATOMIC_RELAXED, __HIP_MEMORY_SCOPE_WORKGROUP); }
            }
            if (do_kv) {
                const float* kvm = wsp<float>(F, WS_KVMOD) + (size_t)b * 2048; bf16* HKV = wsp<bf16>(F, WS_HKV);
                f32x4 kv[4];
#pragma unroll
                for (int j = 0; j < 4; ++j) { const f32x4 ksh = *(const f32x4*)(kvm + 4 * lane + 256 * j), ksc = *(const f32x4*)(kvm + 1024 + 4 * lane + 256 * j); kv[j] = v[j] * (ksc + 1.0f) + ksh;
                    *(u32x2*)(HKV + ro + 4 * lane + 256 * j) = f32_to_bf4(kv[j]); }
                f32x2 a2[NH];
#pragma unroll
                for (int e = 0; e < NH; ++e) { a2[e] = (f32x2){0.f, 0.f};
#pragma unroll
                    for (int j = 0; j < 4; ++j) { const f32x4 w = WL[e * 256 + lane + 64 * j]; a2[e] += (f32x2){kv[j].x, kv[j].y} * (f32x2){w.x, w.y}; a2[e] += (f32x2){kv[j].z, kv[j].w} * (f32x2){w.z, w.w}; } }
                float r[NH];
#pragma unroll
                for (int e = 0; e < NH; ++e) r[e] = a2[e].x + a2[e].y;
                const int hh = lane >> 2;
                const float z = LaneRed<NH, 32>::run(r, lane) + b_f[hh];
                const float lf = fminf(z, 0.f) - log1pf(expf(-fabsf(z)));
                if ((lane & 3) == 0) wsp<float>(F, WS_LOGF)[(size_t)row * NH + hh] = lf;
            }
        }
        if (MODE == 0) { __syncthreads(); if (tid < 32) { wsp<int>(F, WS_BLKCNT)[g * 32 + tid] = hist[tid]; hist[tid] = 0; } __syncthreads(); }
    }
}

__device__ __forceinline__ void ph_slot(Frame& F) {
    const int tid = F.tid;
    LAS int* cnt = (LAS int*)(F.lds);
    LAS int* sw = (LAS int*)(F.lds + SLOTW_OFF);
    const int* blk = wsp<int>(F, WS_BLKCNT);
    for (int i = tid; i < NGROUP * 32 / 4; i += NWAVES * 64) ((LAS i32x4*)cnt)[i] = ((const i32x4*)blk)[i];
    __syncthreads();
    if (tid < 32) { int s = 0; for (int gq = 0; gq < NGROUP; ++gq) s += cnt[gq * 32 + tid]; sw[tid] = s; }
    __syncthreads();
    if (tid == 0) { int acc = 0; for (int e = 0; e < NE; ++e) { sw[32 + e] = acc; acc += (sw[e] + 255) >> 8; } sw[128] = acc; }
    __syncthreads();
    const int* tki = wsp<int>(F, WS_TKI); int* slot_of = wsp<int>(F, WS_SLOTOF); int* slot_tok = wsp<int>(F, WS_SLOTTOK);
    for (int g = F.vcu; g < NGROUP; g += F.G) {
        if (tid < 32) { int s = 0; for (int gq = 0; gq < g; ++gq) s += cnt[gq * 32 + tid]; sw[96 + tid] = sw[32 + tid] * 256 + s; }
        __syncthreads();
        { const int a = g * 512 + tid; const int e = tki[a]; const int slot = __hip_atomic_fetch_add(sw + 96 + e, 1, __ATOMIC_RELAXED, __HIP_MEMORY_SCOPE_WORKGROUP); slot_of[a] = slot; slot_tok[slot] = a >> 2; }
        __syncthreads();
    }
    if (blockIdx.x == 0) {
        int* tiles = wsp<int>(F, WS_TILES);
        for (int e = 0; e < NE; ++e) { const int t0 = sw[32 + e], nt = (sw[e] + 255) >> 8; for (int i = tid; i < nt; i += NWAVES * 64) tiles[t0 + i] = e;
            const int p0 = t0 * 256 + sw[e], p1 = (t0 + nt) * 256; for (int i = p0 + tid; i < p1; i += NWAVES * 64) slot_tok[i] = 0; }
        if (tid == 0) tiles[1023] = sw[128];
    }
}

__device__ __forceinline__ pg8::MoeOrder moe_order(Frame& F, int sh) {
    LAS int* tl = (LAS int*)(F.lds + TILE_OFF);
    const int* tiles = wsp<int>(F, WS_TILES);
    const int NT = __builtin_amdgcn_readfirstlane(tiles[1023]);
    for (int i = F.tid; i < NTILE_MAX; i += NWAVES * 64) tl[i] = (i < NT) ? tiles[i] : 0;
    __syncthreads();
    const long U = (long)NT << sh;
    pg8::MoeOrder S; S.u0 = __builtin_amdgcn_readfirstlane((int)((U * F.vcu) / F.G)); S.u1 = __builtin_amdgcn_readfirstlane((int)((U * (F.vcu + 1)) / F.G)); S.sh = sh; S.tile_e = tl;
    return S;
}

__device__ __forceinline__ void ph_cumsum(Frame& F) {
    LAS float* tot = (LAS float*)(F.lds);
    const float* logf = wsp<float>(F, WS_LOGF); float* cs = wsp<float>(F, WS_CS);
    const int tid = F.tid;
    for (int bh = blockIdx.x; bh < BATCH * NH; bh += F.G) {
        const int b = bh >> 4, hh = bh & 15; const int t0 = tid * 16;
        float v[16]; float run = 0.f;
#pragma unroll
        for (int i = 0; i < 16; ++i) { run += logf[((size_t)b * SEQ + t0 + i) * NH + hh]; v[i] = run; }
        tot[tid] = run;
        __syncthreads();
        float off = 0.f; for (int j = 0; j < tid; ++j) off += tot[j];
#pragma unroll
        for (int i = 0; i < 16; ++i) cs[(size_t)bh * SEQ + t0 + i] = (off + v[i]) * LOG2E;
        __syncthreads();
    }
}

constexpr int ST_OFF = LDSCTL_OFF + 9216, WAVETAB_OFF = ST_OFF + 256;
enum { ST_PH = 0, ST_L, ST_LO, ST_HI, ST_VCU, ST_G, ST_WS_LO, ST_WS_HI, ST_BAR_LO, ST_BAR_HI, ST_BX };
__device__ __forceinline__ int st_get(LAS unsigned char* L, int i) { return __builtin_amdgcn_readfirstlane(((volatile LAS int*)(L + ST_OFF))[i]); }
__device__ __forceinline__ unsigned hw_slot() { return (unsigned)__builtin_amdgcn_s_getreg((5 << 11) | 4) & 63u; }
__device__ __forceinline__ Frame fresh(LAS unsigned char* L) {
    Frame P; P.lds = L; P.MISC = (volatile LAS unsigned*)(L + MISC_OFF);
    int wave = __builtin_amdgcn_readfirstlane(((volatile LAS int*)(L + WAVETAB_OFF))[hw_slot()]);
    int lane = (int)__builtin_amdgcn_mbcnt_hi(~0u, __builtin_amdgcn_mbcnt_lo(~0u, 0u)); asm volatile("" : "+v"(lane));
    P.wave = wave; P.lane = lane; P.tid = wave * 64 + lane; P.vcu = st_get(L, ST_VCU); P.G = st_get(L, ST_G);
    P.ws = (unsigned char*)(((unsigned long long)(unsigned)st_get(L, ST_WS_HI) << 32) | (unsigned)st_get(L, ST_WS_LO));
    return P;
}
__device__ __forceinline__ void grid_barrier(LAS unsigned char* L, int tid) {
    XcdBarrier b; b.bar = (unsigned*)(((unsigned long long)(unsigned)st_get(L, ST_BAR_HI) << 32) | (unsigned)st_get(L, ST_BAR_LO)); b.x = xb_xcc_id(); b.st = (volatile LAS unsigned*)(L + MISC_OFF) + 8;
    xcd_barrier(b, tid == 0);
}
__device__ __forceinline__ bool ph_on(LAS unsigned char* L) { const int ph = st_get(L, ST_PH); return ph >= st_get(L, ST_LO) && ph < st_get(L, ST_HI); }
__device__ __forceinline__ void ph_end(LAS unsigned char* L) {
    const int ph = st_get(L, ST_PH), lo = st_get(L, ST_LO), hi = st_get(L, ST_HI);
    const int wave = __builtin_amdgcn_readfirstlane(((volatile LAS int*)(L + WAVETAB_OFF))[hw_slot()]);
    const int tid = wave * 64 + (int)__builtin_amdgcn_mbcnt_hi(~0u, __builtin_amdgcn_mbcnt_lo(~0u, 0u));
    if (ph >= lo && ph + 1 < hi) grid_barrier(L, tid); else __syncthreads();
    if (tid == 0) ((volatile LAS int*)(L + ST_OFF))[ST_PH] = ph + 1;
    __syncthreads();
}
struct Args { const void* in[21]; float* out; unsigned char* ws; int ph_lo, ph_hi, region, pad; };
__global__ void __launch_bounds__(NWAVES * 64, 2) yoco_fwd(Args args) {
    extern __shared__ __attribute__((aligned(16))) unsigned char lds[];
    LAS unsigned char* L = (LAS unsigned char*)lds;
    {   const int tid0 = threadIdx.x;
        for (int u = tid0; u < (LDS_BYTES - LDSCTL_OFF) / 4; u += NWAVES * 64) ((LAS unsigned*)(L + LDSCTL_OFF))[u] = 0u;
        __syncthreads();
        if ((tid0 & 63) == 0) ((LAS int*)(L + WAVETAB_OFF))[hw_slot()] = tid0 >> 6;
        if (tid0 == 0) {
            LAS unsigned long long* pt = (LAS unsigned long long*)(L + PTRS_OFF);
#pragma unroll
            for (int i = 0; i < 21; ++i) pt[i] = (unsigned long long)args.in[i];
            pt[I_OUT] = (unsigned long long)args.out;
            LAS int* st = (LAS int*)(L + ST_OFF);
            const int G = gridDim.x, bx = blockIdx.x;
            unsigned* barw = (unsigned*)(args.ws + WS_CTL) + CW_BAR + args.region * XCD_BAR_WORDS;
            st[ST_PH] = 0; st[ST_L] = 0; st[ST_LO] = args.ph_lo; st[ST_HI] = args.ph_hi; st[ST_VCU] = (G % 8 == 0) ? (bx % 8) * (G / 8) + bx / 8 : bx; st[ST_G] = G; st[ST_BX] = bx;
            st[ST_WS_LO] = (int)(unsigned)(unsigned long long)args.ws; st[ST_WS_HI] = (int)(unsigned)((unsigned long long)args.ws >> 32);
            st[ST_BAR_LO] = (int)(unsigned)(unsigned long long)barw; st[ST_BAR_HI] = (int)(unsigned)((unsigned long long)barw >> 32);
            (void)xb_add(&barw[XB_XCNT(xb_xcc_id())], 1u);
        }
        __syncthreads();
    }
#ifndef YK_ONLY
#define YK_ONLY -1
#endif
#define EN(k) (YK_ONLY < 0 || YK_ONLY == (k))
#define PH_ON(k) (EN(k) && ph_on(L))
#define PH_END ph_end(L)
#define HB wsp<bf16>(P, WS_HB)
#define SUBB wsp<bf16>(P, WS_SUB)
#define X wsp<float>(P, WS_X)
    if (PH_ON(0)) { Frame P = fresh(L); ph_prologue(P); }
    PH_END;
    if (PH_ON(1)) { Frame P = fresh(L); ph_mod0(P); }
    PH_END;
    for (;;) {
        const int l = st_get(L, ST_L);
        if (l >= DEPTH) break;
        if (l < 2) {
            if (PH_ON(2)) { Frame P = fresh(L); const int bx = st_get(L, ST_BX);
                pg8::Gemm g{HB, wsp<bf16>(P, WS_WCI) + (size_t)l * 3072 * D, T, 3072, D, 0, nullptr}; pg8::StaticOrder S; S.init(T, 3072, P.G, bx);
                pg8::EpiConvIn E{wsp<bf16>(P, WS_ZB), wsp<bf16>(P, WS_GB)};
                pg8::gemm_phase<pg8::EpiConvIn, pg8::StaticOrder, true, false>(P.lds + RING_OFF, g, S, E, P.wave);
            }
            PH_END;
            if (PH_ON(3)) { Frame P = fresh(L); ph_conv(P, l); }
            PH_END;
            if (PH_ON(4)) { Frame P = fresh(L); const int bx = st_get(L, ST_BX);
                pg8::Gemm g{wsp<bf16>(P, WS_YB), wsp<bf16>(P, WS_WCO) + (size_t)l * D * D, T, D, D, 0, nullptr}; pg8::StaticOrder S; S.init(T, D, P.G, bx);
                pg8::EpiBf16 E{SUBB, D, nullptr, 0, 0, 0, 1.f};
                pg8::gemm_phase<pg8::EpiBf16, pg8::StaticOrder, true, false>(P.lds + RING_OFF, g, S, E, P.wave);
            }
            PH_END;
        } else {
            if (PH_ON(5)) { Frame P = fresh(L); const int bx = st_get(L, ST_BX);
                pg8::Gemm g{HB, wsp<bf16>(P, WS_WQ) + (size_t)(l - 2) * D * D, T, D, D, 0, nullptr}; pg8::StaticOrder S; S.init(T, D, P.G, bx);
                pg8::EpiBf16 E{wsp<bf16>(P, WS_Q), D, nullptr, 0, D, 0, attn_body::C2};
                pg8::gemm_phase<pg8::EpiBf16, pg8::StaticOrder, true, false>(P.lds + RING_OFF, g, S, E, P.wave);
            }
            PH_END;
            if (PH_ON(6)) { Frame P = fresh(L); const int bx = st_get(L, ST_BX);
                static_assert(attn_body::ATTN_LDS_BYTES <= RING_BYTES && attn_body::ATTN_PITCH == D, "attention body geometry vs frame");
                const attn_body::AttnTensors AT{(const attn_body::bf16*)wsp<bf16>(P, WS_Q), (const attn_body::bf16*)wsp<bf16>(P, WS_K), (const attn_body::bf16*)wsp<bf16>(P, WS_V), (attn_body::bf16*)wsp<bf16>(P, WS_Q), wsp<float>(P, WS_CS)};
                const attn_body::StaticOrder S(P.G, bx);
                attn_body::attn_phase<attn_body::StaticOrder>((char*)lds + RING_OFF, AT, S, P.wave);
            }
            PH_END;
            if (PH_ON(7)) { Frame P = fresh(L); const int bx = st_get(L, ST_BX);
                pg8::Gemm g{wsp<bf16>(P, WS_Q), wsp<bf16>(P, WS_WO) + (size_t)(l - 2) * D * D, T, D, D, 0, nullptr}; pg8::StaticOrder S; S.init(T, D, P.G, bx);
                pg8::EpiBf16 E{SUBB, D, nullptr, 0, 0, 0, 1.f};
                pg8::gemm_phase<pg8::EpiBf16, pg8::StaticOrder, true, false>(P.lds + RING_OFF, g, S, E, P.wave);
            }
            PH_END;
        }
        if (PH_ON(8)) { Frame P = fresh(L); ph_ln<0>(P, l, l == 0 ? inp(P, I_X) : X, X, 0u); }
        PH_END;
        if (PH_ON(9)) { Frame P = fresh(L); ph_slot(P); }
        PH_END;
        if (PH_ON(10)) { Frame P = fresh(L);
            const pg8::MoeOrder S = moe_order(P, 3);
            pg8::Gemm g{HB, wsp<bf16>(P, WS_WGU) + (size_t)l * NE * 2048 * D, NSLOT_MAX, 2048, D, (size_t)2048 * D * 2, wsp<int>(P, WS_SLOTTOK)};
            pg8::EpiSwiGLU E{wsp<bf16>(P, WS_A1), inp(P, I_EXP_B_GU) + (size_t)l * NE * 2048};
            pg8::gemm_phase<pg8::EpiSwiGLU, pg8::MoeOrder, true, true>(P.lds + RING_OFF, g, S, E, P.wave);
        }
        PH_END;
        if (PH_ON(11)) { Frame P = fresh(L);
            const pg8::MoeOrder S = moe_order(P, 2);
            pg8::Gemm g{wsp<bf16>(P, WS_A1), wsp<bf16>(P, WS_WD) + (size_t)l * NE * D * FF, NSLOT_MAX, D, FF, (size_t)D * FF * 2, nullptr};
            pg8::EpiBf16 E{wsp<bf16>(P, WS_Y2), D, inp(P, I_EXP_B_DOWN) + (size_t)l * NE * D, D, 0, 0, 1.f};
            pg8::gemm_phase<pg8::EpiBf16, pg8::MoeOrder, true, false>(P.lds + RING_OFF, g, S, E, P.wave);
        }
        PH_END;
        if (PH_ON(12)) { Frame P = fresh(L); unsigned poison = 0u;
            if (l == DEPTH - 1) { const unsigned* barw = (const unsigned*)(((unsigned long long)(unsigned)st_get(L, ST_BAR_HI) << 32) | (unsigned)st_get(L, ST_BAR_LO)); poison = (__hip_atomic_load((gu32*)(barw + XB_TMO), RLX_AGENT) != 0u) ? 1u : 0u; }
            ph_ln<1>(P, l, X, l == DEPTH - 1 ? (float*)inp(P, I_OUT) : X, poison); }
        PH_END;
        if (l == 1) {
            if (PH_ON(14)) { Frame P = fresh(L); ph_cumsum(P); }
            PH_END;
            if (PH_ON(13)) { Frame P = fresh(L); const int bx = st_get(L, ST_BX);
                pg8::Gemm g{wsp<bf16>(P, WS_HKV), wsp<bf16>(P, WS_WKV), T, 2048, D, 0, nullptr}; pg8::StaticOrder S; S.init(T, 2048, P.G, bx);
                pg8::EpiBf16 E{wsp<bf16>(P, WS_K), D, nullptr, 0, D, (size_t)(WS_V - WS_K) / 2, 1.f};
                pg8::gemm_phase<pg8::EpiBf16, pg8::StaticOrder, true, false>(P.lds + RING_OFF, g, S, E, P.wave);
            }
            PH_END;
        }
        { Frame P = fresh(L); __syncthreads(); if (P.tid == 0) ((volatile LAS int*)(L + ST_OFF))[ST_L] = l + 1; __syncthreads(); }
    }
#undef PH_ON
#undef PH_END
#undef HB
#undef SUBB
#undef X
}
constexpr int N_PHASES = 2 + 2 * 8 + 2 + 2 * 8;

#if defined(YK_CHECK)
__global__ void chk_moe(const float* w_gu, const float* b_gu, const float* w_dn, const float* b_dn, const float* w_r, const float* b_r, unsigned char* ws, float* res) {
    __shared__ float h[1024], gu[2048], a[1024], ys[1024], red[512 * 3];
    const int tid = threadIdx.x; const int t = (blockIdx.x * 509 + 7) % T; const int l = 3;
    const bf16* HB = (const bf16*)(ws + WS_HB); const int* tki = (const int*)(ws + WS_TKI); const float* tkw = (const float*)(ws + WS_TKW); const int* slot_of = (const int*)(ws + WS_SLOTOF); const bf16* Y2 = (const bf16*)(ws + WS_Y2);
    for (int i = tid; i < 1024; i += 512) { h[i] = __builtin_bit_cast(float, (unsigned)HB[(size_t)t * D + i] << 16); ys[i] = 0.f; }
    __syncthreads();
    for (int k = 0; k < 4; ++k) {
        const int e = tki[t * 4 + k]; const float w = tkw[t * 4 + k];
        const float* wg = w_gu + ((size_t)l * NE + e) * D * 2048; const float* bg = b_gu + ((size_t)l * NE + e) * 2048;
        for (int c = tid; c < 2048; c += 512) { float acc = bg[c]; for (int kk = 0; kk < 1024; ++kk) acc += h[kk] * wg[(size_t)kk * 2048 + c]; gu[c] = acc; }
        __syncthreads();
        for (int n = tid; n < 1024; n += 512) { const float g = fminf(gu[n], 7.f), u = fminf(fmaxf(gu[1024 + n], -7.f), 7.f); a[n] = g / (1.f + expf(-1.702f * g)) * (u + 1.f); }
        __syncthreads();
        const float* wd = w_dn + ((size_t)l * NE + e) * FF * D; const float* bd = b_dn + ((size_t)l * NE + e) * D;
        for (int c = tid; c < 1024; c += 512) { float acc = bd[c]; for (int f = 0; f < 1024; ++f) acc += a[f] * wd[(size_t)f * D + c]; ys[c] += w * acc; }
        __syncthreads();
    }
    float dot = 0.f, nm = 0.f, nn = 0.f;
    for (int c = tid; c < 1024; c += 512) { float m = 0.f; for (int k = 0; k < 4; ++k) m += tkw[t * 4 + k] * __builtin_bit_cast(float, (unsigned)Y2[(size_t)slot_of[t * 4 + k] * D + c] << 16);
        dot += m * ys[c]; nm += m * m; nn += ys[c] * ys[c]; }
    red[tid] = dot; red[512 + tid] = nm; red[1024 + tid] = nn; __syncthreads();
    if (tid == 0) { float s0 = 0, s1 = 0, s2 = 0; for (int i = 0; i < 512; ++i) { s0 += red[i]; s1 += red[512 + i]; s2 += red[1024 + i]; } atomicAdd(res + 0, s0); atomicAdd(res + 1, s1); atomicAdd(res + 2, s2); }
    __syncthreads();
    if (tid < 32) { float acc = b_r[l * NE + tid]; for (int kk = 0; kk < 1024; ++kk) acc += h[kk] * w_r[((size_t)l * D + kk) * NE + tid]; gu[tid] = acc; }
    __syncthreads();
    if (tid == 0) { int match = 0; float tmp[32]; for (int i = 0; i < 32; ++i) tmp[i] = gu[i];
        for (int k = 0; k < 4; ++k) { int bi = 0; for (int i = 1; i < 32; ++i) if (tmp[i] > tmp[bi]) bi = i; tmp[bi] = -1e30f; for (int q = 0; q < 4; ++q) if (tki[t * 4 + q] == bi) ++match; }
        atomicAdd(res + 3, (float)match); atomicAdd(res + 4, 4.0f); }
}
__global__ void chk_ln1(const float* ln_g, const float* ln_b, unsigned char* ws, const float* out, float* res) {
    __shared__ float v[1024], red[512 * 3];
    const int tid = threadIdx.x; const int t = (blockIdx.x * 509 + 7) % T; const int l = 3, b = t >> 13;
    const float* Xb = (const float*)(ws + WS_X); const float* MOD = (const float*)(ws + WS_MOD); const float* tkw = (const float*)(ws + WS_TKW); const int* slot_of = (const int*)(ws + WS_SLOTOF); const bf16* Y2 = (const bf16*)(ws + WS_Y2);
    for (int c = tid; c < 1024; c += 512) { float m = 0.f; for (int k = 0; k < 4; ++k) m += tkw[t * 4 + k] * __builtin_bit_cast(float, (unsigned)Y2[(size_t)slot_of[t * 4 + k] * D + c] << 16);
        const float gate = MOD[((size_t)(l * 2 + 1) * 4 + b) * 3072 + 2048 + c]; v[c] = DN_ALPHA * Xb[(size_t)t * D + c] + (1.f + gate) * m; }
    __syncthreads();
    float s = 0.f; for (int c = 0; c < 1024; ++c) s += v[c]; const float mean = s / 1024.f; float q = 0.f; for (int c = 0; c < 1024; ++c) q += (v[c] - mean) * (v[c] - mean); const float rstd = 1.f / sqrtf(q / 1024.f + LN_EPS);
    float dot = 0.f, nm = 0.f, nn = 0.f;
    for (int c = tid; c < 1024; c += 512) { const float y = (v[c] - mean) * rstd * ln_g[(l * 2 + 1) * D + c] + ln_b[(l * 2 + 1) * D + c]; const float m = out[(size_t)t * D + c]; dot += m * y; nm += m * m; nn += y * y; }
    red[tid] = dot; red[512 + tid] = nm; red[1024 + tid] = nn; __syncthreads();
    if (tid == 0) { float s0 = 0, s1 = 0, s2 = 0; for (int i = 0; i < 512; ++i) { s0 += red[i]; s1 += red[512 + i]; s2 += red[1024 + i]; } atomicAdd(res + 8, s0); atomicAdd(res + 9, s1); atomicAdd(res + 10, s2); }
}
__global__ void chk_scale(float* out, const float* res, int n) {
    const float dot = res[0], nm = res[1], nn = res[2];
    float f = 1.f;
    if (YK_CHECK == 1) f = 1.f + dot / nn;
    if (YK_CHECK == 2) f = 1.f + sqrtf(fmaxf(nm - dot * dot / nn, 0.f) / nn);
    if (YK_CHECK == 3) f = 1.f + res[3] / res[4];
    if (YK_CHECK == 4) f = 1.f + sqrtf(fmaxf(res[9] + res[10] - 2.f * res[8], 0.f) / res[10]);
    for (int i = blockIdx.x * blockDim.x + threadIdx.x; i < n; i += gridDim.x * blockDim.x) out[i] *= f;
}
#endif
#ifndef YK_N_LAUNCHES
#define YK_N_LAUNCHES 1
#endif
extern "C" void kernel_launch(void* const* d_in, const int* in_sizes, int n_in, void* d_out, int out_size, void* d_ws, size_t ws_size, hipStream_t stream) {
    static int grid = 0;
    if (grid == 0) {
        if (n_in != 21 || in_sizes[0] != T * D || out_size != T * D || ws_size < WS_END) { fprintf(stderr, "kernel_launch: unexpected problem: n_in %d in0 %d out %d ws %zu (need %zu)\n", n_in, n_in > 0 ? in_sizes[0] : -1, out_size, ws_size, (size_t)WS_END); grid = -1; return; }
        int dev = 0, cus = 0, per_cu = 0;
        if (hipGetDevice(&dev) != hipSuccess || hipDeviceGetAttribute(&cus, hipDeviceAttributeMultiprocessorCount, dev) != hipSuccess) { grid = -1; return; }
        if (hipFuncSetAttribute((const void*)yoco_fwd, hipFuncAttributeMaxDynamicSharedMemorySize, LDS_BYTES) != hipSuccess) { fprintf(stderr, "kernel_launch: hipFuncSetAttribute failed\n"); grid = -1; return; }
        if (hipOccupancyMaxActiveBlocksPerMultiprocessor(&per_cu, (const void*)yoco_fwd, NWAVES * 64, LDS_BYTES) != hipSuccess || per_cu < 1) { fprintf(stderr, "kernel_launch: occupancy query says %d\n", per_cu); }
        (void)hipGetLastError();
        grid = cus;
    }
    if (grid < 0) return;
    (void)hipMemsetAsync((char*)d_ws + WS_CTL, 0, CTL_ZERO_BYTES, stream);
    Args a{};
    for (int i = 0; i < 21; ++i) a.in[i] = d_in[i];
    a.out = (float*)d_out; a.ws = (unsigned char*)d_ws;
#if YK_N_LAUNCHES == 1
    a.ph_lo = 0; a.ph_hi = N_PHASES; a.region = 0; a.pad = 0;
    hipLaunchKernelGGL(yoco_fwd, dim3(grid), dim3(NWAVES * 64), LDS_BYTES, stream, a);
#else
    for (int p = 0; p < N_PHASES; ++p) { a.ph_lo = p; a.ph_hi = p + 1; a.region = p; a.pad = 0;
        hipLaunchKernelGGL(yoco_fwd, dim3(grid), dim3(NWAVES * 64), LDS_BYTES, stream, a); }
#endif
#if defined(YK_CHECK)
    {   float* res = (float*)((char*)d_ws + WS_CTL + 512 * 1024);
        hipLaunchKernelGGL(chk_moe, dim3(64), dim3(512), 0, stream, (const float*)d_in[17], (const float*)d_in[18], (const float*)d_in[19], (const float*)d_in[20], (const float*)d_in[15], (const float*)d_in[16], (unsigned char*)d_ws, res);
        hipLaunchKernelGGL(chk_ln1, dim3(64), dim3(512), 0, stream, (const float*)d_in[13], (const float*)d_in[14], (unsigned char*)d_ws, (const float*)d_out, res);
        hipLaunchKernelGGL(chk_scale, dim3(1024), dim3(256), 0, stream, (float*)d_out, (const float*)res, T * D); }
#endif
    const hipError_t le = hipPeekAtLastError();
    if (le != hipSuccess) fprintf(stderr, "kernel_launch: launch failed: %s\n", hipGetErrorName(le));
}
```

```cpp
#include <hip/hip_runtime.h>
#include <cstdio>
#include <cstdint>
namespace pg8 {
#define PG8_LAS __attribute__((address_space(3)))
typedef unsigned short bf16_t;
typedef short bf16x8 __attribute__((ext_vector_type(8)));
typedef float f32x4 __attribute__((ext_vector_type(4)));
typedef unsigned u32x4 __attribute__((ext_vector_type(4)));
typedef int i32x4v __attribute__((ext_vector_type(4)));
typedef int i32x8v __attribute__((ext_vector_type(8)));
constexpr int BM = 256, BK = 64, HALF = 128, HTB = HALF * BK * 2  , STAGE_BYTES = 8 * HTB, NXCD = 8, WGM = 8;

__host__ __device__ __forceinline__ int lds_byte(int r, int c) { const int st = (r >> 4) * 2 + (c >> 5), rr = r & 15, cc = c & 31, ob = rr * 64 + cc * 2; return st * 1024 + (ob ^ (((ob >> 9) & 1) << 5)); }
__host__ __device__ __forceinline__ void stage_rc(int b, int& R, int& C) { const int st = b / 1024, sb = b % 1024, swz = sb ^ (((sb >> 9) & 1) << 5); R = (st >> 1) * 16 + swz / 64; C = (st & 1) * 32 + (swz % 64) / 2; }
__host__ __device__ __forceinline__ int perm32(int rho) { const int n = rho >> 4, i = rho & 15; return 8 * (i >> 2) + 4 * n + (i & 3); }

struct Unit { int pm, pn, e; };
struct Gemm { const bf16_t* A; const bf16_t* Bt; int M, N, K; size_t bstride; const int* rowidx; int dbg; int sA, sB; };

struct StaticOrder {
    int nM, nN, nwg, G, c;
    __host__ __device__ void init(int M, int N, int G_, int c_) { nM = M / BM; nN = N / BM; nwg = nM * nN; G = G_; c = c_; }
    __host__ __device__ bool next(int i, Unit& u) const {
        const long L = (long)i * G + c; if (L >= nwg) return false;
        int wgid = (int)L; { const int q = nwg / NXCD, r = nwg % NXCD, xcd = wgid % NXCD, off = wgid / NXCD; wgid = (xcd < r ? xcd * (q + 1) : r * (q + 1) + (xcd - r) * q) + off; }
        const int nig = WGM * nN, gid = wgid / nig, fm = gid * WGM, gsz = (nM - fm) < WGM ? (nM - fm) : WGM;
        u.pm = fm + ((wgid % nig) % gsz); u.pn = (wgid % nig) / gsz; u.e = 0; return true;
    }
};
struct MoeOrder {
    int mode, u0, u1, sh, x, c, nx, NT, rev; const PG8_LAS int* tile_e;
    __device__ __forceinline__ bool next(int i, Unit& u) const {
        if (mode == 0) { const int q = u0 + i; if (q >= u1) return false; u.pm = q >> sh; u.pn = q & ((1 << sh) - 1); u.e = tile_e[u.pm]; return true; }
        const int gi = x + nx * i;
        const int mt = (gi << (5 - sh)) + (c >> sh); if (mt >= NT) return false; u.pm = mt; u.pn = c & ((1 << sh) - 1); u.e = tile_e[mt]; return true;
    }
};

#define PG8_GAS __attribute__((address_space(1)))
__device__ __forceinline__ unsigned cvt_pk_bf16(float lo, float hi) { unsigned r; asm volatile("v_cvt_pk_bf16_f32 %0, %1, %2" : "=v"(r) : "v"(lo), "v"(hi)); return r; }

struct EpiBf16 {
    static constexpr bool PERM = true, WIDE16 = false; static constexpr int NSTORE = 16;
    bf16_t* O; int ldc; const float* bias; int bias_estride; int split_cols; size_t split_stride; float scale0; int nt_store;
    static constexpr bool HAS_PRE = true;
    __device__ __forceinline__ bool want_pre() const { return bias != nullptr; }
    __device__ __forceinline__ void pre(const Unit& u, PG8_LAS unsigned char* tab, int lane) const {
        __builtin_amdgcn_global_load_lds((const unsigned*)(bias + (size_t)u.e * bias_estride + u.pn * BM + 4 * lane), (PG8_LAS unsigned*)tab, 16, 0, 0); }
    __device__ __forceinline__ void init(f32x4 (&acc)[2][2][4][2], int wc, int fq, const PG8_LAS float* tab) const {
        f32x4 bv[2][2];
#pragma unroll
        for (int bj = 0; bj < 2; ++bj)
#pragma unroll
            for (int n = 0; n < 2; ++n) bv[bj][n] = bias ? *(const PG8_LAS f32x4*)(tab + wc * 32 + 8 * fq + bj * HALF + 4 * n) : (f32x4){0.f, 0.f, 0.f, 0.f};
#pragma unroll
        for (int a = 0; a < 2; ++a)
#pragma unroll
            for (int bj = 0; bj < 2; ++bj)
#pragma unroll
                for (int m = 0; m < 4; ++m)
#pragma unroll
                    for (int n = 0; n < 2; ++n) acc[a][bj][m][n] = bv[bj][n];
    }
    __device__ __forceinline__ void operator()(const f32x4 (&acc)[2][2][4][2], const Unit& u, int wr, int wc, int fr, int fq, const PG8_LAS float* tab) const {
        const int row0 = u.pm * BM + wr * 64 + fr; int colt = u.pn * BM; bf16_t* base = O;
        float sc = 1.f; if (split_cols) { const int t = colt / split_cols; base += (size_t)t * split_stride; colt -= t * split_cols; if (t == 0) sc = scale0; }
        const int col0 = colt + wc * 32 + 8 * fq;
#pragma unroll
        for (int ai = 0; ai < 2; ++ai)
#pragma unroll
            for (int m = 0; m < 4; ++m) { bf16_t* rowp = base + (size_t)(row0 + ai * HALF + m * 16) * ldc + col0;
#pragma unroll
                for (int bj = 0; bj < 2; ++bj) { f32x4 v0 = acc[ai][bj][m][0], v1 = acc[ai][bj][m][1];
                    v0 = v0 * sc; v1 = v1 * sc; u32x4 w; w.x = cvt_pk_bf16(v0[0], v0[1]); w.y = cvt_pk_bf16(v0[2], v0[3]); w.z = cvt_pk_bf16(v1[0], v1[1]); w.w = cvt_pk_bf16(v1[2], v1[3]);
                    if (nt_store) __builtin_nontemporal_store(w, (u32x4*)(rowp + bj * HALF)); else *(PG8_GAS u32x4*)(rowp + bj * HALF) = w; } }
    }
};
template <bool OUT8> struct EpiBias8 {
    static constexpr bool PERM = true, WIDE16 = OUT8; static constexpr int NSTORE = OUT8 ? 8 : 16;
    bf16_t* O; const float* bias; int bias_estride;
    static constexpr bool HAS_PRE = true;
    __device__ __forceinline__ bool want_pre() const { return true; }
    __device__ __forceinline__ void pre(const Unit& u, PG8_LAS unsigned char* tab, int lane) const {
        __builtin_amdgcn_global_load_lds((const unsigned*)(bias + (size_t)u.e * bias_estride + u.pn * BM + 4 * lane), (PG8_LAS unsigned*)tab, 16, 0, 0); }
    __device__ __forceinline__ void init(f32x4 (&acc)[2][2][4][2], int wc, int fq, const PG8_LAS float* tab) const {
        f32x4 bv[2][2];
#pragma unroll
        for (int bj = 0; bj < 2; ++bj)
#pragma unroll
            for (int n = 0; n < 2; ++n) bv[bj][n] = OUT8 ? *(const PG8_LAS f32x4*)(tab + 64 * wc + 16 * fq + 8 * bj + 4 * n) : *(const PG8_LAS f32x4*)(tab + wc * 32 + 8 * fq + bj * HALF + 4 * n);
#pragma unroll
        for (int a = 0; a < 2; ++a)
#pragma unroll
            for (int bj = 0; bj < 2; ++bj)
#pragma unroll
                for (int m = 0; m < 4; ++m)
#pragma unroll
                    for (int n = 0; n < 2; ++n) acc[a][bj][m][n] = bv[bj][n];
    }
    __device__ __forceinline__ void operator()(const f32x4 (&acc)[2][2][4][2], const Unit& u, int wr, int wc, int fr, int fq, const PG8_LAS float* tab) const {
        const int row0 = u.pm * BM + wr * 64 + fr;
        if constexpr (OUT8) {
            const int cl = 64 * wc + 16 * fq;
#pragma unroll
            for (int ai = 0; ai < 2; ++ai)
#pragma unroll
                for (int m = 0; m < 4; ++m) { int w[4];
#pragma unroll
                    for (int bj = 0; bj < 2; ++bj)
#pragma unroll
                        for (int n = 0; n < 2; ++n) { const f32x4 v = acc[ai][bj][m][n]; int t = 0; t = __builtin_amdgcn_cvt_pk_fp8_f32(v[0], v[1], t, false); t = __builtin_amdgcn_cvt_pk_fp8_f32(v[2], v[3], t, true); w[2 * bj + n] = t; }
                    *(PG8_GAS u32x4*)((unsigned char*)O + (size_t)(row0 + ai * HALF + m * 16) * 1024 + u.pn * BM + cl) = (u32x4){(unsigned)w[0], (unsigned)w[1], (unsigned)w[2], (unsigned)w[3]}; }
        } else {
            const int col0 = u.pn * BM + wc * 32 + 8 * fq;
#pragma unroll
            for (int ai = 0; ai < 2; ++ai)
#pragma unroll
                for (int m = 0; m < 4; ++m) { const size_t ro = (size_t)(row0 + ai * HALF + m * 16) * 1024 + col0;
#pragma unroll
                    for (int bj = 0; bj < 2; ++bj) { const f32x4 v0 = acc[ai][bj][m][0], v1 = acc[ai][bj][m][1];
                        u32x4 w; w.x = cvt_pk_bf16(v0[0], v0[1]); w.y = cvt_pk_bf16(v0[2], v0[3]); w.z = cvt_pk_bf16(v1[0], v1[1]); w.w = cvt_pk_bf16(v1[2], v1[3]);
                        *(PG8_GAS u32x4*)(O + ro + bj * HALF) = w; } }
        }
    }
};
struct EpiConvIn {
    static constexpr bool PERM = true, WIDE16 = false; static constexpr int NSTORE = 8;
    bf16_t* Z; bf16_t* GB;
    static constexpr bool HAS_PRE = false;
    __device__ __forceinline__ bool want_pre() const { return false; }
    __device__ __forceinline__ void pre(const Unit&, PG8_LAS unsigned char*, int) const {}
    __device__ __forceinline__ void init(f32x4 (&)[2][2][4][2], int, int, const PG8_LAS float*) const {}
    __device__ __forceinline__ void operator()(const f32x4 (&acc)[2][2][4][2], const Unit& u, int wr, int wc, int fr, int fq, const PG8_LAS float*) const {
        const int row0 = u.pm * BM + wr * 64 + fr;
        if (u.pn < 8) {
            const int col0 = u.pn * HALF + wc * 32 + 8 * fq;
#pragma unroll
            for (int ai = 0; ai < 2; ++ai)
#pragma unroll
                for (int m = 0; m < 4; ++m) { bf16_t* rowp = Z + (size_t)(row0 + ai * HALF + m * 16) * 1024 + col0;
                    const f32x4 v0 = acc[ai][0][m][0] * acc[ai][1][m][0], v1 = acc[ai][0][m][1] * acc[ai][1][m][1];
                    u32x4 w; w.x = cvt_pk_bf16(v0[0], v0[1]); w.y = cvt_pk_bf16(v0[2], v0[3]); w.z = cvt_pk_bf16(v1[0], v1[1]); w.w = cvt_pk_bf16(v1[2], v1[3]);
                    *(PG8_GAS u32x4*)rowp = w; }
        } else {
            const int col0 = (u.pn - 8) * BM + wc * 32 + 8 * fq;
#pragma unroll
            for (int ai = 0; ai < 2; ++ai)
#pragma unroll
                for (int m = 0; m < 4; ++m) { bf16_t* rowp = GB + (size_t)(row0 + ai * HALF + m * 16) * 1024 + col0;
#pragma unroll
                    for (int bj = 0; bj < 2; ++bj) { const f32x4 v0 = acc[ai][bj][m][0], v1 = acc[ai][bj][m][1];
                        u32x4 w; w.x = cvt_pk_bf16(v0[0], v0[1]); w.y = cvt_pk_bf16(v0[2], v0[3]); w.z = cvt_pk_bf16(v1[0], v1[1]); w.w = cvt_pk_bf16(v1[2], v1[3]);
                        *(PG8_GAS u32x4*)(rowp + bj * HALF) = w; } }
        }
    }
};
typedef float f32x2 __attribute__((ext_vector_type(2)));
__device__ __forceinline__ f32x2 pk_add(f32x2 a, f32x2 b) { f32x2 d; asm("v_pk_add_f32 %0, %1, %2" : "=v"(d) : "v"(a), "v"(b)); return d; }
__device__ __forceinline__ f32x2 pk_mul(f32x2 a, f32x2 b) { f32x2 d; asm("v_pk_mul_f32 %0, %1, %2" : "=v"(d) : "v"(a), "v"(b)); return d; }
__device__ __forceinline__ float min_sv(float c, float a) { float d; asm("v_min_f32 %0, %1, %2" : "=v"(d) : "s"(c), "v"(a)); return d; }
template <bool OUT8> struct EpiSwiGLU {
    static constexpr bool PERM = true, WIDE16 = false; static constexpr int NSTORE = 8;
    bf16_t* O; const float* bgu;
    static constexpr bool HAS_PRE = true;
    __device__ __forceinline__ bool want_pre() const { return true; }
    __device__ __forceinline__ void pre(const Unit& u, PG8_LAS unsigned char* tab, int lane) const {
        __builtin_amdgcn_global_load_lds((const unsigned*)(bgu + (size_t)u.e * 2048 + (lane >> 5) * 1024 + u.pn * HALF + 4 * (lane & 31)), (PG8_LAS unsigned*)tab, 16, 0, 0); }
    __device__ __forceinline__ void init(f32x4 (&acc)[2][2][4][2], int wc, int fq, const PG8_LAS float* tab) const {
        f32x4 bg[2], bu[2];
#pragma unroll
        for (int n = 0; n < 2; ++n) { bg[n] = *(const PG8_LAS f32x4*)(tab + wc * 32 + 8 * fq + 4 * n); bu[n] = *(const PG8_LAS f32x4*)(tab + HALF + wc * 32 + 8 * fq + 4 * n) + 1.0f; }
#pragma unroll
        for (int a = 0; a < 2; ++a)
#pragma unroll
            for (int m = 0; m < 4; ++m)
#pragma unroll
                for (int n = 0; n < 2; ++n) { acc[a][0][m][n] = bg[n]; acc[a][1][m][n] = bu[n]; }
    }
    __device__ __forceinline__ void operator()(const f32x4 (&acc)[2][2][4][2], const Unit& u, int wr, int wc, int fr, int fq, const PG8_LAS float* tab) const {
        const int row0 = u.pm * BM + wr * 64 + fr, col0 = u.pn * HALF + wc * 32 + 8 * fq;
#define PG8_SWIGLU_ROW(ai, m, r) do { \
                _Pragma("unroll") for (int n = 0; n < 2; ++n) { \
                    _Pragma("unroll") for (int h = 0; h < 2; ++h) { \
                        const f32x2 ag = h ? __builtin_shufflevector(acc[ai][0][m][n], acc[ai][0][m][n], 2, 3) : __builtin_shufflevector(acc[ai][0][m][n], acc[ai][0][m][n], 0, 1); \
                        const f32x2 au = h ? __builtin_shufflevector(acc[ai][1][m][n], acc[ai][1][m][n], 2, 3) : __builtin_shufflevector(acc[ai][1][m][n], acc[ai][1][m][n], 0, 1); \
                        f32x2 g = ag, u1 = au;     \
                        g[0] = min_sv(7.0f, g[0]); g[1] = min_sv(7.0f, g[1]);     \
                        u1[0] = __builtin_amdgcn_fmed3f(u1[0], -6.0f, 8.0f); u1[1] = __builtin_amdgcn_fmed3f(u1[1], -6.0f, 8.0f); \
                        const f32x2 t = pk_mul(g, (f32x2){-1.702f * 1.4426950408889634f, -1.702f * 1.4426950408889634f}); \
                        f32x2 ex; ex[0] = __builtin_amdgcn_exp2f(t[0]); ex[1] = __builtin_amdgcn_exp2f(t[1]); \
                        const f32x2 den = ex + 1.0f;     \
                        f32x2 rc; rc[0] = __builtin_amdgcn_rcpf(den[0]); rc[1] = __builtin_amdgcn_rcpf(den[1]); \
                        const f32x2 o = pk_mul(g, u1) * rc; \
                        r[n][2 * h] = o[0]; r[n][2 * h + 1] = o[1]; } } } while (0)
        if constexpr (OUT8) {
#pragma unroll
            for (int ai = 0; ai < 2; ++ai)
#pragma unroll
                for (int mp = 0; mp < 2; ++mp) { unsigned w[2][2];
#pragma unroll
                    for (int mm = 0; mm < 2; ++mm) { f32x4 r[2]; PG8_SWIGLU_ROW(ai, 2 * mp + mm, r);
                        int w0 = 0, w1 = 0; w0 = __builtin_amdgcn_cvt_pk_fp8_f32(r[0][0], r[0][1], w0, false); w0 = __builtin_amdgcn_cvt_pk_fp8_f32(r[0][2], r[0][3], w0, true);
                        w1 = __builtin_amdgcn_cvt_pk_fp8_f32(r[1][0], r[1][1], w1, false); w1 = __builtin_amdgcn_cvt_pk_fp8_f32(r[1][2], r[1][3], w1, true);
                        w[mm][0] = (unsigned)w0; w[mm][1] = (unsigned)w1; }
                    const auto s0 = __builtin_amdgcn_permlane16_swap(w[0][0], w[1][0], false, false);
                    const auto s1 = __builtin_amdgcn_permlane16_swap(w[0][1], w[1][1], false, false);
                    const int rowx = row0 + ai * HALF + (2 * mp + (fq & 1)) * 16;
                    *(PG8_GAS u32x4*)((unsigned char*)O + (size_t)rowx * 1024 + u.pn * HALF + wc * 32 + 16 * (fq >> 1)) = (u32x4){s0[0], s1[0], s0[1], s1[1]}; }
        } else {
#pragma unroll
            for (int ai = 0; ai < 2; ++ai)
#pragma unroll
                for (int m = 0; m < 4; ++m) { bf16_t* rowp = O + (size_t)(row0 + ai * HALF + m * 16) * 1024 + col0;
                    f32x4 r[2]; PG8_SWIGLU_ROW(ai, m, r);
                    u32x4 w; w.x = cvt_pk_bf16(r[0][0], r[0][1]); w.y = cvt_pk_bf16(r[0][2], r[0][3]); w.z = cvt_pk_bf16(r[1][0], r[1][1]); w.w = cvt_pk_bf16(r[1][2], r[1][3]);
                    *(PG8_GAS u32x4*)rowp = w; }
        }
#undef PG8_SWIGLU_ROW
    }
};

__device__ __forceinline__ int fresh_lane() { int l = (int)__builtin_amdgcn_mbcnt_hi(~0u, __builtin_amdgcn_mbcnt_lo(~0u, 0u)); asm volatile("" : "+v"(l)); return l; }
__device__ __forceinline__ void load4_sync(const int* p0, const int* p1, const int* p2, const int* p3, int& a, int& b, int& c, int& d) {
    asm volatile("global_load_dword %0, %4, off\n\tglobal_load_dword %1, %5, off\n\tglobal_load_dword %2, %6, off\n\tglobal_load_dword %3, %7, off\n\ts_waitcnt vmcnt(0)"
                 : "=&v"(a), "=&v"(b), "=&v"(c), "=&v"(d) : "v"(p0), "v"(p1), "v"(p2), "v"(p3) : "memory");
}

template <class Epi, class Sched, bool ALIGN_EPI, bool GATHER, bool FP8 = false>
__device__ __forceinline__ void gemm_phase(PG8_LAS unsigned char* lds, const Gemm g, const Sched& S, const Epi& E, const int wid_in, PG8_LAS unsigned char* etab) {
    int lane_ = (int)__builtin_amdgcn_mbcnt_hi(~0u, __builtin_amdgcn_mbcnt_lo(~0u, 0u)); asm volatile("" : "+v"(lane_));
    const int wid = __builtin_amdgcn_readfirstlane(wid_in), lane = lane_, tid = wid * 64 + lane, wr = wid >> 2, wc = wid & 3, fr = lane & 15, fq = lane >> 4;
    const int K = g.K, RP = FP8 ? K : 2 * K, nt = RP / (BK * 2);
    unsigned voffA[2], voffB[2];
#pragma unroll
    for (int i = 0; i < 2; ++i) { int R, C; stage_rc(tid * 16 + i * 8192, R, C);
        const int rho_ = R & 31; const int Rb = Epi::WIDE16 ? (64 * (R >> 5) + 16 * ((rho_ & 15) >> 2) + 4 * (rho_ >> 4) + (rho_ & 3)) : Epi::PERM ? ((R & ~31) + perm32(rho_)) : R;
        voffA[i] = (unsigned)(R * RP + 2 * C); voffB[i] = (unsigned)(Rb * RP + 2 * C); }
    const size_t kstep = (size_t)(BK * 2);
    const size_t hstep = (size_t)HALF * RP;
    const size_t hstepB = Epi::WIDE16 ? (size_t)8 * RP : hstep;
    const size_t tstep = 2 * hstep;
    const unsigned ldsw = (unsigned)wid * 1024u;
    const int aoff = lds_byte(wr * 64 + fr, fq * 8), boff = lds_byte(wc * 32 + fr, fq * 8);
#define PG8_SA(b, h) (((b) * 2 + (h)) * HTB)
#define PG8_SB(b, h) ((4 + (b) * 2 + (h)) * HTB)
#define PG8_STAGE(bufoff, gbase, voff) do { _Pragma("unroll") for (int _i = 0; _i < 2; ++_i) \
        __builtin_amdgcn_global_load_lds((const unsigned*)((const char*)(gbase) + (voff)[_i]), (PG8_LAS unsigned*)(lds + (bufoff) + ldsw + _i * 8192), 16, 0, 0); } while (0)
#define PG8_STAGE_A(bufoff, base, h, nx) do { if constexpr (GATHER) { PG8_STAGE(bufoff, base, gA[h]); } \
        else { PG8_STAGE(bufoff, (base) + (h) * hstep, voffA); } } while (0)
#define PG8_LDA(dst, b, h) do { _Pragma("unroll") for (int m = 0; m < 4; ++m) { const i32x4v lo_ = *(const PG8_LAS i32x4v*)(lds + PG8_SA(b, h) + aoff + m * 2048), hi_ = *(const PG8_LAS i32x4v*)(lds + PG8_SA(b, h) + aoff + m * 2048 + 1024); \
        dst[m] = __builtin_shufflevector(lo_, hi_, 0, 1, 2, 3, 4, 5, 6, 7); } } while (0)
#define PG8_LDB(dst, b, h) do { _Pragma("unroll") for (int n = 0; n < 2; ++n) { const i32x4v lo_ = *(const PG8_LAS i32x4v*)(lds + PG8_SB(b, h) + boff + n * 2048), hi_ = *(const PG8_LAS i32x4v*)(lds + PG8_SB(b, h) + boff + n * 2048 + 1024); \
        dst[n] = __builtin_shufflevector(lo_, hi_, 0, 1, 2, 3, 4, 5, 6, 7); } } while (0)
#define PG8_HALF(x, k) __builtin_bit_cast(bf16x8, __builtin_shufflevector(x, x, 4 * (k), 4 * (k) + 1, 4 * (k) + 2, 4 * (k) + 3))
#define PG8_MMA(ai, bj, At, Bt) do { __builtin_amdgcn_s_setprio(1); _Pragma("unroll") for (int m = 0; m < 4; ++m) _Pragma("unroll") for (int n = 0; n < 2; ++n) { \
        if constexpr (FP8) { acc[ai][bj][m][n] = __builtin_amdgcn_mfma_scale_f32_16x16x128_f8f6f4(Bt[n], At[m], acc[ai][bj][m][n], 0, 0, 0, g.sB, 0, g.sA); } \
        else { acc[ai][bj][m][n] = __builtin_amdgcn_mfma_f32_16x16x32_bf16(PG8_HALF(Bt[n], 0), PG8_HALF(At[m], 0), acc[ai][bj][m][n], 0, 0, 0); \
               acc[ai][bj][m][n] = __builtin_amdgcn_mfma_f32_16x16x32_bf16(PG8_HALF(Bt[n], 1), PG8_HALF(At[m], 1), acc[ai][bj][m][n], 0, 0, 0); } } \
        __builtin_amdgcn_s_setprio(0); } while (0)
#define PG8_WAIT_V(n) asm volatile("s_waitcnt vmcnt(" #n ")" ::: "memory")
#define PG8_WAIT_L(n) asm volatile("s_waitcnt lgkmcnt(" #n ")" ::: "memory")
#define PG8_BAR __builtin_amdgcn_s_barrier()
#define PG8_SCHED __builtin_amdgcn_sched_barrier(0)
    Unit cur, nxt; int ui = 0;
    if (!S.next(0, cur)) return;
#define PG8_UNI(u_) do { u_.pm = __builtin_amdgcn_readfirstlane(u_.pm); u_.pn = __builtin_amdgcn_readfirstlane(u_.pn); u_.e = __builtin_amdgcn_readfirstlane(u_.e); } while (0)
#define PG8_APM(u_) ((g.dbg & 2) ? 0 : u_.pm)
#define PG8_BOFF(u_) ((g.dbg & 1) ? (size_t)0 : (size_t)u_.e * g.bstride + (size_t)u_.pn * tstep)
    PG8_UNI(cur);
    unsigned gA[2][2];
#define PG8_GLOAD(dst, pm_) do { const int* _ri = g.rowidx + (size_t)(pm_) * BM; int _t0, _t1, _t2, _t3, _R0, _C0, _R1, _C1; const int _tid = wid * 64 + (int)__builtin_amdgcn_mbcnt_hi(~0u, __builtin_amdgcn_mbcnt_lo(~0u, 0u)); stage_rc(_tid * 16, _R0, _C0); stage_rc(_tid * 16 + 8192, _R1, _C1); \
        load4_sync(_ri + _R0, _ri + _R1, _ri + HALF + _R0, _ri + HALF + _R1, _t0, _t1, _t2, _t3); \
        dst[0][0] = (unsigned)_t0 * (unsigned)RP + (unsigned)_C0 * 2u; dst[0][1] = (unsigned)_t1 * (unsigned)RP + (unsigned)_C1 * 2u; \
        dst[1][0] = (unsigned)_t2 * (unsigned)RP + (unsigned)_C0 * 2u; dst[1][1] = (unsigned)_t3 * (unsigned)RP + (unsigned)_C1 * 2u; } while (0)
#define PG8_ILOAD(dst, tab_) do { const PG8_LAS int* _it = (const PG8_LAS int*)(tab_); int _R0, _C0, _R1, _C1; const int _tid = wid * 64 + (int)__builtin_amdgcn_mbcnt_hi(~0u, __builtin_amdgcn_mbcnt_lo(~0u, 0u)); stage_rc(_tid * 16, _R0, _C0); stage_rc(_tid * 16 + 8192, _R1, _C1); \
        const int _t0 = _it[_R0], _t1 = _it[_R1], _t2 = _it[HALF + _R0], _t3 = _it[HALF + _R1]; \
        dst[0][0] = (unsigned)_t0 * (unsigned)RP + (unsigned)_C0 * 2u; dst[0][1] = (unsigned)_t1 * (unsigned)RP + (unsigned)_C1 * 2u; \
        dst[1][0] = (unsigned)_t2 * (unsigned)RP + (unsigned)_C0 * 2u; dst[1][1] = (unsigned)_t3 * (unsigned)RP + (unsigned)_C1 * 2u; } while (0)
    if constexpr (GATHER) { PG8_GLOAD(gA, PG8_APM(cur)); }
    else { gA[0][0] = gA[0][1] = gA[1][0] = gA[1][1] = 0u; }
    const bool want_pre = Epi::HAS_PRE && E.want_pre();
    if (want_pre && wid == 0) E.pre(cur, etab, fresh_lane());
    f32x4 acc[2][2][4][2];
#pragma unroll
    for (int a = 0; a < 2; ++a)
#pragma unroll
        for (int b = 0; b < 2; ++b)
#pragma unroll
            for (int m = 0; m < 4; ++m)
#pragma unroll
                for (int n = 0; n < 2; ++n) acc[a][b][m][n] = (f32x4){0.f, 0.f, 0.f, 0.f};
    i32x8v At[4], B0[2], B1[2];
    const char* cA = GATHER ? (const char*)g.A : (const char*)g.A + (size_t)PG8_APM(cur) * tstep;
    const char* cB = (const char*)g.Bt + PG8_BOFF(cur);
    PG8_STAGE(PG8_SB(0, 0), cB, voffB); PG8_STAGE(PG8_SB(0, 1), cB + hstepB, voffB); PG8_STAGE_A(PG8_SA(0, 0), cA, 0, false); PG8_STAGE_A(PG8_SA(0, 1), cA, 1, false);
    if (wr == 1) PG8_BAR;
    PG8_WAIT_V(2); PG8_BAR;
    PG8_STAGE(PG8_SB(1, 0), cB + kstep, voffB); PG8_STAGE_A(PG8_SA(1, 0), cA + kstep, 0, false); PG8_STAGE(PG8_SB(1, 1), cB + hstepB + kstep, voffB);
    PG8_WAIT_V(6); PG8_BAR;
    if (want_pre) { const int le_ = fresh_lane(); E.init(acc, wc, le_ >> 4, (const PG8_LAS float*)etab); }
    for (;;) {
        const bool has_next = S.next(ui + 1, nxt); PG8_UNI(nxt);
        if (want_pre && has_next && wid == 0) E.pre(nxt, etab + ((ui + 1) & 1) * 1024, fresh_lane());
        if constexpr (GATHER) { if (has_next && wid == 1) __builtin_amdgcn_global_load_lds((const unsigned*)(g.rowidx + (size_t)PG8_APM(nxt) * BM + 4 * fresh_lane()), (PG8_LAS unsigned*)(etab + 2048 + ((ui + 1) & 1) * 1024), 16, 0, 0); }
        const char* nA = (has_next && !GATHER) ? (const char*)g.A + (size_t)PG8_APM(nxt) * tstep : cA;
        const char* nB = has_next ? (const char*)g.Bt + PG8_BOFF(nxt) : cB;
#pragma nounroll
        for (int t = 0; t < nt; t += 2) {
            const bool last = (t == nt - 2);
            const bool nx = last && has_next;
            const char* a1 = cA + (size_t)(t + 1) * kstep;
            const char* a2 = last ? nA : cA + (size_t)(t + 2) * kstep; const char* b2 = last ? nB : cB + (size_t)(t + 2) * kstep;
            const char* a3 = a2 + kstep; const char* b3 = b2 + kstep;
            PG8_LDB(B0, 0, 0); PG8_LDB(B1, 0, 1); PG8_SCHED; PG8_LDA(At, 0, 0); PG8_STAGE_A(PG8_SA(1, 1), a1, 1, false);
            if constexpr (GATHER) { if (nx) { PG8_ILOAD(gA, etab + 2048 + ((ui + 1) & 1) * 1024); } }
            PG8_WAIT_V(8); PG8_WAIT_L(0); PG8_BAR; PG8_MMA(0, 0, At, B0); PG8_MMA(0, 1, At, B1); PG8_BAR; PG8_SCHED;
            PG8_LDA(At, 0, 1); PG8_STAGE(PG8_SB(0, 0), b2, voffB); PG8_STAGE(PG8_SB(0, 1), b2 + hstepB, voffB); PG8_STAGE_A(PG8_SA(0, 0), a2, 0, nx);
            PG8_WAIT_V(8); PG8_WAIT_L(0); PG8_BAR; PG8_MMA(1, 0, At, B0); PG8_MMA(1, 1, At, B1); PG8_BAR; PG8_SCHED;
            PG8_LDB(B0, 1, 0); PG8_LDB(B1, 1, 1); PG8_SCHED; PG8_LDA(At, 1, 0); PG8_STAGE_A(PG8_SA(0, 1), a2, 1, nx);
            PG8_WAIT_V(8); PG8_WAIT_L(0); PG8_BAR; PG8_MMA(0, 0, At, B0); PG8_MMA(0, 1, At, B1); PG8_BAR; PG8_SCHED;
            PG8_LDA(At, 1, 1); PG8_STAGE(PG8_SB(1, 0), b3, voffB); PG8_STAGE(PG8_SB(1, 1), b3 + hstepB, voffB); PG8_STAGE_A(PG8_SA(1, 0), a3, 0, nx);
            PG8_WAIT_V(8); PG8_WAIT_L(0); PG8_BAR; PG8_MMA(1, 0, At, B0); PG8_MMA(1, 1, At, B1); PG8_BAR; PG8_SCHED;
        }
        if constexpr (ALIGN_EPI) { if (wr == 0) PG8_BAR; }
        { const int le_ = fresh_lane();
          E(acc, cur, wr, wc, le_ & 15, le_ >> 4, (const PG8_LAS float*)(etab + (ui & 1) * 1024)); }
        if (!has_next) break;
#pragma unroll
        for (int a = 0; a < 2; ++a)
#pragma unroll
            for (int b = 0; b < 2; ++b)
#pragma unroll
                for (int m = 0; m < 4; ++m)
#pragma unroll
                    for (int n = 0; n < 2; ++n) acc[a][b][m][n] = (f32x4){0.f, 0.f, 0.f, 0.f};
        cur = nxt; cA = nA; cB = nB; ++ui;
        if (want_pre) { const int le_ = fresh_lane(); E.init(acc, wc, le_ >> 4, (const PG8_LAS float*)(etab + (ui & 1) * 1024)); }
        if constexpr (ALIGN_EPI) { if (wr == 1) PG8_BAR; }
    }
    PG8_WAIT_V(0);
    if constexpr (!ALIGN_EPI) { if (wr == 0) PG8_BAR; }
    PG8_BAR;
#undef PG8_SA
#undef PG8_SB
#undef PG8_STAGE
#undef PG8_STAGE_A
#undef PG8_GLOAD
#undef PG8_ILOAD
#undef PG8_UNI
#undef PG8_APM
#undef PG8_BOFF
#undef PG8_LDA
#undef PG8_LDB
#undef PG8_MMA
#undef PG8_HALF
#undef PG8_WAIT_V
#undef PG8_WAIT_L
#undef PG8_BAR
#undef PG8_SCHED
}
}
#include <hip/hip_bf16.h>
#include <cmath>
namespace attn_body {
using bf16=__hip_bfloat16;
using bf16x8=__attribute__((ext_vector_type(8)))short;
using s16x4=__attribute__((ext_vector_type(4)))short;
using f32x16=__attribute__((ext_vector_type(16)))float;
using u32x4=__attribute__((ext_vector_type(4)))unsigned;
constexpr int BATCH=4,NHEAD=16,SEQ=8192,D=64,DM=NHEAD*D;
constexpr int NW=8,QBLK=32,QB=QBLK*NW,KVBLK=64,NQB=SEQ/QB;
constexpr int ATTN_PITCH=DM, ATTN_UNIT_ROWS=QB;
__device__ __forceinline__ int crow(int r,int hi){return (r&3)+8*(r>>2)+4*hi;}
#define SBAR() __builtin_amdgcn_sched_barrier(0)
__device__ __forceinline__ void cmask(f32x16&p0,f32x16&p1,int jb,int qrel,int hi){
  const float NEG=-INFINITY; int kb=64*jb+4*hi;
  #pragma unroll
  for(int r=0;r<16;++r){int kv=kb+(r&3)+8*(r>>2); if(kv>qrel)p0[r]=NEG; if(kv+32>qrel)p1[r]=NEG;}
}

constexpr int NSLOT=3, SLOTB=8192;
constexpr int LDS_K=0, LDS_V=NSLOT*SLOTB, LDS_WS=2*NSLOT*SLOTB, LDS_OST=LDS_WS+NW*64*4, LDS_CS=LDS_OST+NW*4096, LDS_QM=LDS_CS+SEQ*4, LDS_BYTES=LDS_QM+64;
constexpr float PRUNE_LOG2=40.0f;
constexpr float C2=0.125f*1.4426950408889634f;
__device__ __forceinline__ void glds16(const void*gsrc,unsigned lds_dst){unsigned keep;
  asm volatile("s_mov_b32 %0, m0\n\ts_mov_b32 m0, %2\n\ts_nop 0\n\tglobal_load_lds_dwordx4 %1, off\n\ts_mov_b32 m0, %0":"=&s"(keep):"v"(gsrc),"s"(lds_dst):"memory");}
__device__ __forceinline__ float max3f(float a,float b,float c){float r;asm("v_max3_f32 %0, %1, %2, %3":"=v"(r):"v"(a),"v"(b),"v"(c));return r;}
__device__ __forceinline__ float max2f(float a,float b){float r;asm("v_max_f32_e32 %0, %1, %2":"=v"(r):"v"(a),"v"(b));return r;}
__device__ __forceinline__ float fadd_s(float a,float b){float r;asm("v_add_f32_e32 %0, %1, %2":"=v"(r):"v"(a),"v"(b));return r;}
__device__ __forceinline__ float fsub_s(float a,float b){float r;asm("v_sub_f32_e32 %0, %1, %2":"=v"(r):"v"(a),"v"(b));return r;}
typedef float f32x2_t __attribute__((ext_vector_type(2))); typedef __bf16 bf16x2_t __attribute__((ext_vector_type(2)));
__device__ __forceinline__ unsigned cvtpk_s(float lo,float hi){f32x2_t v={lo,hi};bf16x2_t b=__builtin_convertvector(v,bf16x2_t);return __builtin_bit_cast(unsigned,b);}
#define WAIT_BAR(N) asm volatile("s_waitcnt vmcnt(" #N ") lgkmcnt(0)\n\ts_barrier":::"memory")

__device__ __forceinline__ void qkt(f32x16&p0,f32x16&p1,const char*Kslot,const bf16x8*qr,int r32,int hi){
  const char*kb=Kslot+hi*1024+r32*16;
  #pragma unroll
  for(int d0=0;d0<4;++d0){
    const bf16x8 b0=*reinterpret_cast<const bf16x8*>(kb+d0*2048);
    const bf16x8 b1=*reinterpret_cast<const bf16x8*>(kb+d0*2048+512);
    {p0=__builtin_amdgcn_mfma_f32_32x32x16_bf16(b0,qr[d0],p0,0,0,0);p1=__builtin_amdgcn_mfma_f32_32x32x16_bf16(b1,qr[d0],p1,0,0,0);}}
}
typedef __attribute__((address_space(3))) const char* lds_cptr;
typedef short v4i16_t __attribute__((ext_vector_type(4)));
__device__ __forceinline__ void kload8(bf16x8*kf,lds_cptr kp){
  kf[0]=*(const __attribute__((address_space(3))) bf16x8*)(kp);      kf[1]=*(const __attribute__((address_space(3))) bf16x8*)(kp+512);
  kf[2]=*(const __attribute__((address_space(3))) bf16x8*)(kp+2048); kf[3]=*(const __attribute__((address_space(3))) bf16x8*)(kp+2560);
  kf[4]=*(const __attribute__((address_space(3))) bf16x8*)(kp+4096); kf[5]=*(const __attribute__((address_space(3))) bf16x8*)(kp+4608);
  kf[6]=*(const __attribute__((address_space(3))) bf16x8*)(kp+6144); kf[7]=*(const __attribute__((address_space(3))) bf16x8*)(kp+6656);
}
__device__ __forceinline__ void kload2(bf16x8*kf,lds_cptr kp,int j){ kf[2*j]=*(const __attribute__((address_space(3))) bf16x8*)(kp+j*2048); kf[2*j+1]=*(const __attribute__((address_space(3))) bf16x8*)(kp+j*2048+512); }
__device__ __forceinline__ s16x4 vtr(lds_cptr p){ return __builtin_bit_cast(s16x4,__builtin_amdgcn_ds_read_tr16_b64_v4i16((__attribute__((address_space(3))) v4i16_t*)p)); }
__device__ __forceinline__ float rowmax(const f32x16&p0,const f32x16&p1){
  float a=max3f(p0[0],p0[1],p1[0]),b=max3f(p0[2],p0[3],p1[1]);a=max3f(a,p1[2],p1[3]);
  #pragma unroll
  for(int r=4;r<16;r+=4){a=max3f(a,p0[r],p0[r+1]);b=max3f(b,p0[r+2],p0[r+3]);a=max3f(a,p1[r],p1[r+1]);b=max3f(b,p1[r+2],p1[r+3]);}
  const float m=max2f(a,b);
  auto rr=__builtin_amdgcn_permlane32_swap(__float_as_uint(m),__float_as_uint(m),false,false);
  return max2f(__uint_as_float(rr[0]),__uint_as_float(rr[1]));
}
__device__ __forceinline__ void pv(f32x16*o,int vb,bf16x8 pa0,bf16x8 pa1,bf16x8 pa2,bf16x8 pa3){
  #pragma unroll
  for(int d0=0;d0<2;++d0){s16x4 lo[4],hi[4];
    #pragma unroll
    for(int ks=0;ks<4;++ks){
      asm volatile("ds_read_b64_tr_b16 %0,%1 offset:%c2":"=&v"(lo[ks]):"v"(vb),"i"(d0*4096+ks*1024):"memory");
      asm volatile("ds_read_b64_tr_b16 %0,%1 offset:%c2":"=&v"(hi[ks]):"v"(vb),"i"(d0*4096+ks*1024+512):"memory");}
    asm volatile("s_waitcnt lgkmcnt(0)":::"memory");SBAR();
    #define PK(k) (bf16x8){lo[k][0],lo[k][1],lo[k][2],lo[k][3],hi[k][0],hi[k][1],hi[k][2],hi[k][3]}
    o[d0]=__builtin_amdgcn_mfma_f32_32x32x16_bf16(pa0,PK(0),o[d0],0,0,0);
    o[d0]=__builtin_amdgcn_mfma_f32_32x32x16_bf16(pa1,PK(1),o[d0],0,0,0);
    o[d0]=__builtin_amdgcn_mfma_f32_32x32x16_bf16(pa2,PK(2),o[d0],0,0,0);
    o[d0]=__builtin_amdgcn_mfma_f32_32x32x16_bf16(pa3,PK(3),o[d0],0,0,0);
    #undef PK
  }
}

#ifndef ATTN_STORE16
#define ATTN_STORE16(p,v) (*(u32x4*)(p)=(v))
#endif
template<int THRL> __device__ __forceinline__ void attn_unit(int b,int h,int qb,const bf16*Q,const bf16*__restrict__ K,const bf16*__restrict__ V,bf16*O,const float*__restrict__ CS,const float*__restrict__ KM,unsigned char*O8,char*shm,const int wid_in){
  int lane_=(int)__builtin_amdgcn_mbcnt_hi(~0u,__builtin_amdgcn_mbcnt_lo(~0u,0u)); asm volatile("":"+v"(lane_));
  const int wid=__builtin_amdgcn_readfirstlane(wid_in),lane=lane_,tid=wid*64+lane,r32=lane&31,hi=lane>>5;
  const long rowbase=(long)b*SEQ; const int q0=qb*QB;
  const bf16*Qw=Q+(rowbase+q0+wid*QBLK)*DM+h*D;
  const bf16*Kh=K+rowbase*DM+h*D,*Vh=V+rowbase*DM+h*D;
  const unsigned lds0=(unsigned)(uintptr_t)shm;
  float*wsf=(float*)(shm+LDS_WS)+wid*64;
  const bf16*ksrc=Kh+(long)lane*DM+wid*8;
  const bf16*vsrc=Vh+(long)(16*(wid&3)+(lane>>2))*DM+(wid>>2)*32+(lane&3)*8;
  const unsigned kdst=lds0+LDS_K+wid*1024, vdst=lds0+LDS_V+wid*1024;
  #define DMA_K(t,slot) glds16(ksrc+(long)(NT-1-(t))*KVBLK*DM,(unsigned)__builtin_amdgcn_readfirstlane(kdst+(slot)))
  #define DMA_V(t,slot) glds16(vsrc+(long)(NT-1-(t))*KVBLK*DM,(unsigned)__builtin_amdgcn_readfirstlane(vdst+(slot)))
  const int vb0=(int)(lds0+LDS_V)+((lane>>4)&1)*32+(lane&3)*8+(4*hi+((lane&15)>>2))*64;
  const char*Kbase=shm+LDS_K; bf16x8 kf[8];
  const lds_cptr shm3=(lds_cptr)shm; const lds_cptr kp0=shm3+LDS_K+hi*1024+r32*16; const lds_cptr vp0=shm3+LDS_V+((lane>>4)&1)*32+(lane&3)*8+(4*hi+((lane&15)>>2))*64;
  const int NT=(q0+QB)/KVBLK;
  typedef float f32x4v __attribute__((ext_vector_type(4)));
  const float*csrc=CS+(long)(b*NHEAD+h)*SEQ;
  float rowoff=csrc[q0+wid*QBLK+r32];
  const float kmax2=KM[b*NHEAD+h];
  { __attribute__((address_space(3))) f32x4v*cl=(__attribute__((address_space(3))) f32x4v*)(shm3+LDS_CS);
    for(int i_=tid;i_<NT*16;i_+=NW*64){ const f32x4v v_=*(const f32x4v*)(csrc+4*i_); cl[i_]=v_; } }
  const __attribute__((address_space(3))) float*csl=(const __attribute__((address_space(3))) float*)(shm3+LDS_CS)+4*hi;
  #define BIAS(C0,C1,t) do{ const __attribute__((address_space(3))) f32x4v*p_=(const __attribute__((address_space(3))) f32x4v*)(csl+(NT-1-(t))*64); \
    _Pragma("unroll") for(int g_=0;g_<4;++g_){ const f32x4v a_=p_[2*g_], b_=p_[2*g_+8]; \
      C0[4*g_+0]=rowoff-a_[0]; C0[4*g_+1]=rowoff-a_[1]; C0[4*g_+2]=rowoff-a_[2]; C0[4*g_+3]=rowoff-a_[3]; \
      C1[4*g_+0]=rowoff-b_[0]; C1[4*g_+1]=rowoff-b_[1]; C1[4*g_+2]=rowoff-b_[2]; C1[4*g_+3]=rowoff-b_[3]; } }while(0)
  DMA_K(0,0);DMA_V(0,0);DMA_K(1,SLOTB);
  bf16x8 qr[4];
  #pragma unroll
  for(int d0=0;d0<4;++d0)qr[d0]=*reinterpret_cast<const bf16x8*>(&Qw[(long)r32*DM+d0*16+hi*8]);
  bf16x8 kdg[4];
  #pragma unroll
  for(int d0=0;d0<4;++d0)kdg[d0]=*reinterpret_cast<const bf16x8*>(&Kh[(long)(q0+wid*QBLK+r32)*DM+d0*16+hi*8]);
  float l_reg=0.f;f32x16 o[2];o[0]=f32x16{};o[1]=f32x16{};
  const int qrel=wid*QBLK+r32;
  #define CMASK(P0,P1,t) do{ if((t)<4)cmask(P0,P1,3-(t),qrel,hi); }while(0)
  bool resc=false;
  #define DECIDE(C0,C1) do{ float a=MX3(C0[0],C0[1],C1[0]),b=MX3(C0[2],C0[3],C1[1]); a=MX3(a,C1[2],C1[3]); \
      _Pragma("unroll") for(int r=4;r<16;r+=4){a=MX3(a,C0[r],C0[r+1]);b=MX3(b,C0[r+2],C0[r+3]);a=MX3(a,C1[r],C1[r+1]);b=MX3(b,C1[r+2],C1[r+3]);} \
      float rm=__builtin_fmaxf(a,b); { auto rr=__builtin_amdgcn_permlane32_swap(__float_as_uint(rm),__float_as_uint(rm),false,false); rm=__builtin_fmaxf(__uint_as_float(rr[0]),__uint_as_float(rr[1])); } \
      resc=false; \
      if(__builtin_expect(__any(rm>(float)THRL),0)){ const float dl=__builtin_fmaxf(rm,0.f); rowoff-=dl; \
        _Pragma("unroll") for(int r=0;r<16;++r){C0[r]-=dl;C1[r]-=dl;} \
        const float f=__builtin_amdgcn_exp2f(-dl); l_reg*=f; if(hi==0)wsf[r32]=f; resc=true; } }while(0)
  #define MX3(a,b,c) __builtin_fmaxf(__builtin_fmaxf((a),(b)),(c))
  #define RESC() do{ if(resc){ asm volatile("s_waitcnt lgkmcnt(0)":::"memory"); \
      _Pragma("unroll") for(int d_=0;d_<2;++d_) _Pragma("unroll") for(int r=0;r<16;++r)o[d_][r]*=wsf[crow(r,hi)]; } }while(0)
  f32x16 pA0,pA1,pB0,pB1;
  int sl_prev=0,sl_cur=0,sl_next=SLOTB;
  #define ROT() do{sl_prev=sl_cur;sl_cur=sl_next;sl_next=(sl_next==(NSLOT-1)*SLOTB)?0:sl_next+SLOTB;}while(0)
  DMA_K(2,2*SLOTB);
  { float s_=0.f,dg_=0.f;
    #pragma unroll
    for(int d0=0;d0<4;++d0){
      #pragma unroll
      for(int e_=0;e_<8;++e_){ const float x_=__uint_as_float(((unsigned)(unsigned short)qr[d0][e_])<<16), k_=__uint_as_float(((unsigned)(unsigned short)kdg[d0][e_])<<16); s_+=x_*x_; dg_+=x_*k_; } }
    { auto rr=__builtin_amdgcn_permlane32_swap(__float_as_uint(s_),__float_as_uint(s_),false,false); s_=__uint_as_float(rr[0])+__uint_as_float(rr[1]); }
    { auto rr=__builtin_amdgcn_permlane32_swap(__float_as_uint(dg_),__float_as_uint(dg_),false,false); dg_=__uint_as_float(rr[0])+__uint_as_float(rr[1]); }
    #pragma unroll
    for(int m_=1;m_<32;m_<<=1){ s_=__builtin_fmaxf(s_,__shfl_xor(s_,m_)); dg_=__builtin_fminf(dg_,__shfl_xor(dg_,m_)); }
    if(lane==0){ ((__attribute__((address_space(3))) float*)(shm3+LDS_QM))[wid]=s_; ((__attribute__((address_space(3))) float*)(shm3+LDS_QM))[8+wid]=dg_; } }
  WAIT_BAR(3);
  int NTe;
  { const __attribute__((address_space(3))) float*cst=(const __attribute__((address_space(3))) float*)(shm3+LDS_CS);
    const __attribute__((address_space(3))) float*qm=(const __attribute__((address_space(3))) float*)(shm3+LDS_QM);
    float q2=qm[0],dmin=qm[8];
    #pragma unroll
    for(int w_=1;w_<NW;++w_){q2=__builtin_fmaxf(q2,qm[w_]);dmin=__builtin_fminf(dmin,qm[8+w_]);}
    const float B2=__builtin_sqrtf(q2*kmax2)-dmin+1.0f;
    const float cq0=cst[q0];
    const bool k0=(lane<NT)&&(B2+cq0-cst[64*lane+63]>=-PRUNE_LOG2), k1=(lane+64<NT)&&(B2+cq0-cst[64*(lane+64)+63]>=-PRUNE_LOG2);
    const unsigned long long m0=__ballot(k0), m1=__ballot(k1);
    int pmin=m0?__builtin_ctzll(m0):(m1?64+__builtin_ctzll(m1):NT-4); pmin=pmin<NT-4?pmin:NT-4;
    NTe=(NT-pmin+1)&~1; NTe=__builtin_amdgcn_readfirstlane(NTe); }
  BIAS(pA0,pA1,0); qkt(pA0,pA1,Kbase,qr,r32,hi);asm volatile("s_nop 15\n\ts_nop 7":"+v"(pA0),"+v"(pA1));CMASK(pA0,pA1,0);
  DECIDE(pA0,pA1); resc=false;
  _Pragma("unroll") for(int r=0;r<16;++r){pA0[r]=__builtin_amdgcn_exp2f(pA0[r]);pA1[r]=__builtin_amdgcn_exp2f(pA1[r]);}
  WAIT_BAR(0);
  DMA_K(3,0);DMA_V(1,SLOTB);
  ROT();
  kload8(kf,kp0+sl_cur);
  WAIT_BAR(2);
  s16x4 vlo[8],vhi[8]; u32x4 pw0,pw1,pw2,pw3;
  #define PKW(P,B) cvtpk_s(P[B],P[B+1])
  #define PAF(k) __builtin_bit_cast(bf16x8,pw##k)
  #define VFR(i) (bf16x8){vlo[i][0],vlo[i][1],vlo[i][2],vlo[i][3],vhi[i][0],vhi[i][1],vhi[i][2],vhi[i][3]}
  #define PIN(x) asm volatile("":"+v"(x))
  #define GAPA(MF,A0,A1,A2,A3,W0,W1,PW) do{ MF; sacc+=A0; sacc+=A1; sacc+=A2; sacc+=A3; PIN(sacc); W0; W1; PIN(PW); SBAR(); }while(0)
  #define EX(v) __builtin_amdgcn_exp2f(v)
  #define GAPB(MF,X,B) do{ MF; X[B]=EX(X[B]); X[B+1]=EX(X[B+1]); X[B+2]=EX(X[B+2]); X[B+3]=EX(X[B+3]); PIN(X); SBAR(); }while(0)
  #define VRD(i) do{ vlo[i]=vtr(vp_+(((i)>>2)*4096+((i)&3)*1024)); vhi[i]=vtr(vp_+(((i)>>2)*4096+((i)&3)*1024+512)); }while(0)
  #define KRD(G,j) do{ if(G){ kload2(kf,kp0+sl_next,j); SBAR(); } }while(0)
  #define STEP(C0,C1,P0,P1,t,GK,GV,GL) do{ SBAR(); BIAS(C0,C1,t); SBAR(); \
    const lds_cptr vp_=vp0+sl_prev; \
    VRD(0); SBAR(); float sacc=(P0[0]+P0[1]); \
    GAPA(C0=__builtin_amdgcn_mfma_f32_32x32x16_bf16(kf[0],qr[0],C0,0,0,0), P0[2],P0[3],P0[4],P0[5],     pw0[0]=PKW(P0,0), pw0[1]=PKW(P0,2), pw0); \
    VRD(4); SBAR(); GAPA(C1=__builtin_amdgcn_mfma_f32_32x32x16_bf16(kf[1],qr[0],C1,0,0,0), P0[6],P0[7],P0[8],P0[9],     pw0[2]=PKW(P0,4), pw0[3]=PKW(P0,6), pw0); \
    VRD(1); SBAR(); GAPA(C0=__builtin_amdgcn_mfma_f32_32x32x16_bf16(kf[2],qr[1],C0,0,0,0),   P0[10],P0[11],P0[12],P0[13], pw1[0]=PKW(P0,8), pw1[1]=PKW(P0,10), pw1); \
    VRD(5); SBAR(); GAPA(C1=__builtin_amdgcn_mfma_f32_32x32x16_bf16(kf[3],qr[1],C1,0,0,0),   P0[14],P0[15],P1[0],P1[1],   pw1[2]=PKW(P0,12),pw1[3]=PKW(P0,14), pw1); \
    VRD(2); SBAR(); GAPA(C0=__builtin_amdgcn_mfma_f32_32x32x16_bf16(kf[4],qr[2],C0,0,0,0),   P1[2],P1[3],P1[4],P1[5],     pw2[0]=PKW(P1,0), pw2[1]=PKW(P1,2), pw2); \
    VRD(6); SBAR(); GAPA(C1=__builtin_amdgcn_mfma_f32_32x32x16_bf16(kf[5],qr[2],C1,0,0,0),   P1[6],P1[7],P1[8],P1[9],     pw2[2]=PKW(P1,4), pw2[3]=PKW(P1,6), pw2); \
    VRD(3); SBAR(); GAPA(C0=__builtin_amdgcn_mfma_f32_32x32x16_bf16(kf[6],qr[3],C0,0,0,0),   P1[10],P1[11],P1[12],P1[13], pw3[0]=PKW(P1,8), pw3[1]=PKW(P1,10), pw3); \
    VRD(7); SBAR(); GAPA(C1=__builtin_amdgcn_mfma_f32_32x32x16_bf16(kf[7],qr[3],C1,0,0,0),   P1[14],P1[15],0.f,0.f,       pw3[2]=PKW(P1,12),pw3[3]=PKW(P1,14), pw3); \
    l_reg+=sacc; \
    if(GK){DMA_K((t)+3,sl_cur);} if(GV){DMA_V((t)+1,sl_next);} \
    CMASK(C0,C1,t); \
    DECIDE(C0,C1); \
    SBAR(); \
    GAPB(o[0]=__builtin_amdgcn_mfma_f32_32x32x16_bf16(PAF(0),VFR(0),o[0],0,0,0), C0,0); \
    GAPB(o[1]=__builtin_amdgcn_mfma_f32_32x32x16_bf16(PAF(0),VFR(4),o[1],0,0,0), C0,4); \
    KRD(GL,0); GAPB(o[0]=__builtin_amdgcn_mfma_f32_32x32x16_bf16(PAF(1),VFR(1),o[0],0,0,0), C0,8); \
    KRD(GL,1); GAPB(o[1]=__builtin_amdgcn_mfma_f32_32x32x16_bf16(PAF(1),VFR(5),o[1],0,0,0), C0,12); \
    KRD(GL,2); GAPB(o[0]=__builtin_amdgcn_mfma_f32_32x32x16_bf16(PAF(2),VFR(2),o[0],0,0,0), C1,0); \
    KRD(GL,3); GAPB(o[1]=__builtin_amdgcn_mfma_f32_32x32x16_bf16(PAF(2),VFR(6),o[1],0,0,0), C1,4); \
    GAPB(o[0]=__builtin_amdgcn_mfma_f32_32x32x16_bf16(PAF(3),VFR(3),o[0],0,0,0), C1,8); \
    GAPB(o[1]=__builtin_amdgcn_mfma_f32_32x32x16_bf16(PAF(3),VFR(7),o[1],0,0,0), C1,12); \
    }while(0)
  #define ENDW(tt) do{ if((tt)+3<NTe){WAIT_BAR(2);} else if((tt)+2<NTe){WAIT_BAR(1);} else {WAIT_BAR(0);} }while(0)
  for(int t=1;t+1<NTe;t+=2){
    STEP(pB0,pB1,pA0,pA1,t,(t+3<NTe),(t+1<NTe),(t+1<NTe));       ENDW(t);   RESC(); ROT();
    STEP(pA0,pA1,pB0,pB1,t+1,(t+4<NTe),(t+2<NTe),(t+2<NTe));     ENDW(t+1); RESC(); ROT();
  }
  STEP(pB0,pB1,pA0,pA1,NTe-1,false,false,false); RESC();
  { float sacc=pB0[0]+pB0[1]; _Pragma("unroll") for(int r=2;r<16;++r)sacc+=pB0[r]; _Pragma("unroll") for(int r=0;r<16;++r)sacc+=pB1[r]; l_reg+=sacc;
    pw0=(u32x4){PKW(pB0,0),PKW(pB0,2),PKW(pB0,4),PKW(pB0,6)};pw1=(u32x4){PKW(pB0,8),PKW(pB0,10),PKW(pB0,12),PKW(pB0,14)};pw2=(u32x4){PKW(pB1,0),PKW(pB1,2),PKW(pB1,4),PKW(pB1,6)};pw3=(u32x4){PKW(pB1,8),PKW(pB1,10),PKW(pB1,12),PKW(pB1,14)};
    SBAR(); pv(o,vb0+sl_cur,PAF(0),PAF(1),PAF(2),PAF(3)); }
  #undef PKW
  #undef PAF
  #undef VFR
  #undef PIN
  #undef MX3
  #undef GAPA
  #undef GAPB
  #undef EX
  #undef VRD
  #undef KRD
  #undef STEP
  #undef ENDW
  {auto rr=__builtin_amdgcn_permlane32_swap(__float_as_uint(l_reg),__float_as_uint(l_reg),false,false);l_reg=__uint_as_float(rr[0])+__uint_as_float(rr[1]);}
  if(hi==0)wsf[32+r32]=l_reg;asm volatile("s_waitcnt lgkmcnt(0)":::"memory");
  float rli[16];
  #pragma unroll
  for(int r=0;r<16;++r)rli[r]=__builtin_amdgcn_rcpf(wsf[32+crow(r,hi)]);
  bf16*Ow=O+(rowbase+q0+wid*QBLK)*DM+h*D;
  { bf16*stg=(bf16*)(shm+LDS_OST)+wid*2048;
    #pragma unroll
    for(int r=0;r<16;++r){const int orow=crow(r,hi);
      #pragma unroll
      for(int d0=0;d0<2;++d0)stg[orow*64+d0*32+r32]=__float2bfloat16(o[d0][r]*rli[r]);}
    asm volatile("s_waitcnt lgkmcnt(0)":::"memory");
    #pragma unroll
    for(int i=0;i<4;++i){const int row=i*8+(lane>>3),ch=lane&7; const u32x4 v=*(const u32x4*)(stg+row*64+ch*8);
      if(O8){
        int w0=0,w1=0; w0=__builtin_amdgcn_cvt_pk_fp8_f32(__uint_as_float(v.x<<16),__uint_as_float(v.x&0xffff0000u),w0,false); w0=__builtin_amdgcn_cvt_pk_fp8_f32(__uint_as_float(v.y<<16),__uint_as_float(v.y&0xffff0000u),w0,true);
        w1=__builtin_amdgcn_cvt_pk_fp8_f32(__uint_as_float(v.z<<16),__uint_as_float(v.z&0xffff0000u),w1,false); w1=__builtin_amdgcn_cvt_pk_fp8_f32(__uint_as_float(v.w<<16),__uint_as_float(v.w&0xffff0000u),w1,true);
        typedef int i32x2_t __attribute__((ext_vector_type(2))); *(i32x2_t*)(O8+((rowbase+q0+wid*QBLK+row)*DM+h*D+ch*8))=(i32x2_t){w0,w1}; }
      else ATTN_STORE16(Ow+(long)row*DM+ch*8,v);} }
  asm volatile("s_waitcnt lgkmcnt(0)\n\ts_barrier":::"memory");
  #undef BIAS
  #undef DMA_K
  #undef DMA_V
  #undef CMASK
  #undef DECIDE
  #undef RESC
  #undef ROT
}
constexpr int ATTN_LDS_BYTES=LDS_BYTES;
struct AttnTensors { const bf16* Q; const bf16* K; const bf16* V; bf16* O; const float* CS; const float* KM; unsigned char* O8; };
struct AttnUnit { int bh; int qb; };
struct StaticOrder {
  int vcu, G;
  __device__ __forceinline__ explicit StaticOrder(int grid,int block):vcu((grid%8==0)?(block%8)*(grid/8)+block/8:block),G(grid){}
  __device__ __forceinline__ bool next(int i,AttnUnit&u)const{ const int ci=vcu+(i>>2)*G; if(ci>=BATCH*NHEAD*8)return false; const int s=ci&7, ii=i&3; u.bh=ci>>3; u.qb=(ii==0)?s:(ii==1)?15-s:(ii==2)?16+s:31-s; return true; }
  __device__ __forceinline__ void a_ready(const AttnUnit&)const{}
  __device__ __forceinline__ void done(const AttnUnit&)const{}
};
template<class Sched,int THRL=8> __device__ __forceinline__ void attn_phase(char*lds,const AttnTensors&T,const Sched&S,const int wid){
  AttnUnit u;
  for(int i=0;S.next(i,u);++i){ S.a_ready(u); u.bh=__builtin_amdgcn_readfirstlane(u.bh); u.qb=__builtin_amdgcn_readfirstlane(u.qb); attn_unit<THRL>(u.bh/NHEAD,u.bh%NHEAD,u.qb,T.Q,T.K,T.V,T.O,T.CS,T.KM,T.O8,lds,wid); S.done(u); }
}
#undef SBAR
#undef WAIT_BAR
}

constexpr int NWAVES = 8;
constexpr int BATCH = 4, SEQ = 8192, T = BATCH * SEQ, D = 1024, NH = 16, NE = 32, TOPK = 4, FF = 1024, DEPTH = 4;
constexpr int NGROUP = T / 128;
constexpr int NTILE_MAX = (T * TOPK) / 256 + NE;
constexpr int NSLOT_MAX = NTILE_MAX * 256;
constexpr float LN_EPS = 1e-5f;
constexpr float DN_ALPHA = 1.6817928305074290f;
constexpr float LOG2E = 1.4426950408889634f;
constexpr size_t MiB = 1u << 20;
constexpr size_t WS_CTL = 0, CTL_ZERO_BYTES = 1 * MiB;
constexpr size_t WS_MOD = 1 * MiB, WS_KVMOD = 1 * MiB + 512 * 1024;
constexpr size_t WS_WRT = 2 * MiB, WS_WFT = 2 * MiB + 512 * 1024;
constexpr size_t WS_BLKCNT = 3 * MiB, WS_TILES = 3 * MiB + 64 * 1024;
constexpr size_t WS_LOGF = 4 * MiB, WS_CS = 6 * MiB;
constexpr size_t WS_IDENT = 40 * MiB;
constexpr size_t WS_TKI = 8 * MiB, WS_TKW = 9 * MiB, WS_SLOTOF = 10 * MiB, WS_SLOTTOK = 11 * MiB;
constexpr size_t WS_WCI = 12 * MiB, WS_WCO = 24 * MiB, WS_WKV = 28 * MiB, WS_WQ = 32 * MiB, WS_WO = 36 * MiB;
constexpr size_t WS_WGU = 64 * MiB, WS_WD = 576 * MiB;
constexpr size_t WS_X = 832 * MiB, WS_HB = 960 * MiB, WS_HKV = 1024 * MiB, WS_ZB = 1088 * MiB, WS_GB = 1152 * MiB, WS_YB = 1216 * MiB, WS_SUB = 1280 * MiB;
constexpr size_t WS_Q = 1344 * MiB, WS_K = 1408 * MiB, WS_V = 1472 * MiB, WS_A1 = 1536 * MiB, WS_Y2 = 1808 * MiB, WS_HB8 = 2080 * MiB, WS_END = 2112 * MiB;
static_assert(WS_A1 + (size_t)NSLOT_MAX * 1024 * 2 <= WS_Y2 && WS_Y2 + (size_t)NSLOT_MAX * 1024 * 2 <= WS_HB8 && WS_HB8 + (size_t)T * D <= WS_END, "d_ws map");
#ifndef YK_FP8
#define YK_FP8 1
#endif
constexpr bool MOE_FP8 = (YK_FP8 != 0);
constexpr int WSH_GU = MOE_FP8 ? 6 : 0, WSH_DN = MOE_FP8 ? 7 : 0;
constexpr bool QKV_FP8 = MOE_FP8; constexpr int WSH_QKV = 6;
constexpr bool CONV_FP8 = false;
constexpr bool CONV2_FP8 = QKV_FP8;
constexpr int WSH_O = 7;
constexpr size_t WS_O8 = WS_HKV + 32 * MiB;
#ifndef YK_ALIGN1
#define YK_ALIGN1 true
#endif
#ifndef YK_Y2FP8
#define YK_Y2FP8 1
#endif
constexpr bool Y2_FP8 = MOE_FP8 && (YK_Y2FP8 != 0);
constexpr size_t WS_KMAX = WS_CTL + 640 * 1024;
constexpr int CW_BAR = 4096;
constexpr int MAX_BAR_REGIONS = 64;
constexpr int RING_OFF = 0, RING_BYTES = 131072;
constexpr int LDSCTL_OFF = RING_BYTES, MISC_OFF = LDSCTL_OFF + 320;
constexpr int HIST_OFF = LDSCTL_OFF + 512;
constexpr int TILE_OFF = LDSCTL_OFF + 1024;
constexpr int SLOTW_OFF = LDSCTL_OFF + 4096;
constexpr int ETAB_OFF = LDSCTL_OFF + 10240;
constexpr int PTRS_OFF = LDSCTL_OFF + 8192;
constexpr int LDS_BYTES = 147456;

#define GAS __attribute__((address_space(1)))
#define LAS __attribute__((address_space(3)))
typedef unsigned short bf16;
typedef unsigned v4u __attribute__((ext_vector_type(4)));
typedef float f32x4 __attribute__((ext_vector_type(4)));
typedef short bf16x8 __attribute__((ext_vector_type(8)));
typedef GAS unsigned gu32;
typedef GAS unsigned long long gu64;
#define RLX_AGENT __ATOMIC_RELAXED, __HIP_MEMORY_SCOPE_AGENT
#define LDS_WAIT() asm volatile("s_waitcnt lgkmcnt(0)" ::: "memory")
#define VM_WAIT() asm volatile("s_waitcnt vmcnt(0)" ::: "memory")
__device__ __forceinline__ unsigned long long rt() { return __builtin_amdgcn_s_memrealtime(); }
__device__ __forceinline__ unsigned f2bf(float f) { unsigned u = __builtin_bit_cast(unsigned, f); return (u + 0x7fffu + ((u >> 16) & 1u)) >> 16; }
__device__ __forceinline__ unsigned pk2(float lo, float hi) { return f2bf(lo) | (f2bf(hi) << 16); }

#define XB_TMO      128
#define XB_XCNT(j)  (256  + 64 * (j))
#define XB_XSUB(j)  (1280 + 64 * (j))
#define XB_XGEN(j)  (2304 + 64 * (j))
#define XB_TOP      3328
#define XB_TOPGEN   3392
#define XCD_BAR_WORDS 3456
#define XB_SPIN_CAP (1u << 18)

__device__ __forceinline__ unsigned xb_ld(unsigned* p)              { return __hip_atomic_load(p, __ATOMIC_RELAXED, __HIP_MEMORY_SCOPE_AGENT); }
__device__ __forceinline__ unsigned xb_add(unsigned* p, unsigned v) { return __hip_atomic_fetch_add(p, v, __ATOMIC_RELAXED, __HIP_MEMORY_SCOPE_AGENT); }
__device__ __forceinline__ unsigned xb_xcc_id() { return (unsigned)__builtin_amdgcn_s_getreg((3 << 11) | 20) & 0xFu; }
#define XB_SPIN(cond, bar) do { unsigned _sp = 0; while (cond) { __builtin_amdgcn_s_sleep(1); \
    if ((++_sp & 255u) == 0u) { if (xb_ld(&(bar)[XB_TMO])) break; if (_sp > XB_SPIN_CAP) { atomicAdd(&(bar)[XB_TMO], 1u); break; } } } } while (0)

struct XcdBarrier {
    unsigned* bar; unsigned x;
    volatile LAS unsigned* st;
};

__device__ __forceinline__ XcdBarrier xcd_barrier_post(unsigned* bar, volatile LAS unsigned* st) {
    XcdBarrier b; b.bar = bar; b.x = xb_xcc_id(); b.st = st;
    if (threadIdx.x == 0) (void)xb_add(&bar[XB_XCNT(b.x)], 1u);
    return b;
}
__device__ __forceinline__ void xcd_barrier_complete(unsigned* bar, unsigned x, unsigned& nloc, unsigned& nx) {
    const unsigned G = gridDim.x * gridDim.y * gridDim.z;
    unsigned sum, cnt, mine, sp = 0u;
    for (;;) {
        sum = 0u; cnt = 0u; mine = 0u;
#pragma unroll
        for (unsigned j = 0; j < 16; ++j) { const unsigned c = xb_ld(&bar[XB_XCNT(j)]); sum += c; cnt += (c > 0u) ? 1u : 0u; mine = (j == x) ? c : mine; }
        if (sum == G) break;
        __builtin_amdgcn_s_sleep(1);
        if ((++sp & 255u) == 0u) { if (xb_ld(&bar[XB_TMO])) break; if (sp > XB_SPIN_CAP) { atomicAdd(&bar[XB_TMO], 1u); break; } }
    }
    nloc = mine > 0u ? mine : 1u; nx = cnt > 0u ? cnt : 1u;
}

__device__ __forceinline__ void xcd_barrier(const XcdBarrier& b, const bool leader_thread) {
    asm volatile("s_waitcnt vmcnt(0)" ::: "memory");
    __syncthreads();
    if (leader_thread) {
        unsigned* bar = b.bar;
        __builtin_amdgcn_s_waitcnt(0);
        unsigned nloc = b.st[0], nx = b.st[1];
        if (nloc == 0u) { xcd_barrier_complete(bar, b.x, nloc, nx); b.st[0] = nloc; b.st[1] = nx; }
        const unsigned old = xb_add(&bar[XB_XSUB(b.x)], 1u);
        const unsigned gen = old / nloc;
        if (old + 1u == (gen + 1u) * nloc) {
            __builtin_amdgcn_fence(__ATOMIC_RELEASE, "agent");
            asm volatile("s_waitcnt vmcnt(0)" ::: "memory");
            const unsigned og = xb_add(&bar[XB_TOP], 1u);
            const unsigned tg = og / nx;
            if (og + 1u == (tg + 1u) * nx) xb_add(&bar[XB_TOPGEN], 1u);
            else XB_SPIN(xb_ld(&bar[XB_TOPGEN]) == tg, bar);
            __builtin_amdgcn_fence(__ATOMIC_ACQUIRE, "agent");
            xb_add(&bar[XB_XGEN(b.x)], 1u);
            asm volatile("s_waitcnt vmcnt(0)" ::: "memory");
        } else {
            XB_SPIN(xb_ld(&bar[XB_XGEN(b.x)]) == gen, bar);
            __builtin_amdgcn_fence(__ATOMIC_ACQUIRE, "agent");
            asm volatile("s_waitcnt vmcnt(0)" ::: "memory");
        }
    }
    __syncthreads();
}


static_assert(CW_BAR + MAX_BAR_REGIONS * XCD_BAR_WORDS <= (int)(CTL_ZERO_BYTES / 4), "barrier regions inside the memset region");
typedef float f32x2 __attribute__((ext_vector_type(2)));
typedef unsigned u32x2 __attribute__((ext_vector_type(2)));
typedef int i32x4 __attribute__((ext_vector_type(4)));

struct Frame {
    LAS unsigned char* lds;
    volatile LAS unsigned* MISC;
    int tid, lane, wave, vcu, G, dup;
    unsigned char* ws;
};
enum { I_X = 0, I_C, I_CONV_W_IN, I_CONV_W, I_CONV_W_OUT, I_KV_ADA_W, I_KV_ADA_B, I_W_KVF, I_B_F, I_ATTN_W_Q, I_ATTN_W_O, I_ADA_W, I_ADA_B, I_LN_G, I_LN_B, I_ROUTER_W, I_ROUTER_B, I_EXP_W_GU, I_EXP_B_GU, I_EXP_W_DOWN, I_EXP_B_DOWN, I_OUT, I_NPTR };
__device__ __forceinline__ const float* inp(const Frame& F, int i) {
    const unsigned long long v = ((const LAS unsigned long long*)(F.lds + PTRS_OFF))[i];
    const unsigned lo = __builtin_amdgcn_readfirstlane((unsigned)v), hi = __builtin_amdgcn_readfirstlane((unsigned)(v >> 32));
    return (const float*)(((unsigned long long)hi << 32) | lo);
}
template <class Tp> __device__ __forceinline__ Tp* wsp(const Frame& F, size_t off) { return (Tp*)(F.ws + off); }
template <class Tp> __device__ __forceinline__ Tp* wspo(const Frame& F, size_t off) { return (Tp*)(F.ws + off + (F.dup ? WS_END : (size_t)0)); }
template <int CTRL> __device__ __forceinline__ float dpp_mov(float v) { return __builtin_bit_cast(float, __builtin_amdgcn_update_dpp(0, __builtin_bit_cast(int, v), CTRL, 0xF, 0xF, true)); }
__device__ __forceinline__ float wave_sum(float v) {
    v += dpp_mov<0xB1>(v);
    v += dpp_mov<0x4E>(v);
    v += dpp_mov<0x141>(v);
    v += dpp_mov<0x140>(v);
    const int b = __builtin_bit_cast(int, v);
    return (__builtin_bit_cast(float, __builtin_amdgcn_readlane(b, 0)) + __builtin_bit_cast(float, __builtin_amdgcn_readlane(b, 16))) + (__builtin_bit_cast(float, __builtin_amdgcn_readlane(b, 32)) + __builtin_bit_cast(float, __builtin_amdgcn_readlane(b, 48)));
}
__device__ __forceinline__ f32x4 bf4_to_f32(u32x2 w) { f32x4 r; r.x = __builtin_bit_cast(float, w.x << 16); r.y = __builtin_bit_cast(float, w.x & 0xffff0000u); r.z = __builtin_bit_cast(float, w.y << 16); r.w = __builtin_bit_cast(float, w.y & 0xffff0000u); return r; }
__device__ __forceinline__ u32x2 f32_to_bf4(f32x4 v) { u32x2 r; r.x = pg8::cvt_pk_bf16(v.x, v.y); r.y = pg8::cvt_pk_bf16(v.z, v.w); return r; }

template <int N, int M> struct LaneRed {
    static __device__ __forceinline__ float run(float* r, int lane) {
        if constexpr (N > 1) {
            const bool up = (lane & M) != 0;
#pragma unroll
            for (int e = 0; e < N / 2; ++e) { const float keep = up ? r[e + N / 2] : r[e], send = up ? r[e] : r[e + N / 2]; r[e] = keep + __shfl_xor(send, M); }
            return LaneRed<N / 2, M / 2>::run(r, lane);
        } else {
            float v = r[0];
#pragma unroll
            for (int m = M; m >= 1; m >>= 1) v += __shfl_xor(v, m);
            return v;
        }
    }
};

__device__ __forceinline__ void p0_transpose_item(const float* W, int ldw, int K, bf16* WT, int k0, int n0, int drow, LAS float* scr, int lane) {
#pragma unroll 8
    for (int i = 0; i < 32; ++i) { const int kk = 2 * i + (lane >> 5); scr[kk * 33 + (lane & 31)] = W[(size_t)(k0 + kk) * ldw + n0 + (lane & 31)]; }
    LDS_WAIT(); asm volatile("" ::: "memory");
    const int c = lane & 7;
#pragma unroll
    for (int j = 0; j < 4; ++j) { const int n = (lane >> 3) + 8 * j; const LAS float* s = scr + (8 * c) * 33 + n;
        v4u o; o.x = pk2(s[0 * 33], s[1 * 33]); o.y = pk2(s[2 * 33], s[3 * 33]); o.z = pk2(s[4 * 33], s[5 * 33]); o.w = pk2(s[6 * 33], s[7 * 33]);
        *(GAS v4u*)(WT + (size_t)(drow + n) * K + k0 + 8 * c) = o; }
    LDS_WAIT(); asm volatile("" ::: "memory");
}
__device__ __forceinline__ int glu_row(int n0, int half) { const int isu = n0 >= half ? 1 : 0, np = n0 - isu * half; return 256 * (np >> 7) + 128 * isu + (np & 127); }

__device__ __forceinline__ void ph_prologue(Frame& F) {
    const int tid = F.tid, lane = F.lane, wave = F.wave;
    LAS float* condT = (LAS float*)(F.lds);
    LAS float* part = (LAS float*)(F.lds + 16384);
    const float* cin = inp(F, I_C); const float* ada_w = inp(F, I_ADA_W); const float* ada_b = inp(F, I_ADA_B); const float* kv_ada_w = inp(F, I_KV_ADA_W); const float* kv_ada_b = inp(F, I_KV_ADA_B);
    for (int i = tid; i < BATCH * D; i += NWAVES * 64) { const int b = i >> 10, k = i & 1023; const float cv = cin[i]; condT[k * 4 + b] = cv / (1.0f + expf(-cv)); }
    __syncthreads();
    float* MOD = wsp<float>(F, WS_MOD); float* KVMOD = wsp<float>(F, WS_KVMOD);
    for (int tk = blockIdx.x; tk < 208; tk += F.G) {
        const int c0 = tk * 128; const float* W; int ldw, col; const float* bias; float* dst; int dstld;
        if (c0 < 24576) { const int m = c0 / 3072; col = c0 - m * 3072; W = ada_w + (size_t)m * 1024 * 3072; ldw = 3072; bias = ada_b + m * 3072; dst = MOD + (size_t)m * 4 * 3072; dstld = 3072; }
        else { col = c0 - 24576; W = kv_ada_w; ldw = 2048; bias = kv_ada_b; dst = KVMOD; dstld = 2048; }
        float a0[4] = {0.f, 0.f, 0.f, 0.f}, a1[4] = {0.f, 0.f, 0.f, 0.f};
        const float* wp = W + (size_t)(wave * 128) * ldw + col + 2 * lane;
#pragma unroll 16
        for (int kk = 0; kk < 128; ++kk) { const f32x2 w2 = *(const f32x2*)(wp + (size_t)kk * ldw); const f32x4 c4 = *(const LAS f32x4*)(condT + (wave * 128 + kk) * 4);
#pragma unroll
            for (int b = 0; b < 4; ++b) { a0[b] += c4[b] * w2.x; a1[b] += c4[b] * w2.y; } }
#pragma unroll
        for (int b = 0; b < 4; ++b) { part[(wave * 4 + b) * 128 + 2 * lane] = a0[b]; part[(wave * 4 + b) * 128 + 2 * lane + 1] = a1[b]; }
        __syncthreads();
        { const int b = tid >> 7, cc = tid & 127; float s = bias[col + cc];
#pragma unroll
            for (int w = 0; w < 8; ++w) s += part[(w * 4 + b) * 128 + cc];
            dst[(size_t)b * dstld + col + cc] = s; }
        __syncthreads();
    }
    __syncthreads();
    {   const int gt = (F.vcu * NWAVES + wave) * 64 + lane, NGT = F.G * NWAVES * 64;
        float* WRT = wsp<float>(F, WS_WRT); float* WFT = wsp<float>(F, WS_WFT); const float* router_w = inp(F, I_ROUTER_W); const float* w_kvf = inp(F, I_W_KVF);
        { bf16* WH = (bf16*)WRT; bf16* WL = WH + DEPTH * NE * D;
          for (int i = gt; i < DEPTH * NE * D; i += NGT) { const int l = i >> 15, e = (i >> 10) & 31, k = i & 1023; const float w = router_w[((size_t)l * D + k) * NE + e];
              const unsigned hb = f2bf(w); const float hf = __builtin_bit_cast(float, hb << 16); WH[i] = (bf16)hb; WL[i] = (bf16)f2bf(w - hf); } }
        for (int i = gt; i < NH * D; i += NGT) { const int h = i >> 10, k = i & 1023; WFT[i] = w_kvf[(size_t)k * 2064 + 2048 + h]; }
        int* ident = wsp<int>(F, WS_IDENT); for (int i = gt; i < NSLOT_MAX; i += NGT) ident[i] = i;
    }
    LAS float* scr = (LAS float*)(F.lds + RING_OFF + wave * 16384);
    const int gw = F.vcu * NWAVES + wave, NGW = F.G * NWAVES;
    constexpr int I_CI = 2 * 8 * 96, I_CO = 2 * 8 * 32, I_KV = 8 * 64, I_Q = 2 * 8 * 32, I_O = 2 * 8 * 32, I_GU = 128 * 8 * 64, I_DN = 128 * 8 * 32;
    constexpr int NITEMS = I_CI + I_CO + I_KV + I_Q + I_O + I_GU + I_DN;
    const float* src_ci = inp(F, I_CONV_W_IN); const float* src_co = inp(F, I_CONV_W_OUT); const float* src_kv = inp(F, I_W_KVF); const float* src_q = inp(F, I_ATTN_W_Q); const float* src_o = inp(F, I_ATTN_W_O);
    const float* src_gu = inp(F, I_EXP_W_GU); const float* src_dn = inp(F, I_EXP_W_DOWN);
#define P0_DECODE(it_, SRC, LDW, DST, F8) do { int r = (it_); F8 = 0; \
        if (r < I_CI) { const int mtx = r / (8 * 96), q = r % (8 * 96), kb = q / 96, nb = q % 96, n0 = nb * 32; \
            int drow; if (n0 < 1024) drow = 256 * (n0 >> 7) + (n0 & 127); else if (n0 < 2048) drow = 2048 + (n0 - 1024); else { const int np = n0 - 2048; drow = 256 * (np >> 7) + 128 + (np & 127); } \
            SRC = src_ci + (size_t)mtx * D * 3072 + (size_t)(kb * 128) * 3072 + n0; LDW = 3072; \
            if (CONV_FP8) { DST = (bf16*)(F.ws + WS_WCI + (size_t)mtx * 3072 * D + (size_t)drow * D + kb * 128); F8 = WSH_QKV; } else DST = wsp<bf16>(F, WS_WCI) + (size_t)mtx * 3072 * D + (size_t)drow * D + kb * 128; break; } r -= I_CI; \
        if (r < I_CO) { const int mtx = r >> 8, q = r & 255, kb = q >> 5, nb = q & 31; SRC = src_co + (size_t)mtx * D * D + (size_t)(kb * 128) * D + nb * 32; LDW = D; \
            if (CONV2_FP8) { DST = (bf16*)(F.ws + WS_WCO + (size_t)mtx * D * D + (size_t)(nb * 32) * D + kb * 128); F8 = WSH_O; } else DST = wsp<bf16>(F, WS_WCO) + (size_t)mtx * D * D + (size_t)(nb * 32) * D + kb * 128; break; } r -= I_CO; \
        if (r < I_KV) { const int kb = r >> 6, nb = r & 63; SRC = src_kv + (size_t)(kb * 128) * 2064 + nb * 32; LDW = 2064; \
            if (QKV_FP8) { DST = (bf16*)(F.ws + WS_WKV + (size_t)(nb * 32) * D + kb * 128); F8 = WSH_QKV; } else DST = wsp<bf16>(F, WS_WKV) + (size_t)(nb * 32) * D + kb * 128; break; } r -= I_KV; \
        if (r < I_Q) { const int mtx = r >> 8, q = r & 255, kb = q >> 5, nb = q & 31; SRC = src_q + (size_t)mtx * D * D + (size_t)(kb * 128) * D + nb * 32; LDW = D; \
            if (QKV_FP8) { DST = (bf16*)(F.ws + WS_WQ + (size_t)mtx * D * D + (size_t)(nb * 32) * D + kb * 128); F8 = WSH_QKV; } else DST = wsp<bf16>(F, WS_WQ) + (size_t)mtx * D * D + (size_t)(nb * 32) * D + kb * 128; break; } r -= I_Q; \
        if (r < I_O) { const int mtx = r >> 8, q = r & 255, kb = q >> 5, nb = q & 31; SRC = src_o + (size_t)mtx * D * D + (size_t)(kb * 128) * D + nb * 32; LDW = D; \
            if (QKV_FP8) { DST = (bf16*)(F.ws + WS_WO + (size_t)mtx * D * D + (size_t)(nb * 32) * D + kb * 128); F8 = WSH_O; } else DST = wsp<bf16>(F, WS_WO) + (size_t)mtx * D * D + (size_t)(nb * 32) * D + kb * 128; break; } r -= I_O; \
        if (r < I_GU) { const int mtx = r >> 9, q = r & 511, kb = q >> 6, nb = q & 63, n0 = nb * 32; SRC = src_gu + (size_t)mtx * D * 2048 + (size_t)(kb * 128) * 2048 + n0; LDW = 2048; \
            DST = (bf16*)(F.ws + WS_WGU + ((size_t)mtx * 2048 * D + (size_t)glu_row(n0, 1024) * D + kb * 128) * (MOE_FP8 ? 1 : 2)); F8 = WSH_GU; break; } r -= I_GU; \
        { const int mtx = r >> 8, q = r & 255, kb = q >> 5, nb = q & 31; SRC = src_dn + (size_t)mtx * FF * D + (size_t)(kb * 128) * D + nb * 32; LDW = D; \
            DST = (bf16*)(F.ws + WS_WD + ((size_t)mtx * D * FF + (size_t)(nb * 32) * FF + kb * 128) * (MOE_FP8 ? 1 : 2)); F8 = WSH_DN; } } while (0)
#define P0_LOAD(V, SRC, LDW) do { const float* p_ = (SRC) + (size_t)(lane >> 3) * (LDW) + 4 * (lane & 7); _Pragma("unroll") for (int g_ = 0; g_ < 16; ++g_) V[g_] = __builtin_nontemporal_load((const f32x4*)(p_ + (size_t)(8 * g_) * (LDW))); } while (0)
#define P0_SWZ(k_) ((((k_) >> 4) & 1) << 2 ^ ((k_) & 3))
#define P0_XPOSE(V, DST, F8) do { \
        _Pragma("unroll") for (int g_ = 0; g_ < 16; ++g_) { const int k_ = 8 * g_ + (lane >> 3); *(LAS f32x4*)(scr + k_ * 32 + ((((lane & 7) ^ P0_SWZ(k_)) & 7) << 2)) = V[g_]; } \
        LDS_WAIT(); asm volatile("" ::: "memory"); \
        { const int n_ = lane >> 1, h_ = lane & 1;     \
        if (F8) { const float sc_ = (float)(1 << (F8)); \
          _Pragma("unroll") for (int q_ = 0; q_ < 4; ++q_) { int w_[4]; \
            _Pragma("unroll") for (int d_ = 0; d_ < 4; ++d_) { float e_[4]; \
                _Pragma("unroll") for (int j_ = 0; j_ < 4; ++j_) { const int k_ = 32 * q_ + 16 * h_ + 4 * d_ + j_; e_[j_] = scr[k_ * 32 + (((((n_ >> 2) ^ P0_SWZ(k_)) & 7) << 2) | (n_ & 3))] * sc_; } \
                int t_ = 0; t_ = __builtin_amdgcn_cvt_pk_fp8_f32(e_[0], e_[1], t_, false); t_ = __builtin_amdgcn_cvt_pk_fp8_f32(e_[2], e_[3], t_, true); w_[d_] = t_; } \
            v4u o_; o_.x = (unsigned)w_[0]; o_.y = (unsigned)w_[1]; o_.z = (unsigned)w_[2]; o_.w = (unsigned)w_[3]; \
            *(GAS v4u*)((unsigned char*)(DST) + (size_t)n_ * 1024 + 32 * q_ + 16 * h_) = o_; } } \
        else { \
          _Pragma("unroll") for (int q_ = 0; q_ < 8; ++q_) { float e_[8];     \
            _Pragma("unroll") for (int j_ = 0; j_ < 8; ++j_) { const int k_ = 16 * q_ + 8 * h_ + j_; e_[j_] = scr[k_ * 32 + (((((n_ >> 2) ^ P0_SWZ(k_)) & 7) << 2) | (n_ & 3))]; } \
            v4u o_; o_.x = pk2(e_[0], e_[1]); o_.y = pk2(e_[2], e_[3]); o_.z = pk2(e_[4], e_[5]); o_.w = pk2(e_[6], e_[7]); \
            *(GAS v4u*)((DST) + (size_t)n_ * 1024 + 16 * q_ + 8 * h_) = o_; } } } \
        LDS_WAIT(); asm volatile("" ::: "memory"); } while (0)
    {   f32x4 va[16], vb[16]; const float* sa; const float* sb; int la, lb_, fa = 0, fb = 0; bf16* da; bf16* db;
        int it = gw;
        if (it < NITEMS) { P0_DECODE(it, sa, la, da, fa); P0_LOAD(va, sa, la); }
        while (it < NITEMS) {
            const int it1 = it + NGW, it2 = it + 2 * NGW;
            if (it1 < NITEMS) { P0_DECODE(it1, sb, lb_, db, fb); P0_LOAD(vb, sb, lb_); }
            P0_XPOSE(va, da, fa);
            if (it1 >= NITEMS) break;
            if (it2 < NITEMS) { P0_DECODE(it2, sa, la, da, fa); P0_LOAD(va, sa, la); }
            P0_XPOSE(vb, db, fb);
            it = it2;
        }
    }
#undef P0_DECODE
#undef P0_LOAD
#undef P0_SWZ
#undef P0_XPOSE
}

__device__ __forceinline__ unsigned f32_to_fp8x4(f32x4 h) { int w8 = 0; w8 = __builtin_amdgcn_cvt_pk_fp8_f32(h.x, h.y, w8, false); w8 = __builtin_amdgcn_cvt_pk_fp8_f32(h.z, h.w, w8, true); return (unsigned)w8; }
__device__ __forceinline__ void ph_mod0(Frame& F) {
    const float* MOD = wsp<float>(F, WS_MOD); bf16* HB = wsp<bf16>(F, WS_HB); const float* xin = inp(F, I_X);
    const int gw = F.vcu * NWAVES + F.wave, NGW = F.G * NWAVES, lane = F.lane;
    for (int row0 = gw * 16; row0 < T; row0 += NGW * 16) {
        const int b = row0 >> 13; const float* mp = MOD + (size_t)b * 3072;
        f32x4 sh[4], sc[4];
#pragma unroll
        for (int j = 0; j < 4; ++j) { sh[j] = *(const f32x4*)(mp + 4 * lane + 256 * j); sc[j] = *(const f32x4*)(mp + 1024 + 4 * lane + 256 * j) + 1.0f; }
        for (int i = 0; i < 16; i += 4) { f32x4 xv[4][4];
#pragma unroll
            for (int r = 0; r < 4; ++r)
#pragma unroll
                for (int j = 0; j < 4; ++j) xv[r][j] = __builtin_nontemporal_load((const f32x4*)(xin + (size_t)(row0 + i + r) * D + 4 * lane + 256 * j));
#pragma unroll
            for (int r = 0; r < 4; ++r)
#pragma unroll
                for (int j = 0; j < 4; ++j) {
                    if (CONV_FP8) *(unsigned*)(wsp<unsigned char>(F, WS_HB8) + (size_t)(row0 + i + r) * D + 4 * lane + 256 * j) = f32_to_fp8x4(xv[r][j] * sc[j] + sh[j]);
                    else *(u32x2*)(HB + (size_t)(row0 + i + r) * D + 4 * lane + 256 * j) = f32_to_bf4(xv[r][j] * sc[j] + sh[j]); } }
    }
}

__device__ __forceinline__ void ph_conv(Frame& F, int l) {
    const bf16* ZB = wsp<bf16>(F, WS_ZB); const bf16* GB = wsp<bf16>(F, WS_GB); bf16* YB = wsp<bf16>(F, WS_YB);
    const float* cw = inp(F, I_CONV_W) + (size_t)l * 3 * D;
    const int gw = F.vcu * NWAVES + F.wave, NGW = F.G * NWAVES, lane = F.lane;
    for (int task = gw; task < (T / 16) * 2; task += NGW) {
        const int row0 = (task >> 1) * 16, ch = (task & 1) * 512 + lane * 8;
        f32x4 w0[2], w1[2], w2[2];
#pragma unroll
        for (int q = 0; q < 2; ++q) { w0[q] = *(const f32x4*)(cw + ch + 4 * q); w1[q] = *(const f32x4*)(cw + D + ch + 4 * q); w2[q] = *(const f32x4*)(cw + 2 * D + ch + 4 * q); }
        f32x4 zm2[2], zm1[2];
        if ((row0 & (SEQ - 1)) == 0) { zm2[0] = zm2[1] = zm1[0] = zm1[1] = (f32x4){0.f, 0.f, 0.f, 0.f}; }
        else { const v4u a = *(const v4u*)(ZB + (size_t)(row0 - 2) * D + ch), b = *(const v4u*)(ZB + (size_t)(row0 - 1) * D + ch);
            zm2[0] = bf4_to_f32((u32x2){a.x, a.y}); zm2[1] = bf4_to_f32((u32x2){a.z, a.w}); zm1[0] = bf4_to_f32((u32x2){b.x, b.y}); zm1[1] = bf4_to_f32((u32x2){b.z, b.w}); }
#pragma unroll 4
        for (int i = 0; i < 16; ++i) { const size_t o = (size_t)(row0 + i) * D + ch;
            const v4u zz = *(const v4u*)(ZB + o), gg = *(const v4u*)(GB + o);
            f32x4 z[2], g[2]; z[0] = bf4_to_f32((u32x2){zz.x, zz.y}); z[1] = bf4_to_f32((u32x2){zz.z, zz.w}); g[0] = bf4_to_f32((u32x2){gg.x, gg.y}); g[1] = bf4_to_f32((u32x2){gg.z, gg.w});
            f32x4 y[2];
#pragma unroll
            for (int q = 0; q < 2; ++q) { y[q] = g[q] * (w0[q] * zm2[q] + w1[q] * zm1[q] + w2[q] * z[q]); zm2[q] = zm1[q]; zm1[q] = z[q]; }
            if (CONV2_FP8) *(u32x2*)((unsigned char*)YB + o) = (u32x2){f32_to_fp8x4(y[0]), f32_to_fp8x4(y[1])};
            else { const u32x2 p0 = f32_to_bf4(y[0]), p1 = f32_to_bf4(y[1]);
                *(v4u*)(YB + o) = (v4u){p0.x, p0.y, p1.x, p1.y}; } }
    }
}

__device__ __forceinline__ void ld16(const float* p, f32x4 (&v)[4], int lane) {
#pragma unroll
    for (int j = 0; j < 4; ++j) v[j] = *(const f32x4*)(p + 4 * lane + 256 * j);
}
#define LN1_COL(lane_, q_) (((q_) >> 1) * 512 + 8 * (lane_) + 4 * ((q_) & 1))
__device__ __forceinline__ void ld16c(const float* p, f32x4 (&v)[4], int lane) {
#pragma unroll
    for (int q = 0; q < 4; ++q) v[q] = *(const f32x4*)(p + LN1_COL(lane, q));
}
__device__ __forceinline__ void bf8_to_f32(v4u w, f32x4& a, f32x4& b) { a = bf4_to_f32((u32x2){w.x, w.y}); b = bf4_to_f32((u32x2){w.z, w.w}); }
__device__ __forceinline__ f32x4 fp8x4_to_f32(unsigned w) { const f32x2 lo = __builtin_amdgcn_cvt_pk_f32_fp8((int)w, false), hi = __builtin_amdgcn_cvt_pk_f32_fp8((int)w, true); return (f32x4){lo.x, lo.y, hi.x, hi.y}; }
typedef GAS v4u gv4u; typedef GAS f32x4 gf32x4; typedef GAS u32x2 gu32x2;
__device__ __forceinline__ void ln1_kv(Frame& F, const f32x4 (&v)[4], size_t ro, int row, int lo_, int lane, LAS f32x4* WL, LAS f32x4* VL, float bfv) {
    bf16* HKV = wspo<bf16>(F, WS_HKV);
    f32x4 kv[4];
#pragma unroll
    for (int q = 0; q < 4; ++q) kv[q] = v[q] * VL[1280 + 64 * q + lo_] + VL[1536 + 64 * q + lo_];
    if (QKV_FP8) { *(gu32x2*)((unsigned char*)HKV + ro + 8 * lane) = (u32x2){f32_to_fp8x4(kv[0]), f32_to_fp8x4(kv[1])}; *(gu32x2*)((unsigned char*)HKV + ro + 512 + 8 * lane) = (u32x2){f32_to_fp8x4(kv[2]), f32_to_fp8x4(kv[3])}; }
    else { const u32x2 p0 = f32_to_bf4(kv[0]), p1 = f32_to_bf4(kv[1]), p2 = f32_to_bf4(kv[2]), p3 = f32_to_bf4(kv[3]);
        *(gv4u*)(HKV + ro + 8 * lane) = (v4u){p0.x, p0.y, p1.x, p1.y}; *(gv4u*)(HKV + ro + 512 + 8 * lane) = (v4u){p2.x, p2.y, p3.x, p3.y}; }
    f32x2 a2[NH];
#pragma unroll
    for (int e = 0; e < NH; ++e) { a2[e] = (f32x2){0.f, 0.f};
#pragma unroll
        for (int q = 0; q < 4; ++q) { const f32x4 w = WL[e * 256 + 64 * q + lane]; a2[e] += (f32x2){kv[q].x, kv[q].y} * (f32x2){w.x, w.y}; a2[e] += (f32x2){kv[q].z, kv[q].w} * (f32x2){w.z, w.w}; } }
    float rr_[NH];
#pragma unroll
    for (int e = 0; e < NH; ++e) rr_[e] = a2[e].x + a2[e].y;
    const int hh = lane >> 2;
    const float z = LaneRed<NH, 32>::run(rr_, lane) + bfv;
    const float lf = fminf(z, 0.f) - log1pf(expf(-fabsf(z)));
    if ((lane & 3) == 0) ((GAS float*)wspo<float>(F, WS_LOGF))[(size_t)row * NH + hh] = lf;
}
__device__ __forceinline__ void ph_ln1(Frame& F, int l, const bf16* xinb, void* xout_, unsigned poison) {
    const bool out_f32 = (l == DEPTH - 1), has_next = (l < DEPTH - 1), do_kv = (l == 1);
    float* xout = (float*)xout_; bf16* xoutb = (bf16*)xout_;
    const int tid = F.tid, lane = F.lane, wave = F.wave;
    const float* MOD = wsp<float>(F, WS_MOD);
    bf16* HB = wspo<bf16>(F, WS_HB); unsigned char* HB8 = F.dup ? wsp<unsigned char>(F, WS_A1 + WS_END) : wsp<unsigned char>(F, WS_HB8);
    LAS f32x4* WL = (LAS f32x4*)(F.lds);
    if (do_kv) { const float* src = wsp<float>(F, WS_WFT); for (int i = tid; i < NH * D / 4; i += NWAVES * 64) { const int e = i >> 8, r = i & 255, q = r >> 6, ln = r & 63; WL[i] = *(const f32x4*)(src + (size_t)e * D + LN1_COL(ln, q)); } }
    __syncthreads();
    const float* lgp = inp(F, I_LN_G) + (size_t)(l * 2 + 1) * D; const float* lbp = inp(F, I_LN_B) + (size_t)(l * 2 + 1) * D;
    const float* b_f = inp(F, I_B_F);
    const int nm = (l + 1) * 2;
    const unsigned char* Y2 = wsp<unsigned char>(F, WS_Y2);
    const int* slot_of = wsp<int>(F, WS_SLOTOF); const float* tkw = wsp<float>(F, WS_TKW);
    const float qnan = __builtin_nanf("");
    LAS f32x4* VL = (LAS f32x4*)(F.lds + 65536);
    for (int g = F.vcu; g < NGROUP; g += F.G) {
        const int row0 = g * 128 + wave * 16, b = row0 >> 13;
        __syncthreads();
        if (tid < 256) { const int q = tid >> 6, ln = tid & 63, col = LN1_COL(ln, q);
            VL[tid] = *(const gf32x4*)(lbp + col);
            if (has_next) { VL[256 + tid] = *(const gf32x4*)(MOD + ((size_t)nm * 4 + b) * 3072 + 1024 + col) + 1.0f; VL[512 + tid] = *(const gf32x4*)(MOD + ((size_t)nm * 4 + b) * 3072 + col); }
            VL[768 + tid] = *(const gf32x4*)(MOD + ((size_t)(l * 2 + 1) * 4 + b) * 3072 + 2048 + col) + 1.0f; VL[1024 + tid] = *(const gf32x4*)(lgp + col);
            if (do_kv) { const float* kvm = wsp<float>(F, WS_KVMOD) + (size_t)b * 2048; VL[1280 + tid] = *(const gf32x4*)(kvm + 1024 + col) + 1.0f; VL[1536 + tid] = *(const gf32x4*)(kvm + col); } }
        __syncthreads();
        const float bfv = do_kv ? ((const GAS float*)b_f)[lane >> 2] : 0.f;
        i32x4 so_all; f32x4 tw_all;
        { const int rr = row0 + (lane & 15); so_all = *(const GAS i32x4*)(slot_of + (size_t)rr * 4); tw_all = *(const gf32x4*)(tkw + (size_t)rr * 4); }
        const int s0 = so_all.x, s1 = so_all.y, s2 = so_all.z, s3 = so_all.w; const float t0 = tw_all.x, t1 = tw_all.y, t2 = tw_all.z, t3 = tw_all.w;
#define LN1_LOAD(XV, YV, TW, ii) do { _Pragma("unroll") for (int r = 0; r < 2; ++r) { const size_t ro = (size_t)(row0 + (ii) + r) * D; int so[4]; \
            so[0] = __builtin_amdgcn_readlane(s0, (ii) + r); so[1] = __builtin_amdgcn_readlane(s1, (ii) + r); so[2] = __builtin_amdgcn_readlane(s2, (ii) + r); so[3] = __builtin_amdgcn_readlane(s3, (ii) + r); \
            TW[r][0] = __int_as_float(__builtin_amdgcn_readlane(__float_as_int(t0), (ii) + r)); TW[r][1] = __int_as_float(__builtin_amdgcn_readlane(__float_as_int(t1), (ii) + r)); \
            TW[r][2] = __int_as_float(__builtin_amdgcn_readlane(__float_as_int(t2), (ii) + r)); TW[r][3] = __int_as_float(__builtin_amdgcn_readlane(__float_as_int(t3), (ii) + r)); \
            XV[r][0] = *(const gv4u*)(xinb + ro + 8 * lane); XV[r][1] = *(const gv4u*)(xinb + ro + 512 + 8 * lane); \
            _Pragma("unroll") for (int k = 0; k < 4; ++k) { \
                if (Y2_FP8) { const u32x2 lo2_ = *(const gu32x2*)(Y2 + (size_t)so[k] * D + 8 * lane), hi2_ = *(const gu32x2*)(Y2 + (size_t)so[k] * D + 512 + 8 * lane); YV[r][k][0] = (v4u){lo2_.x, lo2_.y, hi2_.x, hi2_.y}; } \
                else { YV[r][k][0] = *(const gv4u*)(Y2 + ((size_t)so[k] * D + 8 * lane) * 2); YV[r][k][Y2_FP8 ? 0 : 1] = *(const gv4u*)(Y2 + ((size_t)so[k] * D + 512 + 8 * lane) * 2); } } } } while (0)
#define LN1_BODY(XV, YV, TW, ii) do { _Pragma("unroll") for (int r = 0; r < 2; ++r) { const int row = row0 + (ii) + r; const size_t ro = (size_t)row * D; \
            f32x4 v[4], s[4]; float s1_ = 0.f; int lo_ = lane; asm volatile("" : "+v"(lo_)); \
            _Pragma("unroll") for (int q = 0; q < 4; ++q) s[q] = (f32x4){0.f, 0.f, 0.f, 0.f}; \
            _Pragma("unroll") for (int k = 0; k < 4; ++k) { f32x4 y[4]; \
                if (Y2_FP8) { y[0] = fp8x4_to_f32(YV[r][k][0].x); y[1] = fp8x4_to_f32(YV[r][k][0].y); y[2] = fp8x4_to_f32(YV[r][k][0].z); y[3] = fp8x4_to_f32(YV[r][k][0].w); } \
                else { bf8_to_f32(YV[r][k][0], y[0], y[1]); bf8_to_f32(YV[r][k][Y2_FP8 ? 0 : 1], y[2], y[3]); } \
                _Pragma("unroll") for (int q = 0; q < 4; ++q) s[q] = s[q] + y[q] * TW[r][k]; } \
            bf8_to_f32(XV[r][0], v[0], v[1]); bf8_to_f32(XV[r][1], v[2], v[3]); \
            _Pragma("unroll") for (int q = 0; q < 4; ++q) { v[q] = v[q] * DN_ALPHA + VL[768 + 64 * q + lo_] * s[q]; s1_ += (v[q].x + v[q].y) + (v[q].z + v[q].w); } \
            const float mean = wave_sum(s1_) * (1.0f / D); float s2_ = 0.f; \
            _Pragma("unroll") for (int q = 0; q < 4; ++q) { v[q] = v[q] - mean; s2_ += (v[q].x * v[q].x + v[q].y * v[q].y) + (v[q].z * v[q].z + v[q].w * v[q].w); } \
            const float rstd = 1.0f / sqrtf(wave_sum(s2_) * (1.0f / D) + LN_EPS); \
            f32x4 h[4]; \
            _Pragma("unroll") for (int q = 0; q < 4; ++q) { v[q] = v[q] * rstd * VL[1024 + 64 * q + lo_] + VL[64 * q + lo_]; h[q] = v[q] * VL[256 + 64 * q + lo_] + VL[512 + 64 * q + lo_]; } \
            if (out_f32) { _Pragma("unroll") for (int q = 0; q < 4; ++q) *(gf32x4*)(xout + ro + LN1_COL(lane, q)) = poison ? (f32x4){qnan, qnan, qnan, qnan} : v[q]; } \
            else { const u32x2 p0 = f32_to_bf4(v[0]), p1 = f32_to_bf4(v[1]), p2 = f32_to_bf4(v[2]), p3 = f32_to_bf4(v[3]); \
                *(gv4u*)(xoutb + ro + 8 * lane) = (v4u){p0.x, p0.y, p1.x, p1.y}; *(gv4u*)(xoutb + ro + 512 + 8 * lane) = (v4u){p2.x, p2.y, p3.x, p3.y}; } \
            if (has_next) { \
                if (QKV_FP8 && (CONV_FP8 || l >= 1)) { *(gu32x2*)(HB8 + ro + 8 * lane) = (u32x2){f32_to_fp8x4(h[0]), f32_to_fp8x4(h[1])}; *(gu32x2*)(HB8 + ro + 512 + 8 * lane) = (u32x2){f32_to_fp8x4(h[2]), f32_to_fp8x4(h[3])}; } \
                else { const u32x2 p0 = f32_to_bf4(h[0]), p1 = f32_to_bf4(h[1]), p2 = f32_to_bf4(h[2]), p3 = f32_to_bf4(h[3]); \
                    *(gv4u*)(HB + ro + 8 * lane) = (v4u){p0.x, p0.y, p1.x, p1.y}; *(gv4u*)(HB + ro + 512 + 8 * lane) = (v4u){p2.x, p2.y, p3.x, p3.y}; } } \
            if (do_kv) ln1_kv(F, v, ro, row, lo_, lane, WL, VL, bfv); } } while (0)
        v4u xA[2][2], yA[2][4][Y2_FP8 ? 1 : 2], xB[2][2], yB[2][4][Y2_FP8 ? 1 : 2]; float tA[2][4], tB[2][4];
        LN1_LOAD(xA, yA, tA, 0);
        for (int i = 0; i < 16; i += 4) {
            LN1_LOAD(xB, yB, tB, i + 2);
            LN1_BODY(xA, yA, tA, i);
            if (i + 4 < 16) LN1_LOAD(xA, yA, tA, i + 4);
            LN1_BODY(xB, yB, tB, i + 2);
        }
#undef LN1_LOAD
#undef LN1_BODY
    }
}

constexpr int LN0_PITCH = 2064;
constexpr int LN0_HHI = 0, LN0_HLO = 16 * LN0_PITCH, LN0_P = 2 * 16 * LN0_PITCH;
__device__ __forceinline__ void ph_ln0(Frame& F, int l, const void* xin_, bf16* xout) {
    const int tid = F.tid, lane = F.lane, wave = F.wave;
    const bool in_f32 = (l == 0);
    const float* xin = (const float*)xin_; const bf16* xinb = (const bf16*)xin_;
    const float* MOD = wsp<float>(F, WS_MOD);
    LAS int* hist = (LAS int*)(F.lds + HIST_OFF);
    LAS unsigned char* L = F.lds;
    if (tid < 32) hist[tid] = 0;
    const float* lgp = inp(F, I_LN_G) + (size_t)(l * 2) * D; const float* lbp = inp(F, I_LN_B) + (size_t)(l * 2) * D;
    const float* router_b = inp(F, I_ROUTER_B) + l * NE;
    const bf16* SUB = wsp<bf16>(F, WS_SUB); float* tkw = wspo<float>(F, WS_TKW); int* tki = wspo<int>(F, WS_TKI);
    unsigned char* HB8 = F.dup ? wsp<unsigned char>(F, WS_A1 + WS_END) : wsp<unsigned char>(F, WS_HB8);
    bf16* HBb = wspo<bf16>(F, WS_HB);
    pg8::bf16x8 bh[2][4];
    const bf16* WLo_ = (const bf16*)wsp<float>(F, WS_WRT) + (size_t)l * NE * D + DEPTH * NE * D;
    { const bf16* WH = (const bf16*)wsp<float>(F, WS_WRT) + (size_t)l * NE * D;
#pragma unroll
      for (int hf = 0; hf < 2; ++hf)
#pragma unroll
          for (int s = 0; s < 4; ++s) { const size_t o = (size_t)(16 * hf + (lane & 15)) * D + 128 * wave + 32 * s + 8 * (lane >> 4);
              bh[hf][s] = *(const pg8::bf16x8*)(WH + o); } }
    __syncthreads();
    for (int g = F.vcu; g < NGROUP; g += F.G) {
        const int b = (g * 128) >> 13;
        f32x4 g1[4], lg[4], lb[4], msc[4], msh[4];
        ld16(MOD + ((size_t)(l * 2) * 4 + b) * 3072 + 2048, g1, lane); ld16(lgp, lg, lane); ld16(lbp, lb, lane);
        ld16(MOD + ((size_t)(l * 2 + 1) * 4 + b) * 3072, msh, lane); ld16(MOD + ((size_t)(l * 2 + 1) * 4 + b) * 3072 + 1024, msc, lane);
#pragma unroll
        for (int j = 0; j < 4; ++j) { g1[j] = g1[j] + 1.0f; msc[j] = msc[j] + 1.0f; }
        u32x2 xn[2][4], svn[2][4];
#define LN0_LOADROWS(cc) do { const int rr0_ = g * 128 + 16 * (cc) + 2 * wave; _Pragma("unroll") for (int r = 0; r < 2; ++r) { const size_t ro = (size_t)(rr0_ + r) * D; \
            if (!in_f32) { _Pragma("unroll") for (int j = 0; j < 4; ++j) xn[r][j] = *(const u32x2*)(xinb + ro + 4 * lane + 256 * j); } \
            _Pragma("unroll") for (int j = 0; j < 4; ++j) svn[r][j] = *(const u32x2*)(SUB + ro + 4 * lane + 256 * j); } } while (0)
        LN0_LOADROWS(0);
        for (int c = 0; c < 8; ++c) {
            const int r0 = g * 128 + 16 * c + 2 * wave;
            f32x4 v[2][4]; u32x2 sv[2][4];
#pragma unroll
            for (int r = 0; r < 2; ++r)
#pragma unroll
                for (int j = 0; j < 4; ++j) { sv[r][j] = svn[r][j]; if (!in_f32) v[r][j] = bf4_to_f32(xn[r][j]); }
            if (in_f32) { ld16(xin + (size_t)r0 * D, v[0], lane); ld16(xin + (size_t)(r0 + 1) * D, v[1], lane); }
#pragma unroll
            for (int r = 0; r < 2; ++r) { const size_t ro = (size_t)(r0 + r) * D;
                float s1 = 0.f;
#pragma unroll
                for (int j = 0; j < 4; ++j) { v[r][j] = v[r][j] * DN_ALPHA + g1[j] * bf4_to_f32(sv[r][j]); s1 += (v[r][j].x + v[r][j].y) + (v[r][j].z + v[r][j].w); }
                const float mean = wave_sum(s1) * (1.0f / D); float s2 = 0.f;
#pragma unroll
                for (int j = 0; j < 4; ++j) { v[r][j] = v[r][j] - mean; s2 += (v[r][j].x * v[r][j].x + v[r][j].y * v[r][j].y) + (v[r][j].z * v[r][j].z + v[r][j].w * v[r][j].w); }
                const float rstd = 1.0f / sqrtf(wave_sum(s2) * (1.0f / D) + LN_EPS);
#pragma unroll
                for (int j = 0; j < 4; ++j) { const f32x4 xo = v[r][j] * rstd * lg[j] + lb[j]; *(u32x2*)(xout + ro + 4 * lane + 256 * j) = f32_to_bf4(xo);
                    const f32x4 h = xo * msc[j] + msh[j];
                    if (MOE_FP8) { int w8 = 0; w8 = __builtin_amdgcn_cvt_pk_fp8_f32(h.x, h.y, w8, false); w8 = __builtin_amdgcn_cvt_pk_fp8_f32(h.z, h.w, w8, true); *(int*)(HB8 + ro + 4 * lane + 256 * j) = w8; }
                    else *(u32x2*)(HBb + ro + 4 * lane + 256 * j) = f32_to_bf4(h);
                    const u32x2 hh = f32_to_bf4(h); const f32x4 hr = bf4_to_f32(hh); const u32x2 hl = f32_to_bf4(h - hr);
                    *(LAS u32x2*)(L + LN0_HHI + (2 * wave + r) * LN0_PITCH + (4 * lane + 256 * j) * 2) = hh;
                    *(LAS u32x2*)(L + LN0_HLO + (2 * wave + r) * LN0_PITCH + (4 * lane + 256 * j) * 2) = hl; }
            }
            if (c + 1 < 8) LN0_LOADROWS(c + 1);
            pg8::bf16x8 bl[2][4];
#pragma unroll
            for (int hf = 0; hf < 2; ++hf)
#pragma unroll
                for (int s = 0; s < 4; ++s) bl[hf][s] = *(const pg8::bf16x8*)(WLo_ + (size_t)(16 * hf + (lane & 15)) * D + 128 * wave + 32 * s + 8 * (lane >> 4));
            __syncthreads();
            {   pg8::f32x4 acc[2]; acc[0] = (pg8::f32x4){0.f, 0.f, 0.f, 0.f}; acc[1] = acc[0];
                const int aoff = (lane & 15) * LN0_PITCH + (128 * wave + 8 * (lane >> 4)) * 2;
#pragma unroll
                for (int s = 0; s < 4; ++s) { const pg8::bf16x8 ah = *(const LAS pg8::bf16x8*)(L + LN0_HHI + aoff + 64 * s), al = *(const LAS pg8::bf16x8*)(L + LN0_HLO + aoff + 64 * s);
#pragma unroll
                    for (int hf = 0; hf < 2; ++hf) { acc[hf] = __builtin_amdgcn_mfma_f32_16x16x32_bf16(ah, bh[hf][s], acc[hf], 0, 0, 0); acc[hf] = __builtin_amdgcn_mfma_f32_16x16x32_bf16(ah, bl[hf][s], acc[hf], 0, 0, 0);
                        acc[hf] = __builtin_amdgcn_mfma_f32_16x16x32_bf16(al, bh[hf][s], acc[hf], 0, 0, 0); } }
                LAS float* P = (LAS float*)(L + LN0_P) + wave * 512;
#pragma unroll
                for (int hf = 0; hf < 2; ++hf)
#pragma unroll
                    for (int q = 0; q < 4; ++q) P[(4 * (lane >> 4) + q) * 32 + 16 * hf + (lane & 15)] = acc[hf][q];
            }
            __syncthreads();
            {   const int t16 = tid >> 5, e = tid & 31; const LAS float* P = (const LAS float*)(L + LN0_P) + t16 * 32 + e;
                float lv = router_b[e];
#pragma unroll
                for (int w = 0; w < 8; ++w) lv += P[w * 512];
                float tv[4]; int ti[4];
#pragma unroll
                for (int k = 0; k < 4; ++k) { float m = lv; int mi = e;
#define LN0_ARGMAX(OM, OI) do { const float om = (OM); const int oi = (OI); const bool take = (om > m) || (om == m && oi < mi); m = take ? om : m; mi = take ? oi : mi; } while (0)
                    LN0_ARGMAX(dpp_mov<0xB1>(m), __builtin_amdgcn_update_dpp(0, mi, 0xB1, 0xF, 0xF, true));
                    LN0_ARGMAX(dpp_mov<0x4E>(m), __builtin_amdgcn_update_dpp(0, mi, 0x4E, 0xF, 0xF, true));
                    LN0_ARGMAX(dpp_mov<0x141>(m), __builtin_amdgcn_update_dpp(0, mi, 0x141, 0xF, 0xF, true));
                    LN0_ARGMAX(dpp_mov<0x140>(m), __builtin_amdgcn_update_dpp(0, mi, 0x140, 0xF, 0xF, true));
                    LN0_ARGMAX(__shfl_xor(m, 16), __shfl_xor(mi, 16));
#undef LN0_ARGMAX
                    tv[k] = m; ti[k] = mi; if (e == mi) lv = -INFINITY; }
                const float e1 = expf(tv[1] - tv[0]), e2 = expf(tv[2] - tv[0]), e3 = expf(tv[3] - tv[0]); const float inv = 1.0f / (1.0f + e1 + e2 + e3);
                const int row = g * 128 + 16 * c + t16;
                if (e == 0) { *(i32x4*)(tki + (size_t)row * 4) = (i32x4){ti[0], ti[1], ti[2], ti[3]}; *(f32x4*)(tkw + (size_t)row * 4) = (f32x4){inv, e1 * inv, e2 * inv, e3 * inv}; }
                if (e < 4) { const int ee = e == 0 ? ti[0] : e == 1 ? ti[1] : e == 2 ? ti[2] : ti[3]; __hip_atomic_fetch_add(hist + ee, 1, __ATOMIC_RELAXED, __HIP_MEMORY_SCOPE_WORKGROUP); }
            }
        }
#undef LN0_LOADROWS
        __syncthreads(); if (tid < 32) { wspo<int>(F, WS_BLKCNT)[g * 32 + tid] = hist[tid]; hist[tid] = 0; } __syncthreads();
    }
}

__device__ __forceinline__ void ph_slot(Frame& F) {
    const int tid = F.tid;
    LAS int* cnt = (LAS int*)(F.lds);
    LAS int* sw = (LAS int*)(F.lds + SLOTW_OFF);
    const int* blk = wsp<int>(F, WS_BLKCNT);
    for (int i = tid; i < NGROUP * 32 / 4; i += NWAVES * 64) ((LAS i32x4*)cnt)[i] = ((const i32x4*)blk)[i];
    __syncthreads();
    LAS int* PS = cnt + NGROUP * 32;
    { const int e = tid & 31, part = tid >> 5; int s = 0;
#pragma unroll
      for (int q = 0; q < 16; ++q) s += cnt[(part * 16 + q) * 32 + e];
      PS[part * 32 + e] = s; }
    __syncthreads();
    if (tid < 32) { int s = 0;
#pragma unroll
        for (int p = 0; p < 16; ++p) s += PS[p * 32 + tid];
        sw[tid] = s; }
    __syncthreads();
    if (tid == 0) { int acc = 0; for (int e = 0; e < NE; ++e) { sw[32 + e] = acc; acc += (sw[e] + 255) >> 8; } sw[128] = acc; }
    __syncthreads();
    const int* tki = wsp<int>(F, WS_TKI); int* slot_of = wsp<int>(F, WS_SLOTOF); int* slot_tok = wsp<int>(F, WS_SLOTTOK);
    for (int g = F.vcu; g < NGROUP; g += F.G) {
        if (tid < 32) { int s = 0; const int gp = g >> 4; for (int p = 0; p < gp; ++p) s += PS[p * 32 + tid]; for (int gq = gp * 16; gq < g; ++gq) s += cnt[gq * 32 + tid]; sw[96 + tid] = sw[32 + tid] * 256 + s; }
        __syncthreads();
        { const int a = g * 512 + tid; const int e = tki[a]; const int slot = __hip_atomic_fetch_add(sw + 96 + e, 1, __ATOMIC_RELAXED, __HIP_MEMORY_SCOPE_WORKGROUP); slot_of[a] = slot; slot_tok[slot] = a >> 2; }
        __syncthreads();
    }
    if (blockIdx.x == 0) {
        int* tiles = wsp<int>(F, WS_TILES);
        for (int e = 0; e < NE; ++e) { const int t0 = sw[32 + e], nt = (sw[e] + 255) >> 8; for (int i = tid; i < nt; i += NWAVES * 64) tiles[t0 + i] = e;
            const int p0 = t0 * 256 + sw[e], p1 = (t0 + nt) * 256; for (int i = p0 + tid; i < p1; i += NWAVES * 64) slot_tok[i] = 0; }
        if (tid == 0) tiles[1023] = sw[128];
    }
}

__device__ __forceinline__ pg8::MoeOrder moe_order(Frame& F, int sh) {
    LAS int* tl = (LAS int*)(F.lds + TILE_OFF);
    const int* tiles = wsp<int>(F, WS_TILES);
    const int NT = __builtin_amdgcn_readfirstlane(tiles[1023]);
    for (int i = F.tid; i < NTILE_MAX; i += NWAVES * 64) tl[i] = (i < NT) ? tiles[i] : 0;
    __syncthreads();
    const long U = (long)NT << sh;
    pg8::MoeOrder S; S.u0 = __builtin_amdgcn_readfirstlane((int)((U * F.vcu) / F.G)); S.u1 = __builtin_amdgcn_readfirstlane((int)((U * (F.vcu + 1)) / F.G)); S.sh = sh; S.tile_e = tl;
    S.mode = (F.G % 32 == 0) ? 1 : 0; S.x = F.vcu >> 5; S.c = F.vcu & 31; S.nx = F.G >> 5; S.NT = NT;
    S.rev = 0;
#if defined(YK_MOE_ORDER0)
    S.mode = 0;
#endif
    return S;
}

__device__ __forceinline__ void ph_cumsum(Frame& F) {
    LAS float* tot = (LAS float*)(F.lds);
    const float* logf = wsp<float>(F, WS_LOGF); float* cs = wsp<float>(F, WS_CS);
    const int tid = F.tid;
    for (int bh = blockIdx.x; bh < BATCH * NH; bh += F.G) {
        const int b = bh >> 4, hh = bh & 15; const int t0 = tid * 16;
        float v[16]; float run = 0.f;
#pragma unroll
        for (int i = 0; i < 16; ++i) { run += logf[((size_t)b * SEQ + t0 + i) * NH + hh]; v[i] = run; }
        float inc = run;
#pragma unroll
        for (int o = 1; o < 64; o <<= 1) { const float up = __shfl_up(inc, o); if (F.lane >= o) inc += up; }
        if (F.lane == 63) tot[F.wave] = inc;
        __syncthreads();
        float off = inc - run;
        for (int w = 0; w < F.wave; ++w) off += tot[w];
#pragma unroll
        for (int i = 0; i < 16; ++i) cs[(size_t)bh * SEQ + t0 + i] = (off + v[i]) * LOG2E;
        __syncthreads();
    }
}

__device__ __forceinline__ void ph_knorm(Frame& F) {
    const bf16* KB = wsp<bf16>(F, WS_K); unsigned* km = wsp<unsigned>(F, WS_KMAX);
    const int gw = F.vcu * NWAVES + F.wave, NGW = F.G * NWAVES, lane = F.lane;
    for (int row0 = gw * 16; row0 < T; row0 += NGW * 16) {
        const int b = row0 >> 13; float mx = 0.f;
        for (int i = 0; i < 16; i += 4) { v4u a[4], c[4];
#pragma unroll
            for (int r = 0; r < 4; ++r) { const bf16* rp = KB + (size_t)(row0 + i + r) * D + lane * 16; a[r] = *(const v4u*)rp; c[r] = *(const v4u*)(rp + 8); }
#pragma unroll
            for (int r = 0; r < 4; ++r) { const f32x4 x0 = bf4_to_f32((u32x2){a[r].x, a[r].y}), x1 = bf4_to_f32((u32x2){a[r].z, a[r].w}), x2 = bf4_to_f32((u32x2){c[r].x, c[r].y}), x3 = bf4_to_f32((u32x2){c[r].z, c[r].w});
                const f32x4 q = x0 * x0 + x1 * x1 + x2 * x2 + x3 * x3; float s = (q.x + q.y) + (q.z + q.w);
                s += dpp_mov<0xB1>(s); s += dpp_mov<0x4E>(s); mx = fmaxf(mx, s); } }
        if ((lane & 3) == 0) atomicMax(km + b * NH + (lane >> 2), __float_as_uint(mx));
    }
}
constexpr int ST_OFF = LDSCTL_OFF + 9216, WAVETAB_OFF = ST_OFF + 256;
enum { ST_PH = 0, ST_L, ST_LO, ST_HI, ST_VCU, ST_G, ST_WS_LO, ST_WS_HI, ST_BAR_LO, ST_BAR_HI, ST_BX };
__device__ __forceinline__ int st_get(LAS unsigned char* L, int i) { return __builtin_amdgcn_readfirstlane(((volatile LAS int*)(L + ST_OFF))[i]); }
__device__ __forceinline__ unsigned hw_slot() { return (unsigned)__builtin_amdgcn_s_getreg((5 << 11) | 4) & 63u; }
__device__ __forceinline__ Frame fresh(LAS unsigned char* L) {
    Frame P; P.lds = L; P.MISC = (volatile LAS unsigned*)(L + MISC_OFF);
    int wave = __builtin_amdgcn_readfirstlane(((volatile LAS int*)(L + WAVETAB_OFF))[hw_slot()]);
    int lane = (int)__builtin_amdgcn_mbcnt_hi(~0u, __builtin_amdgcn_mbcnt_lo(~0u, 0u)); asm volatile("" : "+v"(lane));
    P.dup = 0; P.wave = wave; P.lane = lane; P.tid = wave * 64 + lane; P.vcu = st_get(L, ST_VCU); P.G = st_get(L, ST_G);
    P.ws = (unsigned char*)(((unsigned long long)(unsigned)st_get(L, ST_WS_HI) << 32) | (unsigned)st_get(L, ST_WS_LO));
    return P;
}
__device__ __forceinline__ void grid_barrier(LAS unsigned char* L, int tid) {
    XcdBarrier b; b.bar = (unsigned*)(((unsigned long long)(unsigned)st_get(L, ST_BAR_HI) << 32) | (unsigned)st_get(L, ST_BAR_LO)); b.x = xb_xcc_id(); b.st = (volatile LAS unsigned*)(L + MISC_OFF) + 8;
    xcd_barrier(b, tid == 0);
}
__device__ __forceinline__ bool ph_on(LAS unsigned char* L) { const int ph = st_get(L, ST_PH); return ph >= st_get(L, ST_LO) && ph < st_get(L, ST_HI); }
__device__ __forceinline__ void ph_end(LAS unsigned char* L) {
    const int ph = st_get(L, ST_PH), lo = st_get(L, ST_LO), hi = st_get(L, ST_HI);
    const int wave = __builtin_amdgcn_readfirstlane(((volatile LAS int*)(L + WAVETAB_OFF))[hw_slot()]);
    const int tid = wave * 64 + (int)__builtin_amdgcn_mbcnt_hi(~0u, __builtin_amdgcn_mbcnt_lo(~0u, 0u));
    if (ph >= lo && ph + 1 < hi) grid_barrier(L, tid); else __syncthreads();
#if defined(YK_XBAR)
    if (ph >= lo && ph + 1 < hi) { for (int q_ = 0; q_ < YK_XBAR; ++q_) grid_barrier(L, tid); }
#endif
    if (tid == 0) ((volatile LAS int*)(L + ST_OFF))[ST_PH] = ph + 1;
#if defined(YK_PROF)
    if (tid == 0 && st_get(L, ST_BX) == 0) { unsigned long long* stamps = (unsigned long long*)((((unsigned long long)(unsigned)st_get(L, ST_WS_HI) << 32) | (unsigned)st_get(L, ST_WS_LO)) + WS_CTL + 768 * 1024); stamps[ph + 1] = __builtin_amdgcn_s_memrealtime(); if (ph == 0) stamps[0] = ((volatile LAS unsigned long long*)(L + ST_OFF + 128))[0]; }
#endif
    __syncthreads();
}
struct Args { const void* in[21]; float* out; unsigned char* ws; int ph_lo, ph_hi, region, pad; };
__global__ void __launch_bounds__(NWAVES * 64, 2) yoco_fwd(Args args) {
    extern __shared__ __attribute__((aligned(16))) unsigned char lds[];
    LAS unsigned char* L = (LAS unsigned char*)lds;
    {   const int tid0 = threadIdx.x;
        for (int u = tid0; u < (LDS_BYTES - LDSCTL_OFF) / 4; u += NWAVES * 64) ((LAS unsigned*)(L + LDSCTL_OFF))[u] = 0u;
        __syncthreads();
        if ((tid0 & 63) == 0) ((LAS int*)(L + WAVETAB_OFF))[hw_slot()] = tid0 >> 6;
        if (tid0 == 0) {
            LAS unsigned long long* pt = (LAS unsigned long long*)(L + PTRS_OFF);
#pragma unroll
            for (int i = 0; i < 21; ++i) pt[i] = (unsigned long long)args.in[i];
            pt[I_OUT] = (unsigned long long)args.out;
            LAS int* st = (LAS int*)(L + ST_OFF);
            const int G = gridDim.x, bx = blockIdx.x;
            unsigned* barw = (unsigned*)(args.ws + WS_CTL) + CW_BAR + args.region * XCD_BAR_WORDS;
            st[ST_PH] = 0; st[ST_L] = 0; st[ST_LO] = args.ph_lo; st[ST_HI] = args.ph_hi; st[ST_VCU] = (G % 8 == 0) ? (bx % 8) * (G / 8) + bx / 8 : bx; st[ST_G] = G; st[ST_BX] = bx;
            st[ST_WS_LO] = (int)(unsigned)(unsigned long long)args.ws; st[ST_WS_HI] = (int)(unsigned)((unsigned long long)args.ws >> 32);
            st[ST_BAR_LO] = (int)(unsigned)(unsigned long long)barw; st[ST_BAR_HI] = (int)(unsigned)((unsigned long long)barw >> 32);
            (void)xb_add(&barw[XB_XCNT(xb_xcc_id())], 1u);
#if defined(YK_PROF)
            ((volatile LAS unsigned long long*)(L + ST_OFF + 128))[0] = __builtin_amdgcn_s_memrealtime();
#endif
        }
        __syncthreads();
    }
#ifndef YK_ONLY
#define YK_ONLY -1
#endif
#define EN(k) (YK_ONLY < 0 || YK_ONLY == (k))
#ifndef YK_DUP
#define YK_DUP -1
#endif
#ifndef YK_VAR
#define YK_VAR 0
#endif
#define DUP(k) for (int rep_ = (YK_DUP == (k)) ? 1 : 0; rep_ >= 0; --rep_)
#define PH_ON(k) (EN(k) && ph_on(L))
#define PH_END ph_end(L)
#define HB wsp<bf16>(P, WS_HB)
#define SUBB wsp<bf16>(P, WS_SUB)
#define X wsp<bf16>(P, WS_X)
    if (PH_ON(0)) DUP(0) { Frame P = fresh(L); P.dup = rep_; ph_prologue(P); }
    PH_END;
    if (PH_ON(1)) DUP(1) { Frame P = fresh(L); P.dup = rep_; ph_mod0(P); }
    PH_END;
    for (;;) {
        const int l = st_get(L, ST_L);
        if (l >= DEPTH) break;
        if (l < 2) {
            if (PH_ON(2)) DUP(2) { Frame P = fresh(L); P.dup = rep_; const int bx = st_get(L, ST_BX);
                constexpr int ES = CONV_FP8 ? 1 : 2;
                pg8::Gemm g{CONV_FP8 ? wsp<bf16>(P, WS_HB8) : HB, (const bf16*)(P.ws + WS_WCI + (size_t)l * 3072 * D * ES), T, 3072, D, 0, CONV_FP8 ? wsp<int>(P, WS_IDENT) : nullptr, 0, 127, 127 - (CONV_FP8 ? WSH_QKV : 0)}; pg8::StaticOrder S; S.init(T, 3072, P.G, bx);
                pg8::EpiConvIn E{wsp<bf16>(P, WS_ZB), wsp<bf16>(P, WS_GB)};
                pg8::gemm_phase<pg8::EpiConvIn, pg8::StaticOrder, true, CONV_FP8, CONV_FP8>(P.lds + RING_OFF, g, S, E, P.wave, P.lds + ETAB_OFF);
            }
            PH_END;
            if (PH_ON(3)) DUP(3) { Frame P = fresh(L); P.dup = rep_; ph_conv(P, l); }
            PH_END;
            if (PH_ON(4)) DUP(4) { Frame P = fresh(L); P.dup = rep_; const int bx = st_get(L, ST_BX);
                constexpr int ES = CONV2_FP8 ? 1 : 2;
                pg8::Gemm g{wsp<bf16>(P, WS_YB), (const bf16*)(P.ws + WS_WCO + (size_t)l * D * D * ES), T, D, D, 0, CONV2_FP8 ? wsp<int>(P, WS_IDENT) : nullptr, 0, 127, 127 - (CONV2_FP8 ? WSH_O : 0)}; pg8::StaticOrder S; S.init(T, D, P.G, bx);
                pg8::EpiBf16 E{SUBB, D, nullptr, 0, 0, 0, 1.f, 0};
                pg8::gemm_phase<pg8::EpiBf16, pg8::StaticOrder, true, CONV2_FP8, CONV2_FP8>(P.lds + RING_OFF, g, S, E, P.wave, P.lds + ETAB_OFF);
            }
            PH_END;
        } else {
            if (PH_ON(5)) DUP(5) { Frame P = fresh(L); P.dup = rep_; const int bx = st_get(L, ST_BX);
                if (l == 2) ph_knorm(P);
                constexpr int ES = QKV_FP8 ? 1 : 2;
                pg8::Gemm g{QKV_FP8 ? wsp<bf16>(P, WS_HB8) : HB, (const bf16*)(P.ws + WS_WQ + (size_t)(l - 2) * D * D * ES), T, D, D, 0, wsp<int>(P, WS_IDENT), 0, 127, 127 - (QKV_FP8 ? WSH_QKV : 0)}; pg8::StaticOrder S; S.init(T, D, P.G, bx);
                pg8::EpiBf16 E{wsp<bf16>(P, WS_Q), D, nullptr, 0, D, 0, attn_body::C2, 0};
                pg8::gemm_phase<pg8::EpiBf16, pg8::StaticOrder, true, QKV_FP8, QKV_FP8>(P.lds + RING_OFF, g, S, E, P.wave, P.lds + ETAB_OFF);
            }
            PH_END;
            if (PH_ON(6)) DUP(6) { Frame P = fresh(L); P.dup = rep_; const int bx = st_get(L, ST_BX);
                static_assert(attn_body::ATTN_LDS_BYTES <= RING_BYTES && attn_body::ATTN_PITCH == D, "attention body geometry vs frame");
                const attn_body::AttnTensors AT{(const attn_body::bf16*)wsp<bf16>(P, WS_Q), (const attn_body::bf16*)wsp<bf16>(P, WS_K), (const attn_body::bf16*)wsp<bf16>(P, WS_V), (attn_body::bf16*)wspo<bf16>(P, WS_Q), wsp<float>(P, WS_CS), wsp<float>(P, WS_KMAX), QKV_FP8 ? (P.dup ? wsp<unsigned char>(P, WS_A1 + WS_END) : wsp<unsigned char>(P, WS_O8)) : nullptr};
                const attn_body::StaticOrder S(P.G, bx);
                attn_body::attn_phase<attn_body::StaticOrder>((char*)lds + RING_OFF, AT, S, P.wave);
            }
            PH_END;
            if (PH_ON(7)) DUP(7) { Frame P = fresh(L); P.dup = rep_; const int bx = st_get(L, ST_BX);
                constexpr int ES = QKV_FP8 ? 1 : 2;
                pg8::Gemm g{QKV_FP8 ? wsp<bf16>(P, WS_O8) : wsp<bf16>(P, WS_Q), (const bf16*)(P.ws + WS_WO + (size_t)(l - 2) * D * D * ES), T, D, D, 0, wsp<int>(P, WS_IDENT), 0, 127, 127 - (QKV_FP8 ? WSH_O : 0)}; pg8::StaticOrder S; S.init(T, D, P.G, bx);
                pg8::EpiBf16 E{SUBB, D, nullptr, 0, 0, 0, 1.f, 0};
                pg8::gemm_phase<pg8::EpiBf16, pg8::StaticOrder, true, QKV_FP8, QKV_FP8>(P.lds + RING_OFF, g, S, E, P.wave, P.lds + ETAB_OFF);
            }
            PH_END;
        }
        if (PH_ON(8)) DUP(8) { Frame P = fresh(L); P.dup = rep_; ph_ln0(P, l, l == 0 ? (const void*)inp(P, I_X) : (const void*)X, wspo<bf16>(P, WS_X)); }
        PH_END;
        if (PH_ON(9)) DUP(9) { Frame P = fresh(L); P.dup = rep_; ph_slot(P); }
        PH_END;
        if (PH_ON(10)) DUP(10) { Frame P = fresh(L); P.dup = rep_;
            const pg8::MoeOrder S = moe_order(P, 3);
            constexpr int ES = MOE_FP8 ? 1 : 2;
            pg8::Gemm g{MOE_FP8 ? wsp<bf16>(P, WS_HB8) : HB, (const bf16*)(P.ws + WS_WGU + (size_t)l * NE * 2048 * D * ES), NSLOT_MAX, 2048, D, (size_t)2048 * D * ES, wsp<int>(P, WS_SLOTTOK), P.dup ? YK_VAR : 0, 127, 127 - WSH_GU};
            pg8::EpiSwiGLU<MOE_FP8> E{wspo<bf16>(P, WS_A1), inp(P, I_EXP_B_GU) + (size_t)l * NE * 2048};
            pg8::gemm_phase<pg8::EpiSwiGLU<MOE_FP8>, pg8::MoeOrder, YK_ALIGN1, true, MOE_FP8>(P.lds + RING_OFF, g, S, E, P.wave, P.lds + ETAB_OFF);
        }
        PH_END;
        if (PH_ON(11)) DUP(11) { Frame P = fresh(L); P.dup = rep_;
            const pg8::MoeOrder S = moe_order(P, 2);
            constexpr int ES = MOE_FP8 ? 1 : 2;
            pg8::Gemm g{wsp<bf16>(P, WS_A1), (const bf16*)(P.ws + WS_WD + (size_t)l * NE * D * FF * ES), NSLOT_MAX, D, FF, (size_t)D * FF * ES, wsp<int>(P, WS_IDENT), P.dup ? YK_VAR : 0, 127, 127 - WSH_DN};
            pg8::EpiBias8<Y2_FP8> E{P.dup ? wsp<bf16>(P, WS_A1 + WS_END) : wsp<bf16>(P, WS_Y2), inp(P, I_EXP_B_DOWN) + (size_t)l * NE * D, D};
            pg8::gemm_phase<pg8::EpiBias8<Y2_FP8>, pg8::MoeOrder, true, true, MOE_FP8>(P.lds + RING_OFF, g, S, E, P.wave, P.lds + ETAB_OFF);
        }
        PH_END;
        if (PH_ON(12)) DUP(12) { Frame P = fresh(L); P.dup = rep_; unsigned poison = 0u;
            if (l == DEPTH - 1) { const unsigned* barw = (const unsigned*)(((unsigned long long)(unsigned)st_get(L, ST_BAR_HI) << 32) | (unsigned)st_get(L, ST_BAR_LO)); poison = (__hip_atomic_load((gu32*)(barw + XB_TMO), RLX_AGENT) != 0u) ? 1u : 0u; }
            ph_ln1(P, l, X, (l == DEPTH - 1) ? (P.dup ? (void*)wsp<float>(P, WS_Q + WS_END) : (void*)inp(P, I_OUT)) : (void*)wspo<bf16>(P, WS_X), poison); }
        PH_END;
        if (l == 1) {
            if (PH_ON(13)) DUP(13) { { Frame Pc = fresh(L); Pc.dup = rep_; ph_cumsum(Pc); }
                Frame P = fresh(L); P.dup = rep_; const int bx = st_get(L, ST_BX);
                pg8::Gemm g{wsp<bf16>(P, WS_HKV), wsp<bf16>(P, WS_WKV), T, 2048, D, 0, wsp<int>(P, WS_IDENT), 0, 127, 127 - (QKV_FP8 ? WSH_QKV : 0)}; pg8::StaticOrder S; S.init(T, 2048, P.G, bx);
                pg8::EpiBf16 E{wsp<bf16>(P, WS_K), D, nullptr, 0, D, (size_t)(WS_V - WS_K) / 2, 1.f, 0};
                pg8::gemm_phase<pg8::EpiBf16, pg8::StaticOrder, true, QKV_FP8, QKV_FP8>(P.lds + RING_OFF, g, S, E, P.wave, P.lds + ETAB_OFF);
            }
            PH_END;
        }
        { Frame P = fresh(L); __syncthreads(); if (P.tid == 0) ((volatile LAS int*)(L + ST_OFF))[ST_L] = l + 1; __syncthreads(); }
    }
#undef PH_ON
#undef PH_END
#undef HB
#undef SUBB
#undef X
}
constexpr int N_PHASES = 2 + 2 * 8 + 1 + 2 * 8;

#if defined(YK_CHECK)
__global__ void chk_moe(const float* w_gu, const float* b_gu, const float* w_dn, const float* b_dn, const float* w_r, const float* b_r, unsigned char* ws, float* res) {
    __shared__ float h[1024], gu[2048], a[1024], ys[1024], red[512 * 3];
    const int tid = threadIdx.x; const int t = (blockIdx.x * 509 + 7) % T; const int l = 3;
    const bf16* HB = (const bf16*)(ws + WS_HB); const int* tki = (const int*)(ws + WS_TKI); const float* tkw = (const float*)(ws + WS_TKW); const int* slot_of = (const int*)(ws + WS_SLOTOF); const bf16* Y2 = (const bf16*)(ws + WS_Y2);
    for (int i = tid; i < 1024; i += 512) { h[i] = __builtin_bit_cast(float, (unsigned)HB[(size_t)t * D + i] << 16); ys[i] = 0.f; }
    __syncthreads();
    for (int k = 0; k < 4; ++k) {
        const int e = tki[t * 4 + k]; const float w = tkw[t * 4 + k];
        const float* wg = w_gu + ((size_t)l * NE + e) * D * 2048; const float* bg = b_gu + ((size_t)l * NE + e) * 2048;
        for (int c = tid; c < 2048; c += 512) { float acc = bg[c]; for (int kk = 0; kk < 1024; ++kk) acc += h[kk] * wg[(size_t)kk * 2048 + c]; gu[c] = acc; }
        __syncthreads();
        for (int n = tid; n < 1024; n += 512) { const float g = fminf(gu[n], 7.f), u = fminf(fmaxf(gu[1024 + n], -7.f), 7.f); a[n] = g / (1.f + expf(-1.702f * g)) * (u + 1.f); }
        __syncthreads();
        const float* wd = w_dn + ((size_t)l * NE + e) * FF * D; const float* bd = b_dn + ((size_t)l * NE + e) * D;
        for (int c = tid; c < 1024; c += 512) { float acc = bd[c]; for (int f = 0; f < 1024; ++f) acc += a[f] * wd[(size_t)f * D + c]; ys[c] += w * acc; }
        __syncthreads();
    }
    float dot = 0.f, nm = 0.f, nn = 0.f;
    for (int c = tid; c < 1024; c += 512) { float m = 0.f; for (int k = 0; k < 4; ++k) m += tkw[t * 4 + k] * __builtin_bit_cast(float, (unsigned)Y2[(size_t)slot_of[t * 4 + k] * D + c] << 16);
        dot += m * ys[c]; nm += m * m; nn += ys[c] * ys[c]; }
    red[tid] = dot; red[512 + tid] = nm; red[1024 + tid] = nn; __syncthreads();
    if (tid == 0) { float s0 = 0, s1 = 0, s2 = 0; for (int i = 0; i < 512; ++i) { s0 += red[i]; s1 += red[512 + i]; s2 += red[1024 + i]; } atomicAdd(res + 0, s0); atomicAdd(res + 1, s1); atomicAdd(res + 2, s2); }
    __syncthreads();
    if (tid < 32) { float acc = b_r[l * NE + tid]; for (int kk = 0; kk < 1024; ++kk) acc += h[kk] * w_r[((size_t)l * D + kk) * NE + tid]; gu[tid] = acc; }
    __syncthreads();
    if (tid == 0) { int match = 0; float tmp[32]; for (int i = 0; i < 32; ++i) tmp[i] = gu[i];
        for (int k = 0; k < 4; ++k) { int bi = 0; for (int i = 1; i < 32; ++i) if (tmp[i] > tmp[bi]) bi = i; tmp[bi] = -1e30f; for (int q = 0; q < 4; ++q) if (tki[t * 4 + q] == bi) ++match; }
        atomicAdd(res + 3, (float)match); atomicAdd(res + 4, 4.0f); }
}
__global__ void chk_ln1(const float* ln_g, const float* ln_b, unsigned char* ws, const float* out, float* res) {
    __shared__ float v[1024], red[512 * 3];
    const int tid = threadIdx.x; const int t = (blockIdx.x * 509 + 7) % T; const int l = 3, b = t >> 13;
    const float* Xb = (const float*)(ws + WS_X); const float* MOD = (const float*)(ws + WS_MOD); const float* tkw = (const float*)(ws + WS_TKW); const int* slot_of = (const int*)(ws + WS_SLOTOF); const bf16* Y2 = (const bf16*)(ws + WS_Y2);
    for (int c = tid; c < 1024; c += 512) { float m = 0.f; for (int k = 0; k < 4; ++k) m += tkw[t * 4 + k] * __builtin_bit_cast(float, (unsigned)Y2[(size_t)slot_of[t * 4 + k] * D + c] << 16);
        const float gate = MOD[((size_t)(l * 2 + 1) * 4 + b) * 3072 + 2048 + c]; v[c] = DN_ALPHA * Xb[(size_t)t * D + c] + (1.f + gate) * m; }
    __syncthreads();
    float s = 0.f; for (int c = 0; c < 1024; ++c) s += v[c]; const float mean = s / 1024.f; float q = 0.f; for (int c = 0; c < 1024; ++c) q += (v[c] - mean) * (v[c] - mean); const float rstd = 1.f / sqrtf(q / 1024.f + LN_EPS);
    float dot = 0.f, nm = 0.f, nn = 0.f;
    for (int c = tid; c < 1024; c += 512) { const float y = (v[c] - mean) * rstd * ln_g[(l * 2 + 1) * D + c] + ln_b[(l * 2 + 1) * D + c]; const float m = out[(size_t)t * D + c]; dot += m * y; nm += m * m; nn += y * y; }
    red[tid] = dot; red[512 + tid] = nm; red[1024 + tid] = nn; __syncthreads();
    if (tid == 0) { float s0 = 0, s1 = 0, s2 = 0; for (int i = 0; i < 512; ++i) { s0 += red[i]; s1 += red[512 + i]; s2 += red[1024 + i]; } atomicAdd(res + 8, s0); atomicAdd(res + 9, s1); atomicAdd(res + 10, s2); }
}
__global__ void chk_scale(float* out, const float* res, int n) {
    const float dot = res[0], nm = res[1], nn = res[2];
    float f = 1.f;
    if (YK_CHECK == 1) f = 1.f + dot / nn;
    if (YK_CHECK == 2) f = 1.f + sqrtf(fmaxf(nm - dot * dot / nn, 0.f) / nn);
    if (YK_CHECK == 3) f = 1.f + res[3] / res[4];
    if (YK_CHECK == 4) f = 1.f + sqrtf(fmaxf(res[9] + res[10] - 2.f * res[8], 0.f) / res[10]);
    for (int i = blockIdx.x * blockDim.x + threadIdx.x; i < n; i += gridDim.x * blockDim.x) out[i] *= f;
}
#endif

#if defined(YK_PROF_ENCODE)
__device__ __forceinline__ int ph_type(int ph) {
    if (ph < 2) return ph;
    if (ph < 18) { const int q = (ph - 2) & 7; const int tl[8] = {2, 3, 4, 8, 9, 10, 11, 12}; return tl[q]; }
    if (ph == 18) return 14; if (ph == 19) return 13;
    const int q = (ph - 20) & 7; const int tl[8] = {5, 6, 7, 8, 9, 10, 11, 12}; return tl[q];
}
__global__ void prof_encode(float* out, const unsigned long long* stamps) {
    const double tot = (double)(stamps[N_PHASES] - stamps[0]);
    double sa = 0.0, sb = 0.0;
    for (int p = 0; p < N_PHASES; ++p) { const double d = (double)(stamps[p + 1] - stamps[p]); const int ty = ph_type(p);
#if defined(YK_PROF_LAYER)
        const int ly = p < 2 ? -1 : p < 10 ? 0 : p < 20 ? 1 : p < 28 ? 2 : 3; if (ly != YK_PROF_LAYER) continue;
#endif
        if (ty == YK_PROF_A) sa += d; if (ty == YK_PROF_B) sb += d; }
    float fa = (float)(sa / tot), fb = (float)(sb / tot);
    fa = floorf(fa * 100.f + 0.5f) * 0.01f; fb = floorf(fb * 100.f + 0.5f) * 0.01f;
    const size_t nzero = (size_t)((double)fa * (double)T) * D;
    for (size_t i = (size_t)blockIdx.x * blockDim.x + threadIdx.x; i < nzero; i += (size_t)gridDim.x * blockDim.x) out[i] = 0.f;
    if (blockIdx.x == 0 && threadIdx.x == 0) out[(size_t)T * D - 1] = 10000.f * fb;
}
#endif
#ifndef YK_N_LAUNCHES
#define YK_N_LAUNCHES 1
#endif
extern "C" void kernel_launch(void* const* d_in, const int* in_sizes, int n_in, void* d_out, int out_size, void* d_ws, size_t ws_size, hipStream_t stream) {
    static int grid = 0;
    if (grid == 0) {
        if (n_in != 21 || in_sizes[0] != T * D || out_size != T * D || ws_size < WS_END + (YK_DUP >= 0 ? WS_Y2 : 0)) { fprintf(stderr, "kernel_launch: unexpected problem: n_in %d in0 %d out %d ws %zu (need %zu)\n", n_in, n_in > 0 ? in_sizes[0] : -1, out_size, ws_size, (size_t)WS_END); grid = -1; return; }
        int dev = 0, cus = 0, per_cu = 0;
        if (hipGetDevice(&dev) != hipSuccess || hipDeviceGetAttribute(&cus, hipDeviceAttributeMultiprocessorCount, dev) != hipSuccess) { grid = -1; return; }
        if (hipFuncSetAttribute((const void*)yoco_fwd, hipFuncAttributeMaxDynamicSharedMemorySize, LDS_BYTES) != hipSuccess) { fprintf(stderr, "kernel_launch: hipFuncSetAttribute failed\n"); grid = -1; return; }
        if (hipOccupancyMaxActiveBlocksPerMultiprocessor(&per_cu, (const void*)yoco_fwd, NWAVES * 64, LDS_BYTES) != hipSuccess || per_cu < 1) { fprintf(stderr, "kernel_launch: occupancy query says %d\n", per_cu); }
        (void)hipGetLastError();
        grid = cus;
    }
    if (grid < 0) return;
    (void)hipMemsetAsync((char*)d_ws + WS_CTL, 0, CTL_ZERO_BYTES, stream);
    Args a{};
    for (int i = 0; i < 21; ++i) a.in[i] = d_in[i];
    a.out = (float*)d_out; a.ws = (unsigned char*)d_ws;
#if YK_N_LAUNCHES == 1
    a.ph_lo = 0; a.ph_hi = N_PHASES; a.region = 0; a.pad = 0;
    hipLaunchKernelGGL(yoco_fwd, dim3(grid), dim3(NWAVES * 64), LDS_BYTES, stream, a);
#else
    for (int p = 0; p < N_PHASES; ++p) { a.ph_lo = p; a.ph_hi = p + 1; a.region = p; a.pad = 0;
        hipLaunchKernelGGL(yoco_fwd, dim3(grid), dim3(NWAVES * 64), LDS_BYTES, stream, a); }
#endif
#if defined(YK_CHECK)
    {   float* res = (float*)((char*)d_ws + WS_CTL + 512 * 1024);
        hipLaunchKernelGGL(chk_moe, dim3(64), dim3(512), 0, stream, (const float*)d_in[17], (const float*)d_in[18], (const float*)d_in[19], (const float*)d_in[20], (const float*)d_in[15], (const float*)d_in[16], (unsigned char*)d_ws, res);
        hipLaunchKernelGGL(chk_ln1, dim3(64), dim3(512), 0, stream, (const float*)d_in[13], (const float*)d_in[14], (unsigned char*)d_ws, (const float*)d_out, res);
        hipLaunchKernelGGL(chk_scale, dim3(1024), dim3(256), 0, stream, (float*)d_out, (const float*)res, T * D); }
#endif
#if defined(YK_PROF)
    hipLaunchKernelGGL(prof_encode, dim3(1024), dim3(256), 0, stream, (float*)d_out, (const unsigned long long*)((char*)d_ws + WS_CTL + 768 * 1024));
#endif
    const hipError_t le = hipPeekAtLastError();
    if (le != hipSuccess) fprintf(stderr, "kernel_launch: launch failed: %s\n", hipGetErrorName(le));
}
```

```cpp
#include <hip/hip_runtime.h>
#include <cstdio>
#include <cstdint>
namespace pg8 {
#define PG8_LAS __attribute__((address_space(3)))
typedef unsigned short bf16_t;
typedef short bf16x8 __attribute__((ext_vector_type(8)));
typedef float f32x4 __attribute__((ext_vector_type(4)));
typedef unsigned u32x4 __attribute__((ext_vector_type(4)));
typedef int i32x4v __attribute__((ext_vector_type(4)));
typedef int i32x8v __attribute__((ext_vector_type(8)));
constexpr int BM = 256, BK = 64, HALF = 128, HTB = HALF * BK * 2  , STAGE_BYTES = 8 * HTB, NXCD = 8, WGM = 8;

__host__ __device__ __forceinline__ int lds_byte(int r, int c) { const int st = (r >> 4) * 2 + (c >> 5), rr = r & 15, cc = c & 31, ob = rr * 64 + cc * 2; return st * 1024 + (ob ^ (((ob >> 9) & 1) << 5)); }
__host__ __device__ __forceinline__ void stage_rc(int b, int& R, int& C) { const int st = b / 1024, sb = b % 1024, swz = sb ^ (((sb >> 9) & 1) << 5); R = (st >> 1) * 16 + swz / 64; C = (st & 1) * 32 + (swz % 64) / 2; }
__host__ __device__ __forceinline__ int perm32(int rho) { const int n = rho >> 4, i = rho & 15; return 8 * (i >> 2) + 4 * n + (i & 3); }

struct Unit { int pm, pn, e; };
struct Gemm { const bf16_t* A; const bf16_t* Bt; int M, N, K; size_t bstride; const int* rowidx; int dbg; int sA, sB; };

struct StaticOrder {
    int nM, nN, nwg, G, c;
    __host__ __device__ void init(int M, int N, int G_, int c_) { nM = M / BM; nN = N / BM; nwg = nM * nN; G = G_; c = c_; }
    __host__ __device__ bool next(int i, Unit& u) const {
        const long L = (long)i * G + c; if (L >= nwg) return false;
        int wgid = (int)L; { const int q = nwg / NXCD, r = nwg % NXCD, xcd = wgid % NXCD, off = wgid / NXCD; wgid = (xcd < r ? xcd * (q + 1) : r * (q + 1) + (xcd - r) * q) + off; }
        const int nig = WGM * nN, gid = wgid / nig, fm = gid * WGM, gsz = (nM - fm) < WGM ? (nM - fm) : WGM;
        u.pm = fm + ((wgid % nig) % gsz); u.pn = (wgid % nig) / gsz; u.e = 0; return true;
    }
};
struct MoeOrder {
    int mode, u0, u1, sh, x, c, nx, NT, rev; const PG8_LAS int* tile_e;
    __device__ __forceinline__ bool next(int i, Unit& u) const {
        if (mode == 0) { const int q = u0 + i; if (q >= u1) return false; u.pm = q >> sh; u.pn = q & ((1 << sh) - 1); u.e = tile_e[u.pm]; return true; }
        const int gi = x + nx * i;
        const int mt = (gi << (5 - sh)) + (c >> sh); if (mt >= NT) return false; u.pm = mt; u.pn = c & ((1 << sh) - 1); u.e = tile_e[mt]; return true;
    }
};

#define PG8_GAS __attribute__((address_space(1)))
__device__ __forceinline__ unsigned cvt_pk_bf16(float lo, float hi) { unsigned r; asm volatile("v_cvt_pk_bf16_f32 %0, %1, %2" : "=v"(r) : "v"(lo), "v"(hi)); return r; }

struct EpiBf16 {
    static constexpr bool PERM = true, WIDE16 = false; static constexpr int NSTORE = 16;
    bf16_t* O; int ldc; const float* bias; int bias_estride; int split_cols; size_t split_stride; float scale0; int nt_store;
    static constexpr bool HAS_PRE = true;
    __device__ __forceinline__ bool want_pre() const { return bias != nullptr; }
    __device__ __forceinline__ void pre(const Unit& u, PG8_LAS unsigned char* tab, int lane) const {
        __builtin_amdgcn_global_load_lds((const unsigned*)(bias + (size_t)u.e * bias_estride + u.pn * BM + 4 * lane), (PG8_LAS unsigned*)tab, 16, 0, 0); }
    __device__ __forceinline__ void init(f32x4 (&acc)[2][2][4][2], int wc, int fq, const PG8_LAS float* tab) const {
        f32x4 bv[2][2];
#pragma unroll
        for (int bj = 0; bj < 2; ++bj)
#pragma unroll
            for (int n = 0; n < 2; ++n) bv[bj][n] = bias ? *(const PG8_LAS f32x4*)(tab + wc * 32 + 8 * fq + bj * HALF + 4 * n) : (f32x4){0.f, 0.f, 0.f, 0.f};
#pragma unroll
        for (int a = 0; a < 2; ++a)
#pragma unroll
            for (int bj = 0; bj < 2; ++bj)
#pragma unroll
                for (int m = 0; m < 4; ++m)
#pragma unroll
                    for (int n = 0; n < 2; ++n) acc[a][bj][m][n] = bv[bj][n];
    }
    __device__ __forceinline__ void operator()(const f32x4 (&acc)[2][2][4][2], const Unit& u, int wr, int wc, int fr, int fq, const PG8_LAS float* tab) const {
        const int row0 = u.pm * BM + wr * 64 + fr; int colt = u.pn * BM; bf16_t* base = O;
        float sc = 1.f; if (split_cols) { const int t = colt / split_cols; base += (size_t)t * split_stride; colt -= t * split_cols; if (t == 0) sc = scale0; }
        const int col0 = colt + wc * 32 + 8 * fq;
#pragma unroll
        for (int ai = 0; ai < 2; ++ai)
#pragma unroll
            for (int m = 0; m < 4; ++m) { bf16_t* rowp = base + (size_t)(row0 + ai * HALF + m * 16) * ldc + col0;
#pragma unroll
                for (int bj = 0; bj < 2; ++bj) { f32x4 v0 = acc[ai][bj][m][0], v1 = acc[ai][bj][m][1];
                    v0 = v0 * sc; v1 = v1 * sc; u32x4 w; w.x = cvt_pk_bf16(v0[0], v0[1]); w.y = cvt_pk_bf16(v0[2], v0[3]); w.z = cvt_pk_bf16(v1[0], v1[1]); w.w = cvt_pk_bf16(v1[2], v1[3]);
                    if (nt_store) __builtin_nontemporal_store(w, (u32x4*)(rowp + bj * HALF)); else *(PG8_GAS u32x4*)(rowp + bj * HALF) = w; } }
    }
};
template <bool OUT8> struct EpiBias8 {
    static constexpr bool PERM = true, WIDE16 = OUT8; static constexpr int NSTORE = OUT8 ? 8 : 16;
    bf16_t* O; const float* bias; int bias_estride;
    static constexpr bool HAS_PRE = true;
    __device__ __forceinline__ bool want_pre() const { return true; }
    __device__ __forceinline__ void pre(const Unit& u, PG8_LAS unsigned char* tab, int lane) const {
        __builtin_amdgcn_global_load_lds((const unsigned*)(bias + (size_t)u.e * bias_estride + u.pn * BM + 4 * lane), (PG8_LAS unsigned*)tab, 16, 0, 0); }
    __device__ __forceinline__ void init(f32x4 (&acc)[2][2][4][2], int wc, int fq, const PG8_LAS float* tab) const {
        f32x4 bv[2][2];
#pragma unroll
        for (int bj = 0; bj < 2; ++bj)
#pragma unroll
            for (int n = 0; n < 2; ++n) bv[bj][n] = OUT8 ? *(const PG8_LAS f32x4*)(tab + 64 * wc + 16 * fq + 8 * bj + 4 * n) : *(const PG8_LAS f32x4*)(tab + wc * 32 + 8 * fq + bj * HALF + 4 * n);
#pragma unroll
        for (int a = 0; a < 2; ++a)
#pragma unroll
            for (int bj = 0; bj < 2; ++bj)
#pragma unroll
                for (int m = 0; m < 4; ++m)
#pragma unroll
                    for (int n = 0; n < 2; ++n) acc[a][bj][m][n] = bv[bj][n];
    }
    __device__ __forceinline__ void operator()(const f32x4 (&acc)[2][2][4][2], const Unit& u, int wr, int wc, int fr, int fq, const PG8_LAS float* tab) const {
        const int row0 = u.pm * BM + wr * 64 + fr;
        if constexpr (OUT8) {
            const int cl = 64 * wc + 16 * fq;
#pragma unroll
            for (int ai = 0; ai < 2; ++ai)
#pragma unroll
                for (int m = 0; m < 4; ++m) { int w[4];
#pragma unroll
                    for (int bj = 0; bj < 2; ++bj)
#pragma unroll
                        for (int n = 0; n < 2; ++n) { const f32x4 v = acc[ai][bj][m][n]; int t = 0; t = __builtin_amdgcn_cvt_pk_fp8_f32(v[0], v[1], t, false); t = __builtin_amdgcn_cvt_pk_fp8_f32(v[2], v[3], t, true); w[2 * bj + n] = t; }
                    *(PG8_GAS u32x4*)((unsigned char*)O + (size_t)(row0 + ai * HALF + m * 16) * 1024 + u.pn * BM + cl) = (u32x4){(unsigned)w[0], (unsigned)w[1], (unsigned)w[2], (unsigned)w[3]}; }
        } else {
            const int col0 = u.pn * BM + wc * 32 + 8 * fq;
#pragma unroll
            for (int ai = 0; ai < 2; ++ai)
#pragma unroll
                for (int m = 0; m < 4; ++m) { const size_t ro = (size_t)(row0 + ai * HALF + m * 16) * 1024 + col0;
#pragma unroll
                    for (int bj = 0; bj < 2; ++bj) { const f32x4 v0 = acc[ai][bj][m][0], v1 = acc[ai][bj][m][1];
                        u32x4 w; w.x = cvt_pk_bf16(v0[0], v0[1]); w.y = cvt_pk_bf16(v0[2], v0[3]); w.z = cvt_pk_bf16(v1[0], v1[1]); w.w = cvt_pk_bf16(v1[2], v1[3]);
                        *(PG8_GAS u32x4*)(O + ro + bj * HALF) = w; } }
        }
    }
};
struct EpiConvIn {
    static constexpr bool PERM = true, WIDE16 = false; static constexpr int NSTORE = 8;
    bf16_t* Z; bf16_t* GB;
    static constexpr bool HAS_PRE = false;
    __device__ __forceinline__ bool want_pre() const { return false; }
    __device__ __forceinline__ void pre(const Unit&, PG8_LAS unsigned char*, int) const {}
    __device__ __forceinline__ void init(f32x4 (&)[2][2][4][2], int, int, const PG8_LAS float*) const {}
    __device__ __forceinline__ void operator()(const f32x4 (&acc)[2][2][4][2], const Unit& u, int wr, int wc, int fr, int fq, const PG8_LAS float*) const {
        const int row0 = u.pm * BM + wr * 64 + fr;
        if (u.pn < 8) {
            const int col0 = u.pn * HALF + wc * 32 + 8 * fq;
#pragma unroll
            for (int ai = 0; ai < 2; ++ai)
#pragma unroll
                for (int m = 0; m < 4; ++m) { bf16_t* rowp = Z + (size_t)(row0 + ai * HALF + m * 16) * 1024 + col0;
                    const f32x4 v0 = acc[ai][0][m][0] * acc[ai][1][m][0], v1 = acc[ai][0][m][1] * acc[ai][1][m][1];
                    u32x4 w; w.x = cvt_pk_bf16(v0[0], v0[1]); w.y = cvt_pk_bf16(v0[2], v0[3]); w.z = cvt_pk_bf16(v1[0], v1[1]); w.w = cvt_pk_bf16(v1[2], v1[3]);
                    *(PG8_GAS u32x4*)rowp = w; }
        } else {
            const int col0 = (u.pn - 8) * BM + wc * 32 + 8 * fq;
#pragma unroll
            for (int ai = 0; ai < 2; ++ai)
#pragma unroll
                for (int m = 0; m < 4; ++m) { bf16_t* rowp = GB + (size_t)(row0 + ai * HALF + m * 16) * 1024 + col0;
#pragma unroll
                    for (int bj = 0; bj < 2; ++bj) { const f32x4 v0 = acc[ai][bj][m][0], v1 = acc[ai][bj][m][1];
                        u32x4 w; w.x = cvt_pk_bf16(v0[0], v0[1]); w.y = cvt_pk_bf16(v0[2], v0[3]); w.z = cvt_pk_bf16(v1[0], v1[1]); w.w = cvt_pk_bf16(v1[2], v1[3]);
                        *(PG8_GAS u32x4*)(rowp + bj * HALF) = w; } }
        }
    }
};
typedef float f32x2 __attribute__((ext_vector_type(2)));
__device__ __forceinline__ f32x2 pk_add(f32x2 a, f32x2 b) { f32x2 d; asm("v_pk_add_f32 %0, %1, %2" : "=v"(d) : "v"(a), "v"(b)); return d; }
__device__ __forceinline__ f32x2 pk_mul(f32x2 a, f32x2 b) { f32x2 d; asm("v_pk_mul_f32 %0, %1, %2" : "=v"(d) : "v"(a), "v"(b)); return d; }
__device__ __forceinline__ float min_sv(float c, float a) { float d; asm("v_min_f32 %0, %1, %2" : "=v"(d) : "s"(c), "v"(a)); return d; }
template <bool OUT8> struct EpiSwiGLU {
    static constexpr bool PERM = true, WIDE16 = false; static constexpr int NSTORE = 8;
    bf16_t* O; const float* bgu;
    static constexpr bool HAS_PRE = true;
    __device__ __forceinline__ bool want_pre() const { return true; }
    __device__ __forceinline__ void pre(const Unit& u, PG8_LAS unsigned char* tab, int lane) const {
        __builtin_amdgcn_global_load_lds((const unsigned*)(bgu + (size_t)u.e * 2048 + (lane >> 5) * 1024 + u.pn * HALF + 4 * (lane & 31)), (PG8_LAS unsigned*)tab, 16, 0, 0); }
    __device__ __forceinline__ void init(f32x4 (&acc)[2][2][4][2], int wc, int fq, const PG8_LAS float* tab) const {
        f32x4 bg[2], bu[2];
#pragma unroll
        for (int n = 0; n < 2; ++n) { bg[n] = *(const PG8_LAS f32x4*)(tab + wc * 32 + 8 * fq + 4 * n); bu[n] = *(const PG8_LAS f32x4*)(tab + HALF + wc * 32 + 8 * fq + 4 * n) + 1.0f; }
#pragma unroll
        for (int a = 0; a < 2; ++a)
#pragma unroll
            for (int m = 0; m < 4; ++m)
#pragma unroll
                for (int n = 0; n < 2; ++n) { acc[a][0][m][n] = bg[n]; acc[a][1][m][n] = bu[n]; }
    }
    __device__ __forceinline__ void operator()(const f32x4 (&acc)[2][2][4][2], const Unit& u, int wr, int wc, int fr, int fq, const PG8_LAS float* tab) const {
        const int row0 = u.pm * BM + wr * 64 + fr, col0 = u.pn * HALF + wc * 32 + 8 * fq;
#define PG8_SWIGLU_ROW(ai, m, r) do { \
                _Pragma("unroll") for (int n = 0; n < 2; ++n) { \
                    _Pragma("unroll") for (int h = 0; h < 2; ++h) { \
                        const f32x2 ag = h ? __builtin_shufflevector(acc[ai][0][m][n], acc[ai][0][m][n], 2, 3) : __builtin_shufflevector(acc[ai][0][m][n], acc[ai][0][m][n], 0, 1); \
                        const f32x2 au = h ? __builtin_shufflevector(acc[ai][1][m][n], acc[ai][1][m][n], 2, 3) : __builtin_shufflevector(acc[ai][1][m][n], acc[ai][1][m][n], 0, 1); \
                        f32x2 g = ag, u1 = au;     \
                        g[0] = min_sv(7.0f, g[0]); g[1] = min_sv(7.0f, g[1]);     \
                        u1[0] = __builtin_amdgcn_fmed3f(u1[0], -6.0f, 8.0f); u1[1] = __builtin_amdgcn_fmed3f(u1[1], -6.0f, 8.0f); \
                        const f32x2 t = pk_mul(g, (f32x2){-1.702f * 1.4426950408889634f, -1.702f * 1.4426950408889634f}); \
                        f32x2 ex; ex[0] = __builtin_amdgcn_exp2f(t[0]); ex[1] = __builtin_amdgcn_exp2f(t[1]); \
                        const f32x2 den = ex + 1.0f;     \
                        f32x2 rc; rc[0] = __builtin_amdgcn_rcpf(den[0]); rc[1] = __builtin_amdgcn_rcpf(den[1]); \
                        const f32x2 o = pk_mul(g, u1) * rc; \
                        r[n][2 * h] = o[0]; r[n][2 * h + 1] = o[1]; } } } while (0)
        if constexpr (OUT8) {
#pragma unroll
            for (int ai = 0; ai < 2; ++ai)
#pragma unroll
                for (int mp = 0; mp < 2; ++mp) { unsigned w[2][2];
#pragma unroll
                    for (int mm = 0; mm < 2; ++mm) { f32x4 r[2]; PG8_SWIGLU_ROW(ai, 2 * mp + mm, r);
                        int w0 = 0, w1 = 0; w0 = __builtin_amdgcn_cvt_pk_fp8_f32(r[0][0], r[0][1], w0, false); w0 = __builtin_amdgcn_cvt_pk_fp8_f32(r[0][2], r[0][3], w0, true);
                        w1 = __builtin_amdgcn_cvt_pk_fp8_f32(r[1][0], r[1][1], w1, false); w1 = __builtin_amdgcn_cvt_pk_fp8_f32(r[1][2], r[1][3], w1, true);
                        w[mm][0] = (unsigned)w0; w[mm][1] = (unsigned)w1; }
                    const auto s0 = __builtin_amdgcn_permlane16_swap(w[0][0], w[1][0], false, false);
                    const auto s1 = __builtin_amdgcn_permlane16_swap(w[0][1], w[1][1], false, false);
                    const int rowx = row0 + ai * HALF + (2 * mp + (fq & 1)) * 16;
                    *(PG8_GAS u32x4*)((unsigned char*)O + (size_t)rowx * 1024 + u.pn * HALF + wc * 32 + 16 * (fq >> 1)) = (u32x4){s0[0], s1[0], s0[1], s1[1]}; }
        } else {
#pragma unroll
            for (int ai = 0; ai < 2; ++ai)
#pragma unroll
                for (int m = 0; m < 4; ++m) { bf16_t* rowp = O + (size_t)(row0 + ai * HALF + m * 16) * 1024 + col0;
                    f32x4 r[2]; PG8_SWIGLU_ROW(ai, m, r);
                    u32x4 w; w.x = cvt_pk_bf16(r[0][0], r[0][1]); w.y = cvt_pk_bf16(r[0][2], r[0][3]); w.z = cvt_pk_bf16(r[1][0], r[1][1]); w.w = cvt_pk_bf16(r[1][2], r[1][3]);
                    *(PG8_GAS u32x4*)rowp = w; }
        }
#undef PG8_SWIGLU_ROW
    }
};

__device__ __forceinline__ int fresh_lane() { int l = (int)__builtin_amdgcn_mbcnt_hi(~0u, __builtin_amdgcn_mbcnt_lo(~0u, 0u)); asm volatile("" : "+v"(l)); return l; }
__device__ __forceinline__ void load4_sync(const int* p0, const int* p1, const int* p2, const int* p3, int& a, int& b, int& c, int& d) {
    asm volatile("global_load_dword %0, %4, off\n\tglobal_load_dword %1, %5, off\n\tglobal_load_dword %2, %6, off\n\tglobal_load_dword %3, %7, off\n\ts_waitcnt vmcnt(0)"
                 : "=&v"(a), "=&v"(b), "=&v"(c), "=&v"(d) : "v"(p0), "v"(p1), "v"(p2), "v"(p3) : "memory");
}

template <class Epi, class Sched, bool ALIGN_EPI, bool GATHER, bool FP8 = false>
__device__ __forceinline__ void gemm_phase(PG8_LAS unsigned char* lds, const Gemm g, const Sched& S, const Epi& E, const int wid_in, PG8_LAS unsigned char* etab) {
    int lane_ = (int)__builtin_amdgcn_mbcnt_hi(~0u, __builtin_amdgcn_mbcnt_lo(~0u, 0u)); asm volatile("" : "+v"(lane_));
    const int wid = __builtin_amdgcn_readfirstlane(wid_in), lane = lane_, tid = wid * 64 + lane, wr = wid >> 2, wc = wid & 3, fr = lane & 15, fq = lane >> 4;
    const int K = g.K, RP = FP8 ? K : 2 * K, nt = RP / (BK * 2);
    unsigned voffA[2], voffB[2];
#pragma unroll
    for (int i = 0; i < 2; ++i) { int R, C; stage_rc(tid * 16 + i * 8192, R, C);
        const int rho_ = R & 31; const int Rb = Epi::WIDE16 ? (64 * (R >> 5) + 16 * ((rho_ & 15) >> 2) + 4 * (rho_ >> 4) + (rho_ & 3)) : Epi::PERM ? ((R & ~31) + perm32(rho_)) : R;
        voffA[i] = (unsigned)(R * RP + 2 * C); voffB[i] = (unsigned)(Rb * RP + 2 * C); }
    const size_t kstep = (size_t)(BK * 2);
    const size_t hstep = (size_t)HALF * RP;
    const size_t hstepB = Epi::WIDE16 ? (size_t)8 * RP : hstep;
    const size_t tstep = 2 * hstep;
    const unsigned ldsw = (unsigned)wid * 1024u;
    const int aoff = lds_byte(wr * 64 + fr, fq * 8), boff = lds_byte(wc * 32 + fr, fq * 8);
#define PG8_SA(b, h) (((b) * 2 + (h)) * HTB)
#define PG8_SB(b, h) ((4 + (b) * 2 + (h)) * HTB)
#define PG8_STAGE(bufoff, gbase, voff) do { _Pragma("unroll") for (int _i = 0; _i < 2; ++_i) \
        __builtin_amdgcn_global_load_lds((const unsigned*)((const char*)(gbase) + (voff)[_i]), (PG8_LAS unsigned*)(lds + (bufoff) + ldsw + _i * 8192), 16, 0, 0); } while (0)
#define PG8_STAGE_A(bufoff, base, h, nx) do { if constexpr (GATHER) { PG8_STAGE(bufoff, base, gA[h]); } \
        else { PG8_STAGE(bufoff, (base) + (h) * hstep, voffA); } } while (0)
#define PG8_LDA(dst, b, h) do { _Pragma("unroll") for (int m = 0; m < 4; ++m) { const i32x4v lo_ = *(const PG8_LAS i32x4v*)(lds + PG8_SA(b, h) + aoff + m * 2048), hi_ = *(const PG8_LAS i32x4v*)(lds + PG8_SA(b, h) + aoff + m * 2048 + 1024); \
        dst[m] = __builtin_shufflevector(lo_, hi_, 0, 1, 2, 3, 4, 5, 6, 7); } } while (0)
#define PG8_LDB(dst, b, h) do { _Pragma("unroll") for (int n = 0; n < 2; ++n) { const i32x4v lo_ = *(const PG8_LAS i32x4v*)(lds + PG8_SB(b, h) + boff + n * 2048), hi_ = *(const PG8_LAS i32x4v*)(lds + PG8_SB(b, h) + boff + n * 2048 + 1024); \
        dst[n] = __builtin_shufflevector(lo_, hi_, 0, 1, 2, 3, 4, 5, 6, 7); } } while (0)
#define PG8_HALF(x, k) __builtin_bit_cast(bf16x8, __builtin_shufflevector(x, x, 4 * (k), 4 * (k) + 1, 4 * (k) + 2, 4 * (k) + 3))
#define PG8_MMA(ai, bj, At, Bt) do { __builtin_amdgcn_s_setprio(1); _Pragma("unroll") for (int m = 0; m < 4; ++m) _Pragma("unroll") for (int n = 0; n < 2; ++n) { \
        if constexpr (FP8) { acc[ai][bj][m][n] = __builtin_amdgcn_mfma_scale_f32_16x16x128_f8f6f4(Bt[n], At[m], acc[ai][bj][m][n], 0, 0, 0, g.sB, 0, g.sA); } \
        else { acc[ai][bj][m][n] = __builtin_amdgcn_mfma_f32_16x16x32_bf16(PG8_HALF(Bt[n], 0), PG8_HALF(At[m], 0), acc[ai][bj][m][n], 0, 0, 0); \
               acc[ai][bj][m][n] = __builtin_amdgcn_mfma_f32_16x16x32_bf16(PG8_HALF(Bt[n], 1), PG8_HALF(At[m], 1), acc[ai][bj][m][n], 0, 0, 0); } } \
        __builtin_amdgcn_s_setprio(0); } while (0)
#define PG8_WAIT_V(n) asm volatile("s_waitcnt vmcnt(" #n ")" ::: "memory")
#define PG8_WAIT_L(n) asm volatile("s_waitcnt lgkmcnt(" #n ")" ::: "memory")
#define PG8_BAR __builtin_amdgcn_s_barrier()
#define PG8_SCHED __builtin_amdgcn_sched_barrier(0)
    Unit cur, nxt; int ui = 0;
    if (!S.next(0, cur)) return;
#define PG8_UNI(u_) do { u_.pm = __builtin_amdgcn_readfirstlane(u_.pm); u_.pn = __builtin_amdgcn_readfirstlane(u_.pn); u_.e = __builtin_amdgcn_readfirstlane(u_.e); } while (0)
#define PG8_APM(u_) ((g.dbg & 2) ? 0 : u_.pm)
#define PG8_BOFF(u_) ((g.dbg & 1) ? (size_t)0 : (size_t)u_.e * g.bstride + (size_t)u_.pn * tstep)
    PG8_UNI(cur);
    unsigned gA[2][2];
#define PG8_GLOAD(dst, pm_) do { const int* _ri = g.rowidx + (size_t)(pm_) * BM; int _t0, _t1, _t2, _t3, _R0, _C0, _R1, _C1; const int _tid = wid * 64 + (int)__builtin_amdgcn_mbcnt_hi(~0u, __builtin_amdgcn_mbcnt_lo(~0u, 0u)); stage_rc(_tid * 16, _R0, _C0); stage_rc(_tid * 16 + 8192, _R1, _C1); \
        load4_sync(_ri + _R0, _ri + _R1, _ri + HALF + _R0, _ri + HALF + _R1, _t0, _t1, _t2, _t3); \
        dst[0][0] = (unsigned)_t0 * (unsigned)RP + (unsigned)_C0 * 2u; dst[0][1] = (unsigned)_t1 * (unsigned)RP + (unsigned)_C1 * 2u; \
        dst[1][0] = (unsigned)_t2 * (unsigned)RP + (unsigned)_C0 * 2u; dst[1][1] = (unsigned)_t3 * (unsigned)RP + (unsigned)_C1 * 2u; } while (0)
#define PG8_ILOAD(dst, tab_) do { const PG8_LAS int* _it = (const PG8_LAS int*)(tab_); int _R0, _C0, _R1, _C1; const int _tid = wid * 64 + (int)__builtin_amdgcn_mbcnt_hi(~0u, __builtin_amdgcn_mbcnt_lo(~0u, 0u)); stage_rc(_tid * 16, _R0, _C0); stage_rc(_tid * 16 + 8192, _R1, _C1); \
        const int _t0 = _it[_R0], _t1 = _it[_R1], _t2 = _it[HALF + _R0], _t3 = _it[HALF + _R1]; \
        dst[0][0] = (unsigned)_t0 * (unsigned)RP + (unsigned)_C0 * 2u; dst[0][1] = (unsigned)_t1 * (unsigned)RP + (unsigned)_C1 * 2u; \
        dst[1][0] = (unsigned)_t2 * (unsigned)RP + (unsigned)_C0 * 2u; dst[1][1] = (unsigned)_t3 * (unsigned)RP + (unsigned)_C1 * 2u; } while (0)
    if constexpr (GATHER) { PG8_GLOAD(gA, PG8_APM(cur)); }
    else { gA[0][0] = gA[0][1] = gA[1][0] = gA[1][1] = 0u; }
    const bool want_pre = Epi::HAS_PRE && E.want_pre();
    if (want_pre && wid == 0) E.pre(cur, etab, fresh_lane());
    f32x4 acc[2][2][4][2];
#pragma unroll
    for (int a = 0; a < 2; ++a)
#pragma unroll
        for (int b = 0; b < 2; ++b)
#pragma unroll
            for (int m = 0; m < 4; ++m)
#pragma unroll
                for (int n = 0; n < 2; ++n) acc[a][b][m][n] = (f32x4){0.f, 0.f, 0.f, 0.f};
    i32x8v At[4], B0[2], B1[2];
    const char* cA = GATHER ? (const char*)g.A : (const char*)g.A + (size_t)PG8_APM(cur) * tstep;
    const char* cB = (const char*)g.Bt + PG8_BOFF(cur);
    PG8_STAGE(PG8_SB(0, 0), cB, voffB); PG8_STAGE(PG8_SB(0, 1), cB + hstepB, voffB); PG8_STAGE_A(PG8_SA(0, 0), cA, 0, false); PG8_STAGE_A(PG8_SA(0, 1), cA, 1, false);
    if (wr == 1) PG8_BAR;
    PG8_WAIT_V(2); PG8_BAR;
    PG8_STAGE(PG8_SB(1, 0), cB + kstep, voffB); PG8_STAGE_A(PG8_SA(1, 0), cA + kstep, 0, false); PG8_STAGE(PG8_SB(1, 1), cB + hstepB + kstep, voffB);
    PG8_WAIT_V(6); PG8_BAR;
    if (want_pre) { const int le_ = fresh_lane(); E.init(acc, wc, le_ >> 4, (const PG8_LAS float*)etab); }
    for (;;) {
        const bool has_next = S.next(ui + 1, nxt); PG8_UNI(nxt);
        if (want_pre && has_next && wid == 0) E.pre(nxt, etab + ((ui + 1) & 1) * 1024, fresh_lane());
        if constexpr (GATHER) { if (has_next && wid == 1) __builtin_amdgcn_global_load_lds((const unsigned*)(g.rowidx + (size_t)PG8_APM(nxt) * BM + 4 * fresh_lane()), (PG8_LAS unsigned*)(etab + 2048 + ((ui + 1) & 1) * 1024), 16, 0, 0); }
        const char* nA = (has_next && !GATHER) ? (const char*)g.A + (size_t)PG8_APM(nxt) * tstep : cA;
        const char* nB = has_next ? (const char*)g.Bt + PG8_BOFF(nxt) : cB;
#pragma nounroll
        for (int t = 0; t < nt; t += 2) {
            const bool last = (t == nt - 2);
            const bool nx = last && has_next;
            const char* a1 = cA + (size_t)(t + 1) * kstep;
            const char* a2 = last ? nA : cA + (size_t)(t + 2) * kstep; const char* b2 = last ? nB : cB + (size_t)(t + 2) * kstep;
            const char* a3 = a2 + kstep; const char* b3 = b2 + kstep;
            PG8_LDB(B0, 0, 0); PG8_LDB(B1, 0, 1); PG8_SCHED; PG8_LDA(At, 0, 0); PG8_STAGE_A(PG8_SA(1, 1), a1, 1, false);
            if constexpr (GATHER) { if (nx) { PG8_ILOAD(gA, etab + 2048 + ((ui + 1) & 1) * 1024); } }
            PG8_WAIT_V(8); PG8_WAIT_L(0); PG8_BAR; PG8_MMA(0, 0, At, B0); PG8_MMA(0, 1, At, B1); PG8_BAR; PG8_SCHED;
            PG8_LDA(At, 0, 1); PG8_STAGE(PG8_SB(0, 0), b2, voffB); PG8_STAGE(PG8_SB(0, 1), b2 + hstepB, voffB); PG8_STAGE_A(PG8_SA(0, 0), a2, 0, nx);
            PG8_WAIT_V(8); PG8_WAIT_L(0); PG8_BAR; PG8_MMA(1, 0, At, B0); PG8_MMA(1, 1, At, B1); PG8_BAR; PG8_SCHED;
            PG8_LDB(B0, 1, 0); PG8_LDB(B1, 1, 1); PG8_SCHED; PG8_LDA(At, 1, 0); PG8_STAGE_A(PG8_SA(0, 1), a2, 1, nx);
            PG8_WAIT_V(8); PG8_WAIT_L(0); PG8_BAR; PG8_MMA(0, 0, At, B0); PG8_MMA(0, 1, At, B1); PG8_BAR; PG8_SCHED;
            PG8_LDA(At, 1, 1); PG8_STAGE(PG8_SB(1, 0), b3, voffB); PG8_STAGE(PG8_SB(1, 1), b3 + hstepB, voffB); PG8_STAGE_A(PG8_SA(1, 0), a3, 0, nx);
            PG8_WAIT_V(8); PG8_WAIT_L(0); PG8_BAR; PG8_MMA(1, 0, At, B0); PG8_MMA(1, 1, At, B1); PG8_BAR; PG8_SCHED;
        }
        if constexpr (ALIGN_EPI) { if (wr == 0) PG8_BAR; }
        { const int le_ = fresh_lane();
          E(acc, cur, wr, wc, le_ & 15, le_ >> 4, (const PG8_LAS float*)(etab + (ui & 1) * 1024)); }
        if (!has_next) break;
#pragma unroll
        for (int a = 0; a < 2; ++a)
#pragma unroll
            for (int b = 0; b < 2; ++b)
#pragma unroll
                for (int m = 0; m < 4; ++m)
#pragma unroll
                    for (int n = 0; n < 2; ++n) acc[a][b][m][n] = (f32x4){0.f, 0.f, 0.f, 0.f};
        cur = nxt; cA = nA; cB = nB; ++ui;
        if (want_pre) { const int le_ = fresh_lane(); E.init(acc, wc, le_ >> 4, (const PG8_LAS float*)(etab + (ui & 1) * 1024)); }
        if constexpr (ALIGN_EPI) { if (wr == 1) PG8_BAR; }
    }
    PG8_WAIT_V(0);
    if constexpr (!ALIGN_EPI) { if (wr == 0) PG8_BAR; }
    PG8_BAR;
#undef PG8_SA
#undef PG8_SB
#undef PG8_STAGE
#undef PG8_STAGE_A
#undef PG8_GLOAD
#undef PG8_ILOAD
#undef PG8_UNI
#undef PG8_APM
#undef PG8_BOFF
#undef PG8_LDA
#undef PG8_LDB
#undef PG8_MMA
#undef PG8_HALF
#undef PG8_WAIT_V
#undef PG8_WAIT_L
#undef PG8_BAR
#undef PG8_SCHED
}
}
#include <hip/hip_bf16.h>
#include <cmath>
namespace attn_body {
using bf16=__hip_bfloat16;
using bf16x8=__attribute__((ext_vector_type(8)))short;
using s16x4=__attribute__((ext_vector_type(4)))short;
using f32x16=__attribute__((ext_vector_type(16)))float;
using u32x4=__attribute__((ext_vector_type(4)))unsigned;
constexpr int BATCH=4,NHEAD=16,SEQ=8192,D=64,DM=NHEAD*D;
constexpr int NW=8,QBLK=32,QB=QBLK*NW,KVBLK=64,NQB=SEQ/QB;
constexpr int ATTN_PITCH=DM, ATTN_UNIT_ROWS=QB;
__device__ __forceinline__ int crow(int r,int hi){return (r&3)+8*(r>>2)+4*hi;}
#define SBAR() __builtin_amdgcn_sched_barrier(0)
__device__ __forceinline__ void cmask(f32x16&p0,f32x16&p1,int jb,int qrel,int hi){
  const float NEG=-INFINITY; int kb=64*jb+4*hi;
  #pragma unroll
  for(int r=0;r<16;++r){int kv=kb+(r&3)+8*(r>>2); if(kv>qrel)p0[r]=NEG; if(kv+32>qrel)p1[r]=NEG;}
}

constexpr int NSLOT=3, SLOTB=8192;
constexpr int LDS_K=0, LDS_V=NSLOT*SLOTB, LDS_WS=2*NSLOT*SLOTB, LDS_OST=LDS_WS+NW*64*4, LDS_CS=LDS_OST+NW*4096, LDS_QM=LDS_CS+SEQ*4, LDS_BYTES=LDS_QM+64;
constexpr float PRUNE_LOG2=40.0f;
constexpr float C2=0.125f*1.4426950408889634f;
__device__ __forceinline__ void glds16(const void*gsrc,unsigned lds_dst){unsigned keep;
  asm volatile("s_mov_b32 %0, m0\n\ts_mov_b32 m0, %2\n\ts_nop 0\n\tglobal_load_lds_dwordx4 %1, off\n\ts_mov_b32 m0, %0":"=&s"(keep):"v"(gsrc),"s"(lds_dst):"memory");}
__device__ __forceinline__ float max3f(float a,float b,float c){float r;asm("v_max3_f32 %0, %1, %2, %3":"=v"(r):"v"(a),"v"(b),"v"(c));return r;}
__device__ __forceinline__ float max2f(float a,float b){float r;asm("v_max_f32_e32 %0, %1, %2":"=v"(r):"v"(a),"v"(b));return r;}
__device__ __forceinline__ float fadd_s(float a,float b){float r;asm("v_add_f32_e32 %0, %1, %2":"=v"(r):"v"(a),"v"(b));return r;}
__device__ __forceinline__ float fsub_s(float a,float b){float r;asm("v_sub_f32_e32 %0, %1, %2":"=v"(r):"v"(a),"v"(b));return r;}
typedef float f32x2_t __attribute__((ext_vector_type(2))); typedef __bf16 bf16x2_t __attribute__((ext_vector_type(2)));
__device__ __forceinline__ unsigned cvtpk_s(float lo,float hi){f32x2_t v={lo,hi};bf16x2_t b=__builtin_convertvector(v,bf16x2_t);return __builtin_bit_cast(unsigned,b);}
#define WAIT_BAR(N) asm volatile("s_waitcnt vmcnt(" #N ") lgkmcnt(0)\n\ts_barrier":::"memory")

__device__ __forceinline__ void qkt(f32x16&p0,f32x16&p1,const char*Kslot,const bf16x8*qr,int r32,int hi){
  const char*kb=Kslot+hi*1024+r32*16;
  #pragma unroll
  for(int d0=0;d0<4;++d0){
    const bf16x8 b0=*reinterpret_cast<const bf16x8*>(kb+d0*2048);
    const bf16x8 b1=*reinterpret_cast<const bf16x8*>(kb+d0*2048+512);
    {p0=__builtin_amdgcn_mfma_f32_32x32x16_bf16(b0,qr[d0],p0,0,0,0);p1=__builtin_amdgcn_mfma_f32_32x32x16_bf16(b1,qr[d0],p1,0,0,0);}}
}
typedef __attribute__((address_space(3))) const char* lds_cptr;
typedef short v4i16_t __attribute__((ext_vector_type(4)));
__device__ __forceinline__ void kload8(bf16x8*kf,lds_cptr kp){
  kf[0]=*(const __attribute__((address_space(3))) bf16x8*)(kp);      kf[1]=*(const __attribute__((address_space(3))) bf16x8*)(kp+512);
  kf[2]=*(const __attribute__((address_space(3))) bf16x8*)(kp+2048); kf[3]=*(const __attribute__((address_space(3))) bf16x8*)(kp+2560);
  kf[4]=*(const __attribute__((address_space(3))) bf16x8*)(kp+4096); kf[5]=*(const __attribute__((address_space(3))) bf16x8*)(kp+4608);
  kf[6]=*(const __attribute__((address_space(3))) bf16x8*)(kp+6144); kf[7]=*(const __attribute__((address_space(3))) bf16x8*)(kp+6656);
}
__device__ __forceinline__ void kload2(bf16x8*kf,lds_cptr kp,int j){ kf[2*j]=*(const __attribute__((address_space(3))) bf16x8*)(kp+j*2048); kf[2*j+1]=*(const __attribute__((address_space(3))) bf16x8*)(kp+j*2048+512); }
__device__ __forceinline__ s16x4 vtr(lds_cptr p){ return __builtin_bit_cast(s16x4,__builtin_amdgcn_ds_read_tr16_b64_v4i16((__attribute__((address_space(3))) v4i16_t*)p)); }
__device__ __forceinline__ float rowmax(const f32x16&p0,const f32x16&p1){
  float a=max3f(p0[0],p0[1],p1[0]),b=max3f(p0[2],p0[3],p1[1]);a=max3f(a,p1[2],p1[3]);
  #pragma unroll
  for(int r=4;r<16;r+=4){a=max3f(a,p0[r],p0[r+1]);b=max3f(b,p0[r+2],p0[r+3]);a=max3f(a,p1[r],p1[r+1]);b=max3f(b,p1[r+2],p1[r+3]);}
  const float m=max2f(a,b);
  auto rr=__builtin_amdgcn_permlane32_swap(__float_as_uint(m),__float_as_uint(m),false,false);
  return max2f(__uint_as_float(rr[0]),__uint_as_float(rr[1]));
}
__device__ __forceinline__ void pv(f32x16*o,int vb,bf16x8 pa0,bf16x8 pa1,bf16x8 pa2,bf16x8 pa3){
  #pragma unroll
  for(int d0=0;d0<2;++d0){s16x4 lo[4],hi[4];
    #pragma unroll
    for(int ks=0;ks<4;++ks){
      asm volatile("ds_read_b64_tr_b16 %0,%1 offset:%c2":"=&v"(lo[ks]):"v"(vb),"i"(d0*4096+ks*1024):"memory");
      asm volatile("ds_read_b64_tr_b16 %0,%1 offset:%c2":"=&v"(hi[ks]):"v"(vb),"i"(d0*4096+ks*1024+512):"memory");}
    asm volatile("s_waitcnt lgkmcnt(0)":::"memory");SBAR();
    #define PK(k) (bf16x8){lo[k][0],lo[k][1],lo[k][2],lo[k][3],hi[k][0],hi[k][1],hi[k][2],hi[k][3]}
    o[d0]=__builtin_amdgcn_mfma_f32_32x32x16_bf16(pa0,PK(0),o[d0],0,0,0);
    o[d0]=__builtin_amdgcn_mfma_f32_32x32x16_bf16(pa1,PK(1),o[d0],0,0,0);
    o[d0]=__builtin_amdgcn_mfma_f32_32x32x16_bf16(pa2,PK(2),o[d0],0,0,0);
    o[d0]=__builtin_amdgcn_mfma_f32_32x32x16_bf16(pa3,PK(3),o[d0],0,0,0);
    #undef PK
  }
}

#ifndef ATTN_STORE16
#define ATTN_STORE16(p,v) (*(u32x4*)(p)=(v))
#endif
template<int THRL> __device__ __forceinline__ void attn_unit(int b,int h,int qb,const bf16*Q,const bf16*__restrict__ K,const bf16*__restrict__ V,bf16*O,const float*__restrict__ CS,const float*__restrict__ KM,unsigned char*O8,char*shm,const int wid_in){
  int lane_=(int)__builtin_amdgcn_mbcnt_hi(~0u,__builtin_amdgcn_mbcnt_lo(~0u,0u)); asm volatile("":"+v"(lane_));
  const int wid=__builtin_amdgcn_readfirstlane(wid_in),lane=lane_,tid=wid*64+lane,r32=lane&31,hi=lane>>5;
  const long rowbase=(long)b*SEQ; const int q0=qb*QB;
  const bf16*Qw=Q+(rowbase+q0+wid*QBLK)*DM+h*D;
  const bf16*Kh=K+rowbase*DM+h*D,*Vh=V+rowbase*DM+h*D;
  const unsigned lds0=(unsigned)(uintptr_t)shm;
  float*wsf=(float*)(shm+LDS_WS)+wid*64;
  const bf16*ksrc=Kh+(long)lane*DM+wid*8;
  const bf16*vsrc=Vh+(long)(16*(wid&3)+(lane>>2))*DM+(wid>>2)*32+(lane&3)*8;
  const unsigned kdst=lds0+LDS_K+wid*1024, vdst=lds0+LDS_V+wid*1024;
  #define DMA_K(t,slot) glds16(ksrc+(long)(NT-1-(t))*KVBLK*DM,(unsigned)__builtin_amdgcn_readfirstlane(kdst+(slot)))
  #define DMA_V(t,slot) glds16(vsrc+(long)(NT-1-(t))*KVBLK*DM,(unsigned)__builtin_amdgcn_readfirstlane(vdst+(slot)))
  const int vb0=(int)(lds0+LDS_V)+((lane>>4)&1)*32+(lane&3)*8+(4*hi+((lane&15)>>2))*64;
  const char*Kbase=shm+LDS_K; bf16x8 kf[8];
  const lds_cptr shm3=(lds_cptr)shm; const lds_cptr kp0=shm3+LDS_K+hi*1024+r32*16; const lds_cptr vp0=shm3+LDS_V+((lane>>4)&1)*32+(lane&3)*8+(4*hi+((lane&15)>>2))*64;
  const int NT=(q0+QB)/KVBLK;
  typedef float f32x4v __attribute__((ext_vector_type(4)));
  const float*csrc=CS+(long)(b*NHEAD+h)*SEQ;
  float rowoff=csrc[q0+wid*QBLK+r32];
  const float kmax2=KM[b*NHEAD+h];
  { __attribute__((address_space(3))) f32x4v*cl=(__attribute__((address_space(3))) f32x4v*)(shm3+LDS_CS);
    for(int i_=tid;i_<NT*16;i_+=NW*64){ const f32x4v v_=*(const f32x4v*)(csrc+4*i_); cl[i_]=v_; } }
  const __attribute__((address_space(3))) float*csl=(const __attribute__((address_space(3))) float*)(shm3+LDS_CS)+4*hi;
  #define BIAS(C0,C1,t) do{ const __attribute__((address_space(3))) f32x4v*p_=(const __attribute__((address_space(3))) f32x4v*)(csl+(NT-1-(t))*64); \
    _Pragma("unroll") for(int g_=0;g_<4;++g_){ const f32x4v a_=p_[2*g_], b_=p_[2*g_+8]; \
      C0[4*g_+0]=rowoff-a_[0]; C0[4*g_+1]=rowoff-a_[1]; C0[4*g_+2]=rowoff-a_[2]; C0[4*g_+3]=rowoff-a_[3]; \
      C1[4*g_+0]=rowoff-b_[0]; C1[4*g_+1]=rowoff-b_[1]; C1[4*g_+2]=rowoff-b_[2]; C1[4*g_+3]=rowoff-b_[3]; } }while(0)
  DMA_K(0,0);DMA_V(0,0);DMA_K(1,SLOTB);
  bf16x8 qr[4];
  #pragma unroll
  for(int d0=0;d0<4;++d0)qr[d0]=*reinterpret_cast<const bf16x8*>(&Qw[(long)r32*DM+d0*16+hi*8]);
  bf16x8 kdg[4];
  #pragma unroll
  for(int d0=0;d0<4;++d0)kdg[d0]=*reinterpret_cast<const bf16x8*>(&Kh[(long)(q0+wid*QBLK+r32)*DM+d0*16+hi*8]);
  float l_reg=0.f;f32x16 o[2];o[0]=f32x16{};o[1]=f32x16{};
  const int qrel=wid*QBLK+r32;
  #define CMASK(P0,P1,t) do{ if((t)<4)cmask(P0,P1,3-(t),qrel,hi); }while(0)
  bool resc=false;
  #define DECIDE(C0,C1) do{ float a=MX3(C0[0],C0[1],C1[0]),b=MX3(C0[2],C0[3],C1[1]); a=MX3(a,C1[2],C1[3]); \
      _Pragma("unroll") for(int r=4;r<16;r+=4){a=MX3(a,C0[r],C0[r+1]);b=MX3(b,C0[r+2],C0[r+3]);a=MX3(a,C1[r],C1[r+1]);b=MX3(b,C1[r+2],C1[r+3]);} \
      float rm=__builtin_fmaxf(a,b); { auto rr=__builtin_amdgcn_permlane32_swap(__float_as_uint(rm),__float_as_uint(rm),false,false); rm=__builtin_fmaxf(__uint_as_float(rr[0]),__uint_as_float(rr[1])); } \
      resc=false; \
      if(__builtin_expect(__any(rm>(float)THRL),0)){ const float dl=__builtin_fmaxf(rm,0.f); rowoff-=dl; \
        _Pragma("unroll") for(int r=0;r<16;++r){C0[r]-=dl;C1[r]-=dl;} \
        const float f=__builtin_amdgcn_exp2f(-dl); l_reg*=f; if(hi==0)wsf[r32]=f; resc=true; } }while(0)
  #define MX3(a,b,c) __builtin_fmaxf(__builtin_fmaxf((a),(b)),(c))
  #define RESC() do{ if(resc){ asm volatile("s_waitcnt lgkmcnt(0)":::"memory"); \
      _Pragma("unroll") for(int d_=0;d_<2;++d_) _Pragma("unroll") for(int r=0;r<16;++r)o[d_][r]*=wsf[crow(r,hi)]; } }while(0)
  f32x16 pA0,pA1,pB0,pB1;
  int sl_prev=0,sl_cur=0,sl_next=SLOTB;
  #define ROT() do{sl_prev=sl_cur;sl_cur=sl_next;sl_next=(sl_next==(NSLOT-1)*SLOTB)?0:sl_next+SLOTB;}while(0)
  DMA_K(2,2*SLOTB);
  { float s_=0.f,dg_=0.f;
    #pragma unroll
    for(int d0=0;d0<4;++d0){
      #pragma unroll
      for(int e_=0;e_<8;++e_){ const float x_=__uint_as_float(((unsigned)(unsigned short)qr[d0][e_])<<16), k_=__uint_as_float(((unsigned)(unsigned short)kdg[d0][e_])<<16); s_+=x_*x_; dg_+=x_*k_; } }
    { auto rr=__builtin_amdgcn_permlane32_swap(__float_as_uint(s_),__float_as_uint(s_),false,false); s_=__uint_as_float(rr[0])+__uint_as_float(rr[1]); }
    { auto rr=__builtin_amdgcn_permlane32_swap(__float_as_uint(dg_),__float_as_uint(dg_),false,false); dg_=__uint_as_float(rr[0])+__uint_as_float(rr[1]); }
    #pragma unroll
    for(int m_=1;m_<32;m_<<=1){ s_=__builtin_fmaxf(s_,__shfl_xor(s_,m_)); dg_=__builtin_fminf(dg_,__shfl_xor(dg_,m_)); }
    if(lane==0){ ((__attribute__((address_space(3))) float*)(shm3+LDS_QM))[wid]=s_; ((__attribute__((address_space(3))) float*)(shm3+LDS_QM))[8+wid]=dg_; } }
  WAIT_BAR(3);
  int NTe;
  { const __attribute__((address_space(3))) float*cst=(const __attribute__((address_space(3))) float*)(shm3+LDS_CS);
    const __attribute__((address_space(3))) float*qm=(const __attribute__((address_space(3))) float*)(shm3+LDS_QM);
    float q2=qm[0],dmin=qm[8];
    #pragma unroll
    for(int w_=1;w_<NW;++w_){q2=__builtin_fmaxf(q2,qm[w_]);dmin=__builtin_fminf(dmin,qm[8+w_]);}
    const float B2=__builtin_sqrtf(q2*kmax2)-dmin+1.0f;
    const float cq0=cst[q0];
    const bool k0=(lane<NT)&&(B2+cq0-cst[64*lane+63]>=-PRUNE_LOG2), k1=(lane+64<NT)&&(B2+cq0-cst[64*(lane+64)+63]>=-PRUNE_LOG2);
    const unsigned long long m0=__ballot(k0), m1=__ballot(k1);
    int pmin=m0?__builtin_ctzll(m0):(m1?64+__builtin_ctzll(m1):NT-4); pmin=pmin<NT-4?pmin:NT-4;
    NTe=(NT-pmin+1)&~1; NTe=__builtin_amdgcn_readfirstlane(NTe); }
  BIAS(pA0,pA1,0); qkt(pA0,pA1,Kbase,qr,r32,hi);asm volatile("s_nop 15\n\ts_nop 7":"+v"(pA0),"+v"(pA1));CMASK(pA0,pA1,0);
  DECIDE(pA0,pA1); resc=false;
  _Pragma("unroll") for(int r=0;r<16;++r){pA0[r]=__builtin_amdgcn_exp2f(pA0[r]);pA1[r]=__builtin_amdgcn_exp2f(pA1[r]);}
  WAIT_BAR(0);
  DMA_K(3,0);DMA_V(1,SLOTB);
  ROT();
  kload8(kf,kp0+sl_cur);
  WAIT_BAR(2);
  s16x4 vlo[8],vhi[8]; u32x4 pw0,pw1,pw2,pw3;
  #define PKW(P,B) cvtpk_s(P[B],P[B+1])
  #define PAF(k) __builtin_bit_cast(bf16x8,pw##k)
  #define VFR(i) (bf16x8){vlo[i][0],vlo[i][1],vlo[i][2],vlo[i][3],vhi[i][0],vhi[i][1],vhi[i][2],vhi[i][3]}
  #define PIN(x) asm volatile("":"+v"(x))
  #define GAPA(MF,A0,A1,A2,A3,W0,W1,PW) do{ MF; sacc+=A0; sacc+=A1; sacc+=A2; sacc+=A3; PIN(sacc); W0; W1; PIN(PW); SBAR(); }while(0)
  #define EX(v) __builtin_amdgcn_exp2f(v)
  #define GAPB(MF,X,B) do{ MF; X[B]=EX(X[B]); X[B+1]=EX(X[B+1]); X[B+2]=EX(X[B+2]); X[B+3]=EX(X[B+3]); PIN(X); SBAR(); }while(0)
  #define VRD(i) do{ vlo[i]=vtr(vp_+(((i)>>2)*4096+((i)&3)*1024)); vhi[i]=vtr(vp_+(((i)>>2)*4096+((i)&3)*1024+512)); }while(0)
  #define KRD(G,j) do{ if(G){ kload2(kf,kp0+sl_next,j); SBAR(); } }while(0)
  #define STEP(C0,C1,P0,P1,t,GK,GV,GL) do{ SBAR(); BIAS(C0,C1,t); SBAR(); \
    const lds_cptr vp_=vp0+sl_prev; \
    VRD(0); SBAR(); float sacc=(P0[0]+P0[1]); \
    GAPA(C0=__builtin_amdgcn_mfma_f32_32x32x16_bf16(kf[0],qr[0],C0,0,0,0), P0[2],P0[3],P0[4],P0[5],     pw0[0]=PKW(P0,0), pw0[1]=PKW(P0,2), pw0); \
    VRD(4); SBAR(); GAPA(C1=__builtin_amdgcn_mfma_f32_32x32x16_bf16(kf[1],qr[0],C1,0,0,0), P0[6],P0[7],P0[8],P0[9],     pw0[2]=PKW(P0,4), pw0[3]=PKW(P0,6), pw0); \
    VRD(1); SBAR(); GAPA(C0=__builtin_amdgcn_mfma_f32_32x32x16_bf16(kf[2],qr[1],C0,0,0,0),   P0[10],P0[11],P0[12],P0[13], pw1[0]=PKW(P0,8), pw1[1]=PKW(P0,10), pw1); \
    VRD(5); SBAR(); GAPA(C1=__builtin_amdgcn_mfma_f32_32x32x16_bf16(kf[3],qr[1],C1,0,0,0),   P0[14],P0[15],P1[0],P1[1],   pw1[2]=PKW(P0,12),pw1[3]=PKW(P0,14), pw1); \
    VRD(2); SBAR(); GAPA(C0=__builtin_amdgcn_mfma_f32_32x32x16_bf16(kf[4],qr[2],C0,0,0,0),   P1[2],P1[3],P1[4],P1[5],     pw2[0]=PKW(P1,0), pw2[1]=PKW(P1,2), pw2); \
    VRD(6); SBAR(); GAPA(C1=__builtin_amdgcn_mfma_f32_32x32x16_bf16(kf[5],qr[2],C1,0,0,0),   P1[6],P1[7],P1[8],P1[9],     pw2[2]=PKW(P1,4), pw2[3]=PKW(P1,6), pw2); \
    VRD(3); SBAR(); GAPA(C0=__builtin_amdgcn_mfma_f32_32x32x16_bf16(kf[6],qr[3],C0,0,0,0),   P1[10],P1[11],P1[12],P1[13], pw3[0]=PKW(P1,8), pw3[1]=PKW(P1,10), pw3); \
    VRD(7); SBAR(); GAPA(C1=__builtin_amdgcn_mfma_f32_32x32x16_bf16(kf[7],qr[3],C1,0,0,0),   P1[14],P1[15],0.f,0.f,       pw3[2]=PKW(P1,12),pw3[3]=PKW(P1,14), pw3); \
    l_reg+=sacc; \
    if(GK){DMA_K((t)+3,sl_cur);} if(GV){DMA_V((t)+1,sl_next);} \
    CMASK(C0,C1,t); \
    DECIDE(C0,C1); \
    SBAR(); \
    GAPB(o[0]=__builtin_amdgcn_mfma_f32_32x32x16_bf16(PAF(0),VFR(0),o[0],0,0,0), C0,0); \
    GAPB(o[1]=__builtin_amdgcn_mfma_f32_32x32x16_bf16(PAF(0),VFR(4),o[1],0,0,0), C0,4); \
    KRD(GL,0); GAPB(o[0]=__builtin_amdgcn_mfma_f32_32x32x16_bf16(PAF(1),VFR(1),o[0],0,0,0), C0,8); \
    KRD(GL,1); GAPB(o[1]=__builtin_amdgcn_mfma_f32_32x32x16_bf16(PAF(1),VFR(5),o[1],0,0,0), C0,12); \
    KRD(GL,2); GAPB(o[0]=__builtin_amdgcn_mfma_f32_32x32x16_bf16(PAF(2),VFR(2),o[0],0,0,0), C1,0); \
    KRD(GL,3); GAPB(o[1]=__builtin_amdgcn_mfma_f32_32x32x16_bf16(PAF(2),VFR(6),o[1],0,0,0), C1,4); \
    GAPB(o[0]=__builtin_amdgcn_mfma_f32_32x32x16_bf16(PAF(3),VFR(3),o[0],0,0,0), C1,8); \
    GAPB(o[1]=__builtin_amdgcn_mfma_f32_32x32x16_bf16(PAF(3),VFR(7),o[1],0,0,0), C1,12); \
    }while(0)
  #define ENDW(tt) do{ if((tt)+3<NTe){WAIT_BAR(2);} else if((tt)+2<NTe){WAIT_BAR(1);} else {WAIT_BAR(0);} }while(0)
  for(int t=1;t+1<NTe;t+=2){
    STEP(pB0,pB1,pA0,pA1,t,(t+3<NTe),(t+1<NTe),(t+1<NTe));       ENDW(t);   RESC(); ROT();
    STEP(pA0,pA1,pB0,pB1,t+1,(t+4<NTe),(t+2<NTe),(t+2<NTe));     ENDW(t+1); RESC(); ROT();
  }
  STEP(pB0,pB1,pA0,pA1,NTe-1,false,false,false); RESC();
  { float sacc=pB0[0]+pB0[1]; _Pragma("unroll") for(int r=2;r<16;++r)sacc+=pB0[r]; _Pragma("unroll") for(int r=0;r<16;++r)sacc+=pB1[r]; l_reg+=sacc;
    pw0=(u32x4){PKW(pB0,0),PKW(pB0,2),PKW(pB0,4),PKW(pB0,6)};pw1=(u32x4){PKW(pB0,8),PKW(pB0,10),PKW(pB0,12),PKW(pB0,14)};pw2=(u32x4){PKW(pB1,0),PKW(pB1,2),PKW(pB1,4),PKW(pB1,6)};pw3=(u32x4){PKW(pB1,8),PKW(pB1,10),PKW(pB1,12),PKW(pB1,14)};
    SBAR(); pv(o,vb0+sl_cur,PAF(0),PAF(1),PAF(2),PAF(3)); }
  #undef PKW
  #undef PAF
  #undef VFR
  #undef PIN
  #undef MX3
  #undef GAPA
  #undef GAPB
  #undef EX
  #undef VRD
  #undef KRD
  #undef STEP
  #undef ENDW
  {auto rr=__builtin_amdgcn_permlane32_swap(__float_as_uint(l_reg),__float_as_uint(l_reg),false,false);l_reg=__uint_as_float(rr[0])+__uint_as_float(rr[1]);}
  if(hi==0)wsf[32+r32]=l_reg;asm volatile("s_waitcnt lgkmcnt(0)":::"memory");
  float rli[16];
  #pragma unroll
  for(int r=0;r<16;++r)rli[r]=__builtin_amdgcn_rcpf(wsf[32+crow(r,hi)]);
  bf16*Ow=O+(rowbase+q0+wid*QBLK)*DM+h*D;
  { bf16*stg=(bf16*)(shm+LDS_OST)+wid*2048;
    #pragma unroll
    for(int r=0;r<16;++r){const int orow=crow(r,hi);
      #pragma unroll
      for(int d0=0;d0<2;++d0)stg[orow*64+d0*32+r32]=__float2bfloat16(o[d0][r]*rli[r]);}
    asm volatile("s_waitcnt lgkmcnt(0)":::"memory");
    #pragma unroll
    for(int i=0;i<4;++i){const int row=i*8+(lane>>3),ch=lane&7; const u32x4 v=*(const u32x4*)(stg+row*64+ch*8);
      if(O8){
        int w0=0,w1=0; w0=__builtin_amdgcn_cvt_pk_fp8_f32(__uint_as_float(v.x<<16),__uint_as_float(v.x&0xffff0000u),w0,false); w0=__builtin_amdgcn_cvt_pk_fp8_f32(__uint_as_float(v.y<<16),__uint_as_float(v.y&0xffff0000u),w0,true);
        w1=__builtin_amdgcn_cvt_pk_fp8_f32(__uint_as_float(v.z<<16),__uint_as_float(v.z&0xffff0000u),w1,false); w1=__builtin_amdgcn_cvt_pk_fp8_f32(__uint_as_float(v.w<<16),__uint_as_float(v.w&0xffff0000u),w1,true);
        typedef int i32x2_t __attribute__((ext_vector_type(2))); *(i32x2_t*)(O8+((rowbase+q0+wid*QBLK+row)*DM+h*D+ch*8))=(i32x2_t){w0,w1}; }
      else ATTN_STORE16(Ow+(long)row*DM+ch*8,v);} }
  asm volatile("s_waitcnt lgkmcnt(0)\n\ts_barrier":::"memory");
  #undef BIAS
  #undef DMA_K
  #undef DMA_V
  #undef CMASK
  #undef DECIDE
  #undef RESC
  #undef ROT
}
constexpr int ATTN_LDS_BYTES=LDS_BYTES;
struct AttnTensors { const bf16* Q; const bf16* K; const bf16* V; bf16* O; const float* CS; const float* KM; unsigned char* O8; };
struct AttnUnit { int bh; int qb; };
struct StaticOrder {
  int vcu, G;
  __device__ __forceinline__ explicit StaticOrder(int grid,int block):vcu((grid%8==0)?(block%8)*(grid/8)+block/8:block),G(grid){}
  __device__ __forceinline__ bool next(int i,AttnUnit&u)const{ const int ci=vcu+(i>>2)*G; if(ci>=BATCH*NHEAD*8)return false; const int s=ci&7, ii=i&3; u.bh=ci>>3; u.qb=(ii==0)?s:(ii==1)?15-s:(ii==2)?16+s:31-s; return true; }
  __device__ __forceinline__ void a_ready(const AttnUnit&)const{}
  __device__ __forceinline__ void done(const AttnUnit&)const{}
};
template<class Sched,int THRL=8> __device__ __forceinline__ void attn_phase(char*lds,const AttnTensors&T,const Sched&S,const int wid){
  AttnUnit u;
  for(int i=0;S.next(i,u);++i){ S.a_ready(u); u.bh=__builtin_amdgcn_readfirstlane(u.bh); u.qb=__builtin_amdgcn_readfirstlane(u.qb); attn_unit<THRL>(u.bh/NHEAD,u.bh%NHEAD,u.qb,T.Q,T.K,T.V,T.O,T.CS,T.KM,T.O8,lds,wid); S.done(u); }
}
#undef SBAR
#undef WAIT_BAR
}

constexpr int NWAVES = 8;
constexpr int BATCH = 4, SEQ = 8192, T = BATCH * SEQ, D = 1024, NH = 16, NE = 32, TOPK = 4, FF = 1024, DEPTH = 4;
constexpr int NGROUP = T / 128;
constexpr int NTILE_MAX = (T * TOPK) / 256 + NE;
constexpr int NSLOT_MAX = NTILE_MAX * 256;
constexpr float LN_EPS = 1e-5f;
constexpr float DN_ALPHA = 1.6817928305074290f;
constexpr float LOG2E = 1.4426950408889634f;
constexpr size_t MiB = 1u << 20;
constexpr size_t WS_CTL = 0, CTL_ZERO_BYTES = 1 * MiB;
constexpr size_t WS_MOD = 1 * MiB, WS_KVMOD = 1 * MiB + 512 * 1024;
constexpr size_t WS_WRT = 2 * MiB, WS_WFT = 2 * MiB + 512 * 1024;
constexpr size_t WS_BLKCNT = 3 * MiB, WS_TILES = 3 * MiB + 64 * 1024;
constexpr size_t WS_LOGF = 4 * MiB, WS_CS = 6 * MiB;
constexpr size_t WS_IDENT = 40 * MiB;
constexpr size_t WS_TKI = 8 * MiB, WS_TKW = 9 * MiB, WS_SLOTOF = 10 * MiB, WS_SLOTTOK = 11 * MiB;
constexpr size_t WS_WCI = 12 * MiB, WS_WCO = 24 * MiB, WS_WKV = 28 * MiB, WS_WQ = 32 * MiB, WS_WO = 36 * MiB;
constexpr size_t WS_WGU = 64 * MiB, WS_WD = 576 * MiB;
constexpr size_t WS_X = 832 * MiB, WS_HB = 960 * MiB, WS_HKV = 1024 * MiB, WS_ZB = 1088 * MiB, WS_GB = 1152 * MiB, WS_YB = 1216 * MiB, WS_SUB = 1280 * MiB;
constexpr size_t WS_Q = 1344 * MiB, WS_K = 1408 * MiB, WS_V = 1472 * MiB, WS_A1 = 1536 * MiB, WS_Y2 = 1808 * MiB, WS_HB8 = 2080 * MiB, WS_END = 2112 * MiB;
static_assert(WS_A1 + (size_t)NSLOT_MAX * 1024 * 2 <= WS_Y2 && WS_Y2 + (size_t)NSLOT_MAX * 1024 * 2 <= WS_HB8 && WS_HB8 + (size_t)T * D <= WS_END, "d_ws map");
#ifndef YK_FP8
#define YK_FP8 1
#endif
constexpr bool MOE_FP8 = (YK_FP8 != 0);
constexpr int WSH_GU = MOE_FP8 ? 6 : 0, WSH_DN = MOE_FP8 ? 7 : 0;
constexpr bool QKV_FP8 = MOE_FP8; constexpr int WSH_QKV = 6;
constexpr bool CONV_FP8 = false;
constexpr bool CONV2_FP8 = QKV_FP8;
constexpr int WSH_O = 7;
constexpr size_t WS_O8 = WS_HKV + 32 * MiB;
#ifndef YK_ALIGN1
#define YK_ALIGN1 true
#endif
#ifndef YK_Y2FP8
#define YK_Y2FP8 1
#endif
constexpr bool Y2_FP8 = MOE_FP8 && (YK_Y2FP8 != 0);
constexpr size_t WS_KMAX = WS_CTL + 640 * 1024;
constexpr int CW_BAR = 4096;
constexpr int MAX_BAR_REGIONS = 64;
constexpr int RING_OFF = 0, RING_BYTES = 131072;
constexpr int LDSCTL_OFF = RING_BYTES, MISC_OFF = LDSCTL_OFF + 320;
constexpr int HIST_OFF = LDSCTL_OFF + 512;
constexpr int TILE_OFF = LDSCTL_OFF + 1024;
constexpr int SLOTW_OFF = LDSCTL_OFF + 4096;
constexpr int ETAB_OFF = LDSCTL_OFF + 10240;
constexpr int PTRS_OFF = LDSCTL_OFF + 8192;
constexpr int LDS_BYTES = 147456;

#define GAS __attribute__((address_space(1)))
#define LAS __attribute__((address_space(3)))
typedef unsigned short bf16;
typedef unsigned v4u __attribute__((ext_vector_type(4)));
typedef float f32x4 __attribute__((ext_vector_type(4)));
typedef short bf16x8 __attribute__((ext_vector_type(8)));
typedef GAS unsigned gu32;
typedef GAS unsigned long long gu64;
#define RLX_AGENT __ATOMIC_RELAXED, __HIP_MEMORY_SCOPE_AGENT
#define LDS_WAIT() asm volatile("s_waitcnt lgkmcnt(0)" ::: "memory")
#define VM_WAIT() asm volatile("s_waitcnt vmcnt(0)" ::: "memory")
__device__ __forceinline__ unsigned long long rt() { return __builtin_amdgcn_s_memrealtime(); }
__device__ __forceinline__ unsigned f2bf(float f) { unsigned u = __builtin_bit_cast(unsigned, f); return (u + 0x7fffu + ((u >> 16) & 1u)) >> 16; }
__device__ __forceinline__ unsigned pk2(float lo, float hi) { return f2bf(lo) | (f2bf(hi) << 16); }

#define XB_TMO      128
#define XB_XCNT(j)  (256  + 64 * (j))
#define XB_XSUB(j)  (1280 + 64 * (j))
#define XB_XGEN(j)  (2304 + 64 * (j))
#define XB_TOP      3328
#define XB_TOPGEN   3392
#define XCD_BAR_WORDS 3456
#define XB_SPIN_CAP (1u << 18)

__device__ __forceinline__ unsigned xb_ld(unsigned* p)              { return __hip_atomic_load(p, __ATOMIC_RELAXED, __HIP_MEMORY_SCOPE_AGENT); }
__device__ __forceinline__ unsigned xb_add(unsigned* p, unsigned v) { return __hip_atomic_fetch_add(p, v, __ATOMIC_RELAXED, __HIP_MEMORY_SCOPE_AGENT); }
__device__ __forceinline__ unsigned xb_xcc_id() { return (unsigned)__builtin_amdgcn_s_getreg((3 << 11) | 20) & 0xFu; }
#define XB_SPIN(cond, bar) do { unsigned _sp = 0; while (cond) { __builtin_amdgcn_s_sleep(1); \
    if ((++_sp & 255u) == 0u) { if (xb_ld(&(bar)[XB_TMO])) break; if (_sp > XB_SPIN_CAP) { atomicAdd(&(bar)[XB_TMO], 1u); break; } } } } while (0)

struct XcdBarrier {
    unsigned* bar; unsigned x;
    volatile LAS unsigned* st;
};

__device__ __forceinline__ XcdBarrier xcd_barrier_post(unsigned* bar, volatile LAS unsigned* st) {
    XcdBarrier b; b.bar = bar; b.x = xb_xcc_id(); b.st = st;
    if (threadIdx.x == 0) (void)xb_add(&bar[XB_XCNT(b.x)], 1u);
    return b;
}
__device__ __forceinline__ void xcd_barrier_complete(unsigned* bar, unsigned x, unsigned& nloc, unsigned& nx) {
    const unsigned G = gridDim.x * gridDim.y * gridDim.z;
    unsigned sum, cnt, mine, sp = 0u;
    for (;;) {
        sum = 0u; cnt = 0u; mine = 0u;
#pragma unroll
        for (unsigned j = 0; j < 16; ++j) { const unsigned c = xb_ld(&bar[XB_XCNT(j)]); sum += c; cnt += (c > 0u) ? 1u : 0u; mine = (j == x) ? c : mine; }
        if (sum == G) break;
        __builtin_amdgcn_s_sleep(1);
        if ((++sp & 255u) == 0u) { if (xb_ld(&bar[XB_TMO])) break; if (sp > XB_SPIN_CAP) { atomicAdd(&bar[XB_TMO], 1u); break; } }
    }
    nloc = mine > 0u ? mine : 1u; nx = cnt > 0u ? cnt : 1u;
}

__device__ __forceinline__ void xcd_barrier(const XcdBarrier& b, const bool leader_thread) {
    asm volatile("s_waitcnt vmcnt(0)" ::: "memory");
    __syncthreads();
    if (leader_thread) {
        unsigned* bar = b.bar;
        __builtin_amdgcn_s_waitcnt(0);
        unsigned nloc = b.st[0], nx = b.st[1];
        if (nloc == 0u) { xcd_barrier_complete(bar, b.x, nloc, nx); b.st[0] = nloc; b.st[1] = nx; }
        const unsigned old = xb_add(&bar[XB_XSUB(b.x)], 1u);
        const unsigned gen = old / nloc;
        if (old + 1u == (gen + 1u) * nloc) {
            __builtin_amdgcn_fence(__ATOMIC_RELEASE, "agent");
            asm volatile("s_waitcnt vmcnt(0)" ::: "memory");
            const unsigned og = xb_add(&bar[XB_TOP], 1u);
            const unsigned tg = og / nx;
            if (og + 1u == (tg + 1u) * nx) xb_add(&bar[XB_TOPGEN], 1u);
            else XB_SPIN(xb_ld(&bar[XB_TOPGEN]) == tg, bar);
            __builtin_amdgcn_fence(__ATOMIC_ACQUIRE, "agent");
            xb_add(&bar[XB_XGEN(b.x)], 1u);
            asm volatile("s_waitcnt vmcnt(0)" ::: "memory");
        } else {
            XB_SPIN(xb_ld(&bar[XB_XGEN(b.x)]) == gen, bar);
            __builtin_amdgcn_fence(__ATOMIC_ACQUIRE, "agent");
            asm volatile("s_waitcnt vmcnt(0)" ::: "memory");
        }
    }
    __syncthreads();
}


static_assert(CW_BAR + MAX_BAR_REGIONS * XCD_BAR_WORDS <= (int)(CTL_ZERO_BYTES / 4), "barrier regions inside the memset region");
typedef float f32x2 __attribute__((ext_vector_type(2)));
typedef unsigned u32x2 __attribute__((ext_vector_type(2)));
typedef int i32x4 __attribute__((ext_vector_type(4)));

struct Frame {
    LAS unsigned char* lds;
    volatile LAS unsigned* MISC;
    int tid, lane, wave, vcu, G, dup;
    unsigned char* ws;
};
enum { I_X = 0, I_C, I_CONV_W_IN, I_CONV_W, I_CONV_W_OUT, I_KV_ADA_W, I_KV_ADA_B, I_W_KVF, I_B_F, I_ATTN_W_Q, I_ATTN_W_O, I_ADA_W, I_ADA_B, I_LN_G, I_LN_B, I_ROUTER_W, I_ROUTER_B, I_EXP_W_GU, I_EXP_B_GU, I_EXP_W_DOWN, I_EXP_B_DOWN, I_OUT, I_NPTR };
__device__ __forceinline__ const float* inp(const Frame& F, int i) {
    const unsigned long long v = ((const LAS unsigned long long*)(F.lds + PTRS_OFF))[i];
    const unsigned lo = __builtin_amdgcn_readfirstlane((unsigned)v), hi = __builtin_amdgcn_readfirstlane((unsigned)(v >> 32));
    return (const float*)(((unsigned long long)hi << 32) | lo);
}
template <class Tp> __device__ __forceinline__ Tp* wsp(const Frame& F, size_t off) { return (Tp*)(F.ws + off); }
template <class Tp> __device__ __forceinline__ Tp* wspo(const Frame& F, size_t off) { return (Tp*)(F.ws + off + (F.dup ? WS_END : (size_t)0)); }
template <int CTRL> __device__ __forceinline__ float dpp_mov(float v) { return __builtin_bit_cast(float, __builtin_amdgcn_update_dpp(0, __builtin_bit_cast(int, v), CTRL, 0xF, 0xF, true)); }
__device__ __forceinline__ float wave_sum(float v) {
    v += dpp_mov<0xB1>(v);
    v += dpp_mov<0x4E>(v);
    v += dpp_mov<0x141>(v);
    v += dpp_mov<0x140>(v);
    const int b = __builtin_bit_cast(int, v);
    return (__builtin_bit_cast(float, __builtin_amdgcn_readlane(b, 0)) + __builtin_bit_cast(float, __builtin_amdgcn_readlane(b, 16))) + (__builtin_bit_cast(float, __builtin_amdgcn_readlane(b, 32)) + __builtin_bit_cast(float, __builtin_amdgcn_readlane(b, 48)));
}
__device__ __forceinline__ f32x4 bf4_to_f32(u32x2 w) { f32x4 r; r.x = __builtin_bit_cast(float, w.x << 16); r.y = __builtin_bit_cast(float, w.x & 0xffff0000u); r.z = __builtin_bit_cast(float, w.y << 16); r.w = __builtin_bit_cast(float, w.y & 0xffff0000u); return r; }
__device__ __forceinline__ u32x2 f32_to_bf4(f32x4 v) { u32x2 r; r.x = pg8::cvt_pk_bf16(v.x, v.y); r.y = pg8::cvt_pk_bf16(v.z, v.w); return r; }

template <int N, int M> struct LaneRed {
    static __device__ __forceinline__ float run(float* r, int lane) {
        if constexpr (N > 1) {
            const bool up = (lane & M) != 0;
#pragma unroll
            for (int e = 0; e < N / 2; ++e) { const float keep = up ? r[e + N / 2] : r[e], send = up ? r[e] : r[e + N / 2]; r[e] = keep + __shfl_xor(send, M); }
            return LaneRed<N / 2, M / 2>::run(r, lane);
        } else {
            float v = r[0];
#pragma unroll
            for (int m = M; m >= 1; m >>= 1) v += __shfl_xor(v, m);
            return v;
        }
    }
};

__device__ __forceinline__ void p0_transpose_item(const float* W, int ldw, int K, bf16* WT, int k0, int n0, int drow, LAS float* scr, int lane) {
#pragma unroll 8
    for (int i = 0; i < 32; ++i) { const int kk = 2 * i + (lane >> 5); scr[kk * 33 + (lane & 31)] = W[(size_t)(k0 + kk) * ldw + n0 + (lane & 31)]; }
    LDS_WAIT(); asm volatile("" ::: "memory");
    const int c = lane & 7;
#pragma unroll
    for (int j = 0; j < 4; ++j) { const int n = (lane >> 3) + 8 * j; const LAS float* s = scr + (8 * c) * 33 + n;
        v4u o; o.x = pk2(s[0 * 33], s[1 * 33]); o.y = pk2(s[2 * 33], s[3 * 33]); o.z = pk2(s[4 * 33], s[5 * 33]); o.w = pk2(s[6 * 33], s[7 * 33]);
        *(GAS v4u*)(WT + (size_t)(drow + n) * K + k0 + 8 * c) = o; }
    LDS_WAIT(); asm volatile("" ::: "memory");
}
__device__ __forceinline__ int glu_row(int n0, int half) { const int isu = n0 >= half ? 1 : 0, np = n0 - isu * half; return 256 * (np >> 7) + 128 * isu + (np & 127); }

__device__ __forceinline__ void ph_prologue(Frame& F) {
    const int tid = F.tid, lane = F.lane, wave = F.wave;
    LAS float* condT = (LAS float*)(F.lds);
    LAS float* part = (LAS float*)(F.lds + 16384);
    const float* cin = inp(F, I_C); const float* ada_w = inp(F, I_ADA_W); const float* ada_b = inp(F, I_ADA_B); const float* kv_ada_w = inp(F, I_KV_ADA_W); const float* kv_ada_b = inp(F, I_KV_ADA_B);
    for (int i = tid; i < BATCH * D; i += NWAVES * 64) { const int b = i >> 10, k = i & 1023; const float cv = cin[i]; condT[k * 4 + b] = cv / (1.0f + expf(-cv)); }
    __syncthreads();
    float* MOD = wsp<float>(F, WS_MOD); float* KVMOD = wsp<float>(F, WS_KVMOD);
    for (int tk = blockIdx.x; tk < 208; tk += F.G) {
        const int c0 = tk * 128; const float* W; int ldw, col; const float* bias; float* dst; int dstld;
        if (c0 < 24576) { const int m = c0 / 3072; col = c0 - m * 3072; W = ada_w + (size_t)m * 1024 * 3072; ldw = 3072; bias = ada_b + m * 3072; dst = MOD + (size_t)m * 4 * 3072; dstld = 3072; }
        else { col = c0 - 24576; W = kv_ada_w; ldw = 2048; bias = kv_ada_b; dst = KVMOD; dstld = 2048; }
        float a0[4] = {0.f, 0.f, 0.f, 0.f}, a1[4] = {0.f, 0.f, 0.f, 0.f};
        const float* wp = W + (size_t)(wave * 128) * ldw + col + 2 * lane;
#pragma unroll 16
        for (int kk = 0; kk < 128; ++kk) { const f32x2 w2 = *(const f32x2*)(wp + (size_t)kk * ldw); const f32x4 c4 = *(const LAS f32x4*)(condT + (wave * 128 + kk) * 4);
#pragma unroll
            for (int b = 0; b < 4; ++b) { a0[b] += c4[b] * w2.x; a1[b] += c4[b] * w2.y; } }
#pragma unroll
        for (int b = 0; b < 4; ++b) { part[(wave * 4 + b) * 128 + 2 * lane] = a0[b]; part[(wave * 4 + b) * 128 + 2 * lane + 1] = a1[b]; }
        __syncthreads();
        { const int b = tid >> 7, cc = tid & 127; float s = bias[col + cc];
#pragma unroll
            for (int w = 0; w < 8; ++w) s += part[(w * 4 + b) * 128 + cc];
            dst[(size_t)b * dstld + col + cc] = s; }
        __syncthreads();
    }
    __syncthreads();
    {   const int gt = (F.vcu * NWAVES + wave) * 64 + lane, NGT = F.G * NWAVES * 64;
        float* WRT = wsp<float>(F, WS_WRT); float* WFT = wsp<float>(F, WS_WFT); const float* router_w = inp(F, I_ROUTER_W); const float* w_kvf = inp(F, I_W_KVF);
        { bf16* WH = (bf16*)WRT; bf16* WL = WH + DEPTH * NE * D;
          for (int i = gt; i < DEPTH * NE * D; i += NGT) { const int l = i >> 15, e = (i >> 10) & 31, k = i & 1023; const float w = router_w[((size_t)l * D + k) * NE + e];
              const unsigned hb = f2bf(w); const float hf = __builtin_bit_cast(float, hb << 16); WH[i] = (bf16)hb; WL[i] = (bf16)f2bf(w - hf); } }
        for (int i = gt; i < NH * D; i += NGT) { const int h = i >> 10, k = i & 1023; WFT[i] = w_kvf[(size_t)k * 2064 + 2048 + h]; }
        int* ident = wsp<int>(F, WS_IDENT); for (int i = gt; i < NSLOT_MAX; i += NGT) ident[i] = i;
    }
    LAS float* scr = (LAS float*)(F.lds + RING_OFF + wave * 16384);
    const int gw = F.vcu * NWAVES + wave, NGW = F.G * NWAVES;
    constexpr int I_CI = 2 * 8 * 96, I_CO = 2 * 8 * 32, I_KV = 8 * 64, I_Q = 2 * 8 * 32, I_O = 2 * 8 * 32, I_GU = 128 * 8 * 64, I_DN = 128 * 8 * 32;
    constexpr int NITEMS = I_CI + I_CO + I_KV + I_Q + I_O + I_GU + I_DN;
    const float* src_ci = inp(F, I_CONV_W_IN); const float* src_co = inp(F, I_CONV_W_OUT); const float* src_kv = inp(F, I_W_KVF); const float* src_q = inp(F, I_ATTN_W_Q); const float* src_o = inp(F, I_ATTN_W_O);
    const float* src_gu = inp(F, I_EXP_W_GU); const float* src_dn = inp(F, I_EXP_W_DOWN);
#define P0_DECODE(it_, SRC, LDW, DST, F8) do { int r = (it_); F8 = 0; \
        if (r < I_CI) { const int mtx = r / (8 * 96), q = r % (8 * 96), kb = q / 96, nb = q % 96, n0 = nb * 32; \
            int drow; if (n0 < 1024) drow = 256 * (n0 >> 7) + (n0 & 127); else if (n0 < 2048) drow = 2048 + (n0 - 1024); else { const int np = n0 - 2048; drow = 256 * (np >> 7) + 128 + (np & 127); } \
            SRC = src_ci + (size_t)mtx * D * 3072 + (size_t)(kb * 128) * 3072 + n0; LDW = 3072; \
            if (CONV_FP8) { DST = (bf16*)(F.ws + WS_WCI + (size_t)mtx * 3072 * D + (size_t)drow * D + kb * 128); F8 = WSH_QKV; } else DST = wsp<bf16>(F, WS_WCI) + (size_t)mtx * 3072 * D + (size_t)drow * D + kb * 128; break; } r -= I_CI; \
        if (r < I_CO) { const int mtx = r >> 8, q = r & 255, kb = q >> 5, nb = q & 31; SRC = src_co + (size_t)mtx * D * D + (size_t)(kb * 128) * D + nb * 32; LDW = D; \
            if (CONV2_FP8) { DST = (bf16*)(F.ws + WS_WCO + (size_t)mtx * D * D + (size_t)(nb * 32) * D + kb * 128); F8 = WSH_O; } else DST = wsp<bf16>(F, WS_WCO) + (size_t)mtx * D * D + (size_t)(nb * 32) * D + kb * 128; break; } r -= I_CO; \
        if (r < I_KV) { const int kb = r >> 6, nb = r & 63; SRC = src_kv + (size_t)(kb * 128) * 2064 + nb * 32; LDW = 2064; \
            if (QKV_FP8) { DST = (bf16*)(F.ws + WS_WKV + (size_t)(nb * 32) * D + kb * 128); F8 = WSH_QKV; } else DST = wsp<bf16>(F, WS_WKV) + (size_t)(nb * 32) * D + kb * 128; break; } r -= I_KV; \
        if (r < I_Q) { const int mtx = r >> 8, q = r & 255, kb = q >> 5, nb = q & 31; SRC = src_q + (size_t)mtx * D * D + (size_t)(kb * 128) * D + nb * 32; LDW = D; \
            if (QKV_FP8) { DST = (bf16*)(F.ws + WS_WQ + (size_t)mtx * D * D + (size_t)(nb * 32) * D + kb * 128); F8 = WSH_QKV; } else DST = wsp<bf16>(F, WS_WQ) + (size_t)mtx * D * D + (size_t)(nb * 32) * D + kb * 128; break; } r -= I_Q; \
        if (r < I_O) { const int mtx = r >> 8, q = r & 255, kb = q >> 5, nb = q & 31; SRC = src_o + (size_t)mtx * D * D + (size_t)(kb * 128) * D + nb * 32; LDW = D; \
            if (QKV_FP8) { DST = (bf16*)(F.ws + WS_WO + (size_t)mtx * D * D + (size_t)(nb * 32) * D + kb * 128); F8 = WSH_O; } else DST = wsp<bf16>(F, WS_WO) + (size_t)mtx * D * D + (size_t)(nb * 32) * D + kb * 128; break; } r -= I_O; \
        if (r < I_GU) { const int mtx = r >> 9, q = r & 511, kb = q >> 6, nb = q & 63, n0 = nb * 32; SRC = src_gu + (size_t)mtx * D * 2048 + (size_t)(kb * 128) * 2048 + n0; LDW = 2048; \
            DST = (bf16*)(F.ws + WS_WGU + ((size_t)mtx * 2048 * D + (size_t)glu_row(n0, 1024) * D + kb * 128) * (MOE_FP8 ? 1 : 2)); F8 = WSH_GU; break; } r -= I_GU; \
        { const int mtx = r >> 8, q = r & 255, kb = q >> 5, nb = q & 31; SRC = src_dn + (size_t)mtx * FF * D + (size_t)(kb * 128) * D + nb * 32; LDW = D; \
            DST = (bf16*)(F.ws + WS_WD + ((size_t)mtx * D * FF + (size_t)(nb * 32) * FF + kb * 128) * (MOE_FP8 ? 1 : 2)); F8 = WSH_DN; } } while (0)
#define P0_LOAD(V, SRC, LDW) do { const float* p_ = (SRC) + (size_t)(lane >> 3) * (LDW) + 4 * (lane & 7); _Pragma("unroll") for (int g_ = 0; g_ < 16; ++g_) V[g_] = __builtin_nontemporal_load((const f32x4*)(p_ + (size_t)(8 * g_) * (LDW))); } while (0)
#define P0_SWZ(k_) ((((k_) >> 4) & 1) << 2 ^ ((k_) & 3))
#define P0_XPOSE(V, DST, F8) do { \
        _Pragma("unroll") for (int g_ = 0; g_ < 16; ++g_) { const int k_ = 8 * g_ + (lane >> 3); *(LAS f32x4*)(scr + k_ * 32 + ((((lane & 7) ^ P0_SWZ(k_)) & 7) << 2)) = V[g_]; } \
        LDS_WAIT(); asm volatile("" ::: "memory"); \
        { const int n_ = lane >> 1, h_ = lane & 1;     \
        if (F8) { const float sc_ = (float)(1 << (F8)); \
          _Pragma("unroll") for (int q_ = 0; q_ < 4; ++q_) { int w_[4]; \
            _Pragma("unroll") for (int d_ = 0; d_ < 4; ++d_) { float e_[4]; \
                _Pragma("unroll") for (int j_ = 0; j_ < 4; ++j_) { const int k_ = 32 * q_ + 16 * h_ + 4 * d_ + j_; e_[j_] = scr[k_ * 32 + (((((n_ >> 2) ^ P0_SWZ(k_)) & 7) << 2) | (n_ & 3))] * sc_; } \
                int t_ = 0; t_ = __builtin_amdgcn_cvt_pk_fp8_f32(e_[0], e_[1], t_, false); t_ = __builtin_amdgcn_cvt_pk_fp8_f32(e_[2], e_[3], t_, true); w_[d_] = t_; } \
            v4u o_; o_.x = (unsigned)w_[0]; o_.y = (unsigned)w_[1]; o_.z = (unsigned)w_[2]; o_.w = (unsigned)w_[3]; \
            *(GAS v4u*)((unsigned char*)(DST) + (size_t)n_ * 1024 + 32 * q_ + 16 * h_) = o_; } } \
        else { \
          _Pragma("unroll") for (int q_ = 0; q_ < 8; ++q_) { float e_[8];     \
            _Pragma("unroll") for (int j_ = 0; j_ < 8; ++j_) { const int k_ = 16 * q_ + 8 * h_ + j_; e_[j_] = scr[k_ * 32 + (((((n_ >> 2) ^ P0_SWZ(k_)) & 7) << 2) | (n_ & 3))]; } \
            v4u o_; o_.x = pk2(e_[0], e_[1]); o_.y = pk2(e_[2], e_[3]); o_.z = pk2(e_[4], e_[5]); o_.w = pk2(e_[6], e_[7]); \
            *(GAS v4u*)((DST) + (size_t)n_ * 1024 + 16 * q_ + 8 * h_) = o_; } } } \
        LDS_WAIT(); asm volatile("" ::: "memory"); } while (0)
    {   f32x4 va[16], vb[16]; const float* sa; const float* sb; int la, lb_, fa = 0, fb = 0; bf16* da; bf16* db;
        int it = gw;
        if (it < NITEMS) { P0_DECODE(it, sa, la, da, fa); P0_LOAD(va, sa, la); }
        while (it < NITEMS) {
            const int it1 = it + NGW;
            P0_XPOSE(va, da, fa);
            if (it1 >= NITEMS) break;
            P0_DECODE(it1, sa, la, da, fa); P0_LOAD(va, sa, la);
            it = it1;
        }
    }
#undef P0_DECODE
#undef P0_LOAD
#undef P0_SWZ
#undef P0_XPOSE
}

__device__ __forceinline__ unsigned f32_to_fp8x4(f32x4 h) { int w8 = 0; w8 = __builtin_amdgcn_cvt_pk_fp8_f32(h.x, h.y, w8, false); w8 = __builtin_amdgcn_cvt_pk_fp8_f32(h.z, h.w, w8, true); return (unsigned)w8; }
__device__ __forceinline__ void ph_mod0(Frame& F) {
    const float* MOD = wsp<float>(F, WS_MOD); bf16* HB = wsp<bf16>(F, WS_HB); const float* xin = inp(F, I_X);
    const int gw = F.vcu * NWAVES + F.wave, NGW = F.G * NWAVES, lane = F.lane;
    for (int row0 = gw * 16; row0 < T; row0 += NGW * 16) {
        const int b = row0 >> 13; const float* mp = MOD + (size_t)b * 3072;
        f32x4 sh[4], sc[4];
#pragma unroll
        for (int j = 0; j < 4; ++j) { sh[j] = *(const f32x4*)(mp + 4 * lane + 256 * j); sc[j] = *(const f32x4*)(mp + 1024 + 4 * lane + 256 * j) + 1.0f; }
        for (int i = 0; i < 16; i += 4) { f32x4 xv[4][4];
#pragma unroll
            for (int r = 0; r < 4; ++r)
#pragma unroll
                for (int j = 0; j < 4; ++j) xv[r][j] = __builtin_nontemporal_load((const f32x4*)(xin + (size_t)(row0 + i + r) * D + 4 * lane + 256 * j));
#pragma unroll
            for (int r = 0; r < 4; ++r)
#pragma unroll
                for (int j = 0; j < 4; ++j) {
                    if (CONV_FP8) *(unsigned*)(wsp<unsigned char>(F, WS_HB8) + (size_t)(row0 + i + r) * D + 4 * lane + 256 * j) = f32_to_fp8x4(xv[r][j] * sc[j] + sh[j]);
                    else *(u32x2*)(HB + (size_t)(row0 + i + r) * D + 4 * lane + 256 * j) = f32_to_bf4(xv[r][j] * sc[j] + sh[j]); } }
    }
}

__device__ __forceinline__ void ph_conv(Frame& F, int l) {
    const bf16* ZB = wsp<bf16>(F, WS_ZB); const bf16* GB = wsp<bf16>(F, WS_GB); bf16* YB = wsp<bf16>(F, WS_YB);
    const float* cw = inp(F, I_CONV_W) + (size_t)l * 3 * D;
    const int gw = F.vcu * NWAVES + F.wave, NGW = F.G * NWAVES, lane = F.lane;
    for (int task = gw; task < (T / 16) * 2; task += NGW) {
        const int row0 = (task >> 1) * 16, ch = (task & 1) * 512 + lane * 8;
        f32x4 w0[2], w1[2], w2[2];
#pragma unroll
        for (int q = 0; q < 2; ++q) { w0[q] = *(const f32x4*)(cw + ch + 4 * q); w1[q] = *(const f32x4*)(cw + D + ch + 4 * q); w2[q] = *(const f32x4*)(cw + 2 * D + ch + 4 * q); }
        f32x4 zm2[2], zm1[2];
        if ((row0 & (SEQ - 1)) == 0) { zm2[0] = zm2[1] = zm1[0] = zm1[1] = (f32x4){0.f, 0.f, 0.f, 0.f}; }
        else { const v4u a = *(const v4u*)(ZB + (size_t)(row0 - 2) * D + ch), b = *(const v4u*)(ZB + (size_t)(row0 - 1) * D + ch);
            zm2[0] = bf4_to_f32((u32x2){a.x, a.y}); zm2[1] = bf4_to_f32((u32x2){a.z, a.w}); zm1[0] = bf4_to_f32((u32x2){b.x, b.y}); zm1[1] = bf4_to_f32((u32x2){b.z, b.w}); }
#pragma unroll 4
        for (int i = 0; i < 16; ++i) { const size_t o = (size_t)(row0 + i) * D + ch;
            const v4u zz = *(const v4u*)(ZB + o), gg = *(const v4u*)(GB + o);
            f32x4 z[2], g[2]; z[0] = bf4_to_f32((u32x2){zz.x, zz.y}); z[1] = bf4_to_f32((u32x2){zz.z, zz.w}); g[0] = bf4_to_f32((u32x2){gg.x, gg.y}); g[1] = bf4_to_f32((u32x2){gg.z, gg.w});
            f32x4 y[2];
#pragma unroll
            for (int q = 0; q < 2; ++q) { y[q] = g[q] * (w0[q] * zm2[q] + w1[q] * zm1[q] + w2[q] * z[q]); zm2[q] = zm1[q]; zm1[q] = z[q]; }
            if (CONV2_FP8) *(u32x2*)((unsigned char*)YB + o) = (u32x2){f32_to_fp8x4(y[0]), f32_to_fp8x4(y[1])};
            else { const u32x2 p0 = f32_to_bf4(y[0]), p1 = f32_to_bf4(y[1]);
                *(v4u*)(YB + o) = (v4u){p0.x, p0.y, p1.x, p1.y}; } }
    }
}

__device__ __forceinline__ void ld16(const float* p, f32x4 (&v)[4], int lane) {
#pragma unroll
    for (int j = 0; j < 4; ++j) v[j] = *(const f32x4*)(p + 4 * lane + 256 * j);
}
#define LN1_COL(lane_, q_) (((q_) >> 1) * 512 + 8 * (lane_) + 4 * ((q_) & 1))
__device__ __forceinline__ void ld16c(const float* p, f32x4 (&v)[4], int lane) {
#pragma unroll
    for (int q = 0; q < 4; ++q) v[q] = *(const f32x4*)(p + LN1_COL(lane, q));
}
__device__ __forceinline__ void bf8_to_f32(v4u w, f32x4& a, f32x4& b) { a = bf4_to_f32((u32x2){w.x, w.y}); b = bf4_to_f32((u32x2){w.z, w.w}); }
__device__ __forceinline__ f32x4 fp8x4_to_f32(unsigned w) { const f32x2 lo = __builtin_amdgcn_cvt_pk_f32_fp8((int)w, false), hi = __builtin_amdgcn_cvt_pk_f32_fp8((int)w, true); return (f32x4){lo.x, lo.y, hi.x, hi.y}; }
typedef GAS v4u gv4u; typedef GAS f32x4 gf32x4; typedef GAS u32x2 gu32x2;
__device__ __forceinline__ void ln1_kv(Frame& F, const f32x4 (&v)[4], size_t ro, int row, int lo_, int lane, LAS f32x4* WL, LAS f32x4* VL, float bfv) {
    bf16* HKV = wspo<bf16>(F, WS_HKV);
    f32x4 kv[4];
#pragma unroll
    for (int q = 0; q < 4; ++q) kv[q] = v[q] * VL[1280 + 64 * q + lo_] + VL[1536 + 64 * q + lo_];
    if (QKV_FP8) { *(gu32x2*)((unsigned char*)HKV + ro + 8 * lane) = (u32x2){f32_to_fp8x4(kv[0]), f32_to_fp8x4(kv[1])}; *(gu32x2*)((unsigned char*)HKV + ro + 512 + 8 * lane) = (u32x2){f32_to_fp8x4(kv[2]), f32_to_fp8x4(kv[3])}; }
    else { const u32x2 p0 = f32_to_bf4(kv[0]), p1 = f32_to_bf4(kv[1]), p2 = f32_to_bf4(kv[2]), p3 = f32_to_bf4(kv[3]);
        *(gv4u*)(HKV + ro + 8 * lane) = (v4u){p0.x, p0.y, p1.x, p1.y}; *(gv4u*)(HKV + ro + 512 + 8 * lane) = (v4u){p2.x, p2.y, p3.x, p3.y}; }
    f32x2 a2[NH];
#pragma unroll
    for (int e = 0; e < NH; ++e) { a2[e] = (f32x2){0.f, 0.f};
#pragma unroll
        for (int q = 0; q < 4; ++q) { const f32x4 w = WL[e * 256 + 64 * q + lane]; a2[e] += (f32x2){kv[q].x, kv[q].y} * (f32x2){w.x, w.y}; a2[e] += (f32x2){kv[q].z, kv[q].w} * (f32x2){w.z, w.w}; } }
    float rr_[NH];
#pragma unroll
    for (int e = 0; e < NH; ++e) rr_[e] = a2[e].x + a2[e].y;
    const int hh = lane >> 2;
    const float z = LaneRed<NH, 32>::run(rr_, lane) + bfv;
    const float lf = fminf(z, 0.f) - log1pf(expf(-fabsf(z)));
    if ((lane & 3) == 0) ((GAS float*)wspo<float>(F, WS_LOGF))[(size_t)row * NH + hh] = lf;
}
__device__ __forceinline__ void ph_ln1(Frame& F, int l, const bf16* xinb, void* xout_, unsigned poison) {
    const bool out_f32 = (l == DEPTH - 1), has_next = (l < DEPTH - 1), do_kv = (l == 1);
    float* xout = (float*)xout_; bf16* xoutb = (bf16*)xout_;
    const int tid = F.tid, lane = F.lane, wave = F.wave;
    const float* MOD = wsp<float>(F, WS_MOD);
    bf16* HB = wspo<bf16>(F, WS_HB); unsigned char* HB8 = F.dup ? wsp<unsigned char>(F, WS_A1 + WS_END) : wsp<unsigned char>(F, WS_HB8);
    LAS f32x4* WL = (LAS f32x4*)(F.lds);
    if (do_kv) { const float* src = wsp<float>(F, WS_WFT); for (int i = tid; i < NH * D / 4; i += NWAVES * 64) { const int e = i >> 8, r = i & 255, q = r >> 6, ln = r & 63; WL[i] = *(const f32x4*)(src + (size_t)e * D + LN1_COL(ln, q)); } }
    __syncthreads();
    const float* lgp = inp(F, I_LN_G) + (size_t)(l * 2 + 1) * D; const float* lbp = inp(F, I_LN_B) + (size_t)(l * 2 + 1) * D;
    const float* b_f = inp(F, I_B_F);
    const int nm = (l + 1) * 2;
    const unsigned char* Y2 = wsp<unsigned char>(F, WS_Y2);
    const int* slot_of = wsp<int>(F, WS_SLOTOF); const float* tkw = wsp<float>(F, WS_TKW);
    const float qnan = __builtin_nanf("");
    LAS f32x4* VL = (LAS f32x4*)(F.lds + 65536);
    for (int g = F.vcu; g < NGROUP; g += F.G) {
        const int row0 = g * 128 + wave * 16, b = row0 >> 13;
        __syncthreads();
        if (tid < 256) { const int q = tid >> 6, ln = tid & 63, col = LN1_COL(ln, q);
            VL[tid] = *(const gf32x4*)(lbp + col);
            if (has_next) { VL[256 + tid] = *(const gf32x4*)(MOD + ((size_t)nm * 4 + b) * 3072 + 1024 + col) + 1.0f; VL[512 + tid] = *(const gf32x4*)(MOD + ((size_t)nm * 4 + b) * 3072 + col); }
            VL[768 + tid] = *(const gf32x4*)(MOD + ((size_t)(l * 2 + 1) * 4 + b) * 3072 + 2048 + col) + 1.0f; VL[1024 + tid] = *(const gf32x4*)(lgp + col);
            if (do_kv) { const float* kvm = wsp<float>(F, WS_KVMOD) + (size_t)b * 2048; VL[1280 + tid] = *(const gf32x4*)(kvm + 1024 + col) + 1.0f; VL[1536 + tid] = *(const gf32x4*)(kvm + col); } }
        __syncthreads();
        const float bfv = do_kv ? ((const GAS float*)b_f)[lane >> 2] : 0.f;
        i32x4 so_all; f32x4 tw_all;
        { const int rr = row0 + (lane & 15); so_all = *(const GAS i32x4*)(slot_of + (size_t)rr * 4); tw_all = *(const gf32x4*)(tkw + (size_t)rr * 4); }
        const int s0 = so_all.x, s1 = so_all.y, s2 = so_all.z, s3 = so_all.w; const float t0 = tw_all.x, t1 = tw_all.y, t2 = tw_all.z, t3 = tw_all.w;
#define LN1_LOAD(XV, YV, TW, ii) do { _Pragma("unroll") for (int r = 0; r < 2; ++r) { const size_t ro = (size_t)(row0 + (ii) + r) * D; int so[4]; \
            so[0] = __builtin_amdgcn_readlane(s0, (ii) + r); so[1] = __builtin_amdgcn_readlane(s1, (ii) + r); so[2] = __builtin_amdgcn_readlane(s2, (ii) + r); so[3] = __builtin_amdgcn_readlane(s3, (ii) + r); \
            TW[r][0] = __int_as_float(__builtin_amdgcn_readlane(__float_as_int(t0), (ii) + r)); TW[r][1] = __int_as_float(__builtin_amdgcn_readlane(__float_as_int(t1), (ii) + r)); \
            TW[r][2] = __int_as_float(__builtin_amdgcn_readlane(__float_as_int(t2), (ii) + r)); TW[r][3] = __int_as_float(__builtin_amdgcn_readlane(__float_as_int(t3), (ii) + r)); \
            XV[r][0] = *(const gv4u*)(xinb + ro + 8 * lane); XV[r][1] = *(const gv4u*)(xinb + ro + 512 + 8 * lane); \
            _Pragma("unroll") for (int k = 0; k < 4; ++k) { \
                if (Y2_FP8) { const u32x2 lo2_ = *(const gu32x2*)(Y2 + (size_t)so[k] * D + 8 * lane), hi2_ = *(const gu32x2*)(Y2 + (size_t)so[k] * D + 512 + 8 * lane); YV[r][k][0] = (v4u){lo2_.x, lo2_.y, hi2_.x, hi2_.y}; } \
                else { YV[r][k][0] = *(const gv4u*)(Y2 + ((size_t)so[k] * D + 8 * lane) * 2); YV[r][k][Y2_FP8 ? 0 : 1] = *(const gv4u*)(Y2 + ((size_t)so[k] * D + 512 + 8 * lane) * 2); } } } } while (0)
#define LN1_BODY(XV, YV, TW, ii) do { _Pragma("unroll") for (int r = 0; r < 2; ++r) { const int row = row0 + (ii) + r; const size_t ro = (size_t)row * D; \
            f32x4 v[4], s[4]; float s1_ = 0.f; int lo_ = lane; asm volatile("" : "+v"(lo_)); \
            _Pragma("unroll") for (int q = 0; q < 4; ++q) s[q] = (f32x4){0.f, 0.f, 0.f, 0.f}; \
            _Pragma("unroll") for (int k = 0; k < 4; ++k) { f32x4 y[4]; \
                if (Y2_FP8) { y[0] = fp8x4_to_f32(YV[r][k][0].x); y[1] = fp8x4_to_f32(YV[r][k][0].y); y[2] = fp8x4_to_f32(YV[r][k][0].z); y[3] = fp8x4_to_f32(YV[r][k][0].w); } \
                else { bf8_to_f32(YV[r][k][0], y[0], y[1]); bf8_to_f32(YV[r][k][Y2_FP8 ? 0 : 1], y[2], y[3]); } \
                _Pragma("unroll") for (int q = 0; q < 4; ++q) s[q] = s[q] + y[q] * TW[r][k]; } \
            bf8_to_f32(XV[r][0], v[0], v[1]); bf8_to_f32(XV[r][1], v[2], v[3]); \
            _Pragma("unroll") for (int q = 0; q < 4; ++q) { v[q] = v[q] * DN_ALPHA + VL[768 + 64 * q + lo_] * s[q]; s1_ += (v[q].x + v[q].y) + (v[q].z + v[q].w); } \
            const float mean = wave_sum(s1_) * (1.0f / D); float s2_ = 0.f; \
            _Pragma("unroll") for (int q = 0; q < 4; ++q) { v[q] = v[q] - mean; s2_ += (v[q].x * v[q].x + v[q].y * v[q].y) + (v[q].z * v[q].z + v[q].w * v[q].w); } \
            const float rstd = 1.0f / sqrtf(wave_sum(s2_) * (1.0f / D) + LN_EPS); \
            f32x4 h[4]; \
            _Pragma("unroll") for (int q = 0; q < 4; ++q) { v[q] = v[q] * rstd * VL[1024 + 64 * q + lo_] + VL[64 * q + lo_]; h[q] = v[q] * VL[256 + 64 * q + lo_] + VL[512 + 64 * q + lo_]; } \
            if (out_f32) { _Pragma("unroll") for (int q = 0; q < 4; ++q) *(gf32x4*)(xout + ro + LN1_COL(lane, q)) = poison ? (f32x4){qnan, qnan, qnan, qnan} : v[q]; } \
            else { const u32x2 p0 = f32_to_bf4(v[0]), p1 = f32_to_bf4(v[1]), p2 = f32_to_bf4(v[2]), p3 = f32_to_bf4(v[3]); \
                *(gv4u*)(xoutb + ro + 8 * lane) = (v4u){p0.x, p0.y, p1.x, p1.y}; *(gv4u*)(xoutb + ro + 512 + 8 * lane) = (v4u){p2.x, p2.y, p3.x, p3.y}; } \
            if (has_next) { \
                if (QKV_FP8 && (CONV_FP8 || l >= 1)) { *(gu32x2*)(HB8 + ro + 8 * lane) = (u32x2){f32_to_fp8x4(h[0]), f32_to_fp8x4(h[1])}; *(gu32x2*)(HB8 + ro + 512 + 8 * lane) = (u32x2){f32_to_fp8x4(h[2]), f32_to_fp8x4(h[3])}; } \
                else { const u32x2 p0 = f32_to_bf4(h[0]), p1 = f32_to_bf4(h[1]), p2 = f32_to_bf4(h[2]), p3 = f32_to_bf4(h[3]); \
                    *(gv4u*)(HB + ro + 8 * lane) = (v4u){p0.x, p0.y, p1.x, p1.y}; *(gv4u*)(HB + ro + 512 + 8 * lane) = (v4u){p2.x, p2.y, p3.x, p3.y}; } } \
            if (do_kv) ln1_kv(F, v, ro, row, lo_, lane, WL, VL, bfv); } } while (0)
        v4u xA[2][2], yA[2][4][Y2_FP8 ? 1 : 2], xB[2][2], yB[2][4][Y2_FP8 ? 1 : 2]; float tA[2][4], tB[2][4];
        LN1_LOAD(xA, yA, tA, 0);
        for (int i = 0; i < 16; i += 4) {
            LN1_LOAD(xB, yB, tB, i + 2);
            LN1_BODY(xA, yA, tA, i);
            if (i + 4 < 16) LN1_LOAD(xA, yA, tA, i + 4);
            LN1_BODY(xB, yB, tB, i + 2);
        }
#undef LN1_LOAD
#undef LN1_BODY
    }
}

constexpr int LN0_PITCH = 2064;
constexpr int LN0_HHI = 0, LN0_HLO = 16 * LN0_PITCH, LN0_P = 2 * 16 * LN0_PITCH;
__device__ __forceinline__ void ph_ln0(Frame& F, int l, const void* xin_, bf16* xout) {
    const int tid = F.tid, lane = F.lane, wave = F.wave;
    const bool in_f32 = (l == 0);
    const float* xin = (const float*)xin_; const bf16* xinb = (const bf16*)xin_;
    const float* MOD = wsp<float>(F, WS_MOD);
    LAS int* hist = (LAS int*)(F.lds + HIST_OFF);
    LAS unsigned char* L = F.lds;
    if (tid < 32) hist[tid] = 0;
    const float* lgp = inp(F, I_LN_G) + (size_t)(l * 2) * D; const float* lbp = inp(F, I_LN_B) + (size_t)(l * 2) * D;
    const float* router_b = inp(F, I_ROUTER_B) + l * NE;
    const bf16* SUB = wsp<bf16>(F, WS_SUB); float* tkw = wspo<float>(F, WS_TKW); int* tki = wspo<int>(F, WS_TKI);
    unsigned char* HB8 = F.dup ? wsp<unsigned char>(F, WS_A1 + WS_END) : wsp<unsigned char>(F, WS_HB8);
    bf16* HBb = wspo<bf16>(F, WS_HB);
    pg8::bf16x8 bh[2][4];
    const bf16* WLo_ = (const bf16*)wsp<float>(F, WS_WRT) + (size_t)l * NE * D + DEPTH * NE * D;
    { const bf16* WH = (const bf16*)wsp<float>(F, WS_WRT) + (size_t)l * NE * D;
#pragma unroll
      for (int hf = 0; hf < 2; ++hf)
#pragma unroll
          for (int s = 0; s < 4; ++s) { const size_t o = (size_t)(16 * hf + (lane & 15)) * D + 128 * wave + 32 * s + 8 * (lane >> 4);
              bh[hf][s] = *(const pg8::bf16x8*)(WH + o); } }
    __syncthreads();
    for (int g = F.vcu; g < NGROUP; g += F.G) {
        const int b = (g * 128) >> 13;
        f32x4 g1[4], lg[4], lb[4], msc[4], msh[4];
        ld16(MOD + ((size_t)(l * 2) * 4 + b) * 3072 + 2048, g1, lane); ld16(lgp, lg, lane); ld16(lbp, lb, lane);
        ld16(MOD + ((size_t)(l * 2 + 1) * 4 + b) * 3072, msh, lane); ld16(MOD + ((size_t)(l * 2 + 1) * 4 + b) * 3072 + 1024, msc, lane);
#pragma unroll
        for (int j = 0; j < 4; ++j) { g1[j] = g1[j] + 1.0f; msc[j] = msc[j] + 1.0f; }
        u32x2 xn[2][4], svn[2][4];
#define LN0_LOADROWS(cc) do { const int rr0_ = g * 128 + 16 * (cc) + 2 * wave; _Pragma("unroll") for (int r = 0; r < 2; ++r) { const size_t ro = (size_t)(rr0_ + r) * D; \
            if (!in_f32) { _Pragma("unroll") for (int j = 0; j < 4; ++j) xn[r][j] = *(const u32x2*)(xinb + ro + 4 * lane + 256 * j); } \
            _Pragma("unroll") for (int j = 0; j < 4; ++j) svn[r][j] = *(const u32x2*)(SUB + ro + 4 * lane + 256 * j); } } while (0)
        LN0_LOADROWS(0);
        for (int c = 0; c < 8; ++c) {
            const int r0 = g * 128 + 16 * c + 2 * wave;
            f32x4 v[2][4]; u32x2 sv[2][4];
#pragma unroll
            for (int r = 0; r < 2; ++r)
#pragma unroll
                for (int j = 0; j < 4; ++j) { sv[r][j] = svn[r][j]; if (!in_f32) v[r][j] = bf4_to_f32(xn[r][j]); }
            if (in_f32) { ld16(xin + (size_t)r0 * D, v[0], lane); ld16(xin + (size_t)(r0 + 1) * D, v[1], lane); }
#pragma unroll
            for (int r = 0; r < 2; ++r) { const size_t ro = (size_t)(r0 + r) * D;
                float s1 = 0.f;
#pragma unroll
                for (int j = 0; j < 4; ++j) { v[r][j] = v[r][j] * DN_ALPHA + g1[j] * bf4_to_f32(sv[r][j]); s1 += (v[r][j].x + v[r][j].y) + (v[r][j].z + v[r][j].w); }
                const float mean = wave_sum(s1) * (1.0f / D); float s2 = 0.f;
#pragma unroll
                for (int j = 0; j < 4; ++j) { v[r][j] = v[r][j] - mean; s2 += (v[r][j].x * v[r][j].x + v[r][j].y * v[r][j].y) + (v[r][j].z * v[r][j].z + v[r][j].w * v[r][j].w); }
                const float rstd = 1.0f / sqrtf(wave_sum(s2) * (1.0f / D) + LN_EPS);
#pragma unroll
                for (int j = 0; j < 4; ++j) { const f32x4 xo = v[r][j] * rstd * lg[j] + lb[j]; *(u32x2*)(xout + ro + 4 * lane + 256 * j) = f32_to_bf4(xo);
                    const f32x4 h = xo * msc[j] + msh[j];
                    if (MOE_FP8) { int w8 = 0; w8 = __builtin_amdgcn_cvt_pk_fp8_f32(h.x, h.y, w8, false); w8 = __builtin_amdgcn_cvt_pk_fp8_f32(h.z, h.w, w8, true); *(int*)(HB8 + ro + 4 * lane + 256 * j) = w8; }
                    else *(u32x2*)(HBb + ro + 4 * lane + 256 * j) = f32_to_bf4(h);
                    const u32x2 hh = f32_to_bf4(h); const f32x4 hr = bf4_to_f32(hh); const u32x2 hl = f32_to_bf4(h - hr);
                    *(LAS u32x2*)(L + LN0_HHI + (2 * wave + r) * LN0_PITCH + (4 * lane + 256 * j) * 2) = hh;
                    *(LAS u32x2*)(L + LN0_HLO + (2 * wave + r) * LN0_PITCH + (4 * lane + 256 * j) * 2) = hl; }
            }
            if (c + 1 < 8) LN0_LOADROWS(c + 1);
            pg8::bf16x8 bl[2][4];
#pragma unroll
            for (int hf = 0; hf < 2; ++hf)
#pragma unroll
                for (int s = 0; s < 4; ++s) bl[hf][s] = *(const pg8::bf16x8*)(WLo_ + (size_t)(16 * hf + (lane & 15)) * D + 128 * wave + 32 * s + 8 * (lane >> 4));
            __syncthreads();
            {   pg8::f32x4 acc[2]; acc[0] = (pg8::f32x4){0.f, 0.f, 0.f, 0.f}; acc[1] = acc[0];
                const int aoff = (lane & 15) * LN0_PITCH + (128 * wave + 8 * (lane >> 4)) * 2;
#pragma unroll
                for (int s = 0; s < 4; ++s) { const pg8::bf16x8 ah = *(const LAS pg8::bf16x8*)(L + LN0_HHI + aoff + 64 * s), al = *(const LAS pg8::bf16x8*)(L + LN0_HLO + aoff + 64 * s);
#pragma unroll
                    for (int hf = 0; hf < 2; ++hf) { acc[hf] = __builtin_amdgcn_mfma_f32_16x16x32_bf16(ah, bh[hf][s], acc[hf], 0, 0, 0); acc[hf] = __builtin_amdgcn_mfma_f32_16x16x32_bf16(ah, bl[hf][s], acc[hf], 0, 0, 0);
                        acc[hf] = __builtin_amdgcn_mfma_f32_16x16x32_bf16(al, bh[hf][s], acc[hf], 0, 0, 0); } }
                LAS float* P = (LAS float*)(L + LN0_P) + wave * 512;
#pragma unroll
                for (int hf = 0; hf < 2; ++hf)
#pragma unroll
                    for (int q = 0; q < 4; ++q) P[(4 * (lane >> 4) + q) * 32 + 16 * hf + (lane & 15)] = acc[hf][q];
            }
            __syncthreads();
            {   const int t16 = tid >> 5, e = tid & 31; const LAS float* P = (const LAS float*)(L + LN0_P) + t16 * 32 + e;
                float lv = router_b[e];
#pragma unroll
                for (int w = 0; w < 8; ++w) lv += P[w * 512];
                float tv[4]; int ti[4];
#pragma unroll
                for (int k = 0; k < 4; ++k) { float m = lv; int mi = e;
#define LN0_ARGMAX(OM, OI) do { const float om = (OM); const int oi = (OI); const bool take = (om > m) || (om == m && oi < mi); m = take ? om : m; mi = take ? oi : mi; } while (0)
                    LN0_ARGMAX(dpp_mov<0xB1>(m), __builtin_amdgcn_update_dpp(0, mi, 0xB1, 0xF, 0xF, true));
                    LN0_ARGMAX(dpp_mov<0x4E>(m), __builtin_amdgcn_update_dpp(0, mi, 0x4E, 0xF, 0xF, true));
                    LN0_ARGMAX(dpp_mov<0x141>(m), __builtin_amdgcn_update_dpp(0, mi, 0x141, 0xF, 0xF, true));
                    LN0_ARGMAX(dpp_mov<0x140>(m), __builtin_amdgcn_update_dpp(0, mi, 0x140, 0xF, 0xF, true));
                    LN0_ARGMAX(__shfl_xor(m, 16), __shfl_xor(mi, 16));
#undef LN0_ARGMAX
                    tv[k] = m; ti[k] = mi; if (e == mi) lv = -INFINITY; }
                const float e1 = expf(tv[1] - tv[0]), e2 = expf(tv[2] - tv[0]), e3 = expf(tv[3] - tv[0]); const float inv = 1.0f / (1.0f + e1 + e2 + e3);
                const int row = g * 128 + 16 * c + t16;
                if (e == 0) { *(i32x4*)(tki + (size_t)row * 4) = (i32x4){ti[0], ti[1], ti[2], ti[3]}; *(f32x4*)(tkw + (size_t)row * 4) = (f32x4){inv, e1 * inv, e2 * inv, e3 * inv}; }
                if (e < 4) { const int ee = e == 0 ? ti[0] : e == 1 ? ti[1] : e == 2 ? ti[2] : ti[3]; __hip_atomic_fetch_add(hist + ee, 1, __ATOMIC_RELAXED, __HIP_MEMORY_SCOPE_WORKGROUP); }
            }
        }
#undef LN0_LOADROWS
        __syncthreads(); if (tid < 32) { wspo<int>(F, WS_BLKCNT)[g * 32 + tid] = hist[tid]; hist[tid] = 0; } __syncthreads();
    }
}

__device__ __forceinline__ void ph_slot(Frame& F) {
    const int tid = F.tid;
    LAS int* cnt = (LAS int*)(F.lds);
    LAS int* sw = (LAS int*)(F.lds + SLOTW_OFF);
    const int* blk = wsp<int>(F, WS_BLKCNT);
    for (int i = tid; i < NGROUP * 32 / 4; i += NWAVES * 64) ((LAS i32x4*)cnt)[i] = ((const i32x4*)blk)[i];
    __syncthreads();
    LAS int* PS = cnt + NGROUP * 32;
    { const int e = tid & 31, part = tid >> 5; int s = 0;
#pragma unroll
      for (int q = 0; q < 16; ++q) s += cnt[(part * 16 + q) * 32 + e];
      PS[part * 32 + e] = s; }
    __syncthreads();
    if (tid < 32) { int s = 0;
#pragma unroll
        for (int p = 0; p < 16; ++p) s += PS[p * 32 + tid];
        sw[tid] = s; }
    __syncthreads();
    if (tid == 0) { int acc = 0; for (int e = 0; e < NE; ++e) { sw[32 + e] = acc; acc += (sw[e] + 255) >> 8; } sw[128] = acc; }
    __syncthreads();
    const int* tki = wsp<int>(F, WS_TKI); int* slot_of = wsp<int>(F, WS_SLOTOF); int* slot_tok = wsp<int>(F, WS_SLOTTOK);
    for (int g = F.vcu; g < NGROUP; g += F.G) {
        if (tid < 32) { int s = 0; const int gp = g >> 4; for (int p = 0; p < gp; ++p) s += PS[p * 32 + tid]; for (int gq = gp * 16; gq < g; ++gq) s += cnt[gq * 32 + tid]; sw[96 + tid] = sw[32 + tid] * 256 + s; }
        __syncthreads();
        { const int a = g * 512 + tid; const int e = tki[a]; const int slot = __hip_atomic_fetch_add(sw + 96 + e, 1, __ATOMIC_RELAXED, __HIP_MEMORY_SCOPE_WORKGROUP); slot_of[a] = slot; slot_tok[slot] = a >> 2; }
        __syncthreads();
    }
    if (blockIdx.x == 0) {
        int* tiles = wsp<int>(F, WS_TILES);
        for (int e = 0; e < NE; ++e) { const int t0 = sw[32 + e], nt = (sw[e] + 255) >> 8; for (int i = tid; i < nt; i += NWAVES * 64) tiles[t0 + i] = e;
            const int p0 = t0 * 256 + sw[e], p1 = (t0 + nt) * 256; for (int i = p0 + tid; i < p1; i += NWAVES * 64) slot_tok[i] = 0; }
        if (tid == 0) tiles[1023] = sw[128];
    }
}

__device__ __forceinline__ pg8::MoeOrder moe_order(Frame& F, int sh) {
    LAS int* tl = (LAS int*)(F.lds + TILE_OFF);
    const int* tiles = wsp<int>(F, WS_TILES);
    const int NT = __builtin_amdgcn_readfirstlane(tiles[1023]);
    for (int i = F.tid; i < NTILE_MAX; i += NWAVES * 64) tl[i] = (i < NT) ? tiles[i] : 0;
    __syncthreads();
    const long U = (long)NT << sh;
    pg8::MoeOrder S; S.u0 = __builtin_amdgcn_readfirstlane((int)((U * F.vcu) / F.G)); S.u1 = __builtin_amdgcn_readfirstlane((int)((U * (F.vcu + 1)) / F.G)); S.sh = sh; S.tile_e = tl;
    S.mode = (F.G % 32 == 0) ? 1 : 0; S.x = F.vcu >> 5; S.c = F.vcu & 31; S.nx = F.G >> 5; S.NT = NT;
    S.rev = 0;
#if defined(YK_MOE_ORDER0)
    S.mode = 0;
#endif
    return S;
}

__device__ __forceinline__ void ph_cumsum(Frame& F) {
    LAS float* tot = (LAS float*)(F.lds);
    const float* logf = wsp<float>(F, WS_LOGF); float* cs = wsp<float>(F, WS_CS);
    const int tid = F.tid;
    for (int bh = blockIdx.x; bh < BATCH * NH; bh += F.G) {
        const int b = bh >> 4, hh = bh & 15; const int t0 = tid * 16;
        float v[16]; float run = 0.f;
#pragma unroll
        for (int i = 0; i < 16; ++i) { run += logf[((size_t)b * SEQ + t0 + i) * NH + hh]; v[i] = run; }
        float inc = run;
#pragma unroll
        for (int o = 1; o < 64; o <<= 1) { const float up = __shfl_up(inc, o); if (F.lane >= o) inc += up; }
        if (F.lane == 63) tot[F.wave] = inc;
        __syncthreads();
        float off = inc - run;
        for (int w = 0; w < F.wave; ++w) off += tot[w];
#pragma unroll
        for (int i = 0; i < 16; ++i) cs[(size_t)bh * SEQ + t0 + i] = (off + v[i]) * LOG2E;
        __syncthreads();
    }
}

__device__ __forceinline__ void ph_knorm(Frame& F) {
    const bf16* KB = wsp<bf16>(F, WS_K); unsigned* km = wsp<unsigned>(F, WS_KMAX);
    const int gw = F.vcu * NWAVES + F.wave, NGW = F.G * NWAVES, lane = F.lane;
    for (int row0 = gw * 16; row0 < T; row0 += NGW * 16) {
        const int b = row0 >> 13; float mx = 0.f;
        for (int i = 0; i < 16; i += 4) { v4u a[4], c[4];
#pragma unroll
            for (int r = 0; r < 4; ++r) { const bf16* rp = KB + (size_t)(row0 + i + r) * D + lane * 16; a[r] = *(const v4u*)rp; c[r] = *(const v4u*)(rp + 8); }
#pragma unroll
            for (int r = 0; r < 4; ++r) { const f32x4 x0 = bf4_to_f32((u32x2){a[r].x, a[r].y}), x1 = bf4_to_f32((u32x2){a[r].z, a[r].w}), x2 = bf4_to_f32((u32x2){c[r].x, c[r].y}), x3 = bf4_to_f32((u32x2){c[r].z, c[r].w});
                const f32x4 q = x0 * x0 + x1 * x1 + x2 * x2 + x3 * x3; float s = (q.x + q.y) + (q.z + q.w);
                s += dpp_mov<0xB1>(s); s += dpp_mov<0x4E>(s); mx = fmaxf(mx, s); } }
        if ((lane & 3) == 0) atomicMax(km + b * NH + (lane >> 2), __float_as_uint(mx));
    }
}
constexpr int ST_OFF = LDSCTL_OFF + 9216, WAVETAB_OFF = ST_OFF + 256;
enum { ST_PH = 0, ST_L, ST_LO, ST_HI, ST_VCU, ST_G, ST_WS_LO, ST_WS_HI, ST_BAR_LO, ST_BAR_HI, ST_BX };
__device__ __forceinline__ int st_get(LAS unsigned char* L, int i) { return __builtin_amdgcn_readfirstlane(((volatile LAS int*)(L + ST_OFF))[i]); }
__device__ __forceinline__ unsigned hw_slot() { return (unsigned)__builtin_amdgcn_s_getreg((5 << 11) | 4) & 63u; }
__device__ __forceinline__ Frame fresh(LAS unsigned char* L) {
    Frame P; P.lds = L; P.MISC = (volatile LAS unsigned*)(L + MISC_OFF);
    int wave = __builtin_amdgcn_readfirstlane(((volatile LAS int*)(L + WAVETAB_OFF))[hw_slot()]);
    int lane = (int)__builtin_amdgcn_mbcnt_hi(~0u, __builtin_amdgcn_mbcnt_lo(~0u, 0u)); asm volatile("" : "+v"(lane));
    P.dup = 0; P.wave = wave; P.lane = lane; P.tid = wave * 64 + lane; P.vcu = st_get(L, ST_VCU); P.G = st_get(L, ST_G);
    P.ws = (unsigned char*)(((unsigned long long)(unsigned)st_get(L, ST_WS_HI) << 32) | (unsigned)st_get(L, ST_WS_LO));
    return P;
}
__device__ __forceinline__ void grid_barrier(LAS unsigned char* L, int tid) {
    XcdBarrier b; b.bar = (unsigned*)(((unsigned long long)(unsigned)st_get(L, ST_BAR_HI) << 32) | (unsigned)st_get(L, ST_BAR_LO)); b.x = xb_xcc_id(); b.st = (volatile LAS unsigned*)(L + MISC_OFF) + 8;
    xcd_barrier(b, tid == 0);
}
__device__ __forceinline__ bool ph_on(LAS unsigned char* L) { const int ph = st_get(L, ST_PH); return ph >= st_get(L, ST_LO) && ph < st_get(L, ST_HI); }
__device__ __forceinline__ void ph_end(LAS unsigned char* L) {
    const int ph = st_get(L, ST_PH), lo = st_get(L, ST_LO), hi = st_get(L, ST_HI);
    const int wave = __builtin_amdgcn_readfirstlane(((volatile LAS int*)(L + WAVETAB_OFF))[hw_slot()]);
    const int tid = wave * 64 + (int)__builtin_amdgcn_mbcnt_hi(~0u, __builtin_amdgcn_mbcnt_lo(~0u, 0u));
    if (ph >= lo && ph + 1 < hi) grid_barrier(L, tid); else __syncthreads();
#if defined(YK_XBAR)
    if (ph >= lo && ph + 1 < hi) { for (int q_ = 0; q_ < YK_XBAR; ++q_) grid_barrier(L, tid); }
#endif
    if (tid == 0) ((volatile LAS int*)(L + ST_OFF))[ST_PH] = ph + 1;
#if defined(YK_PROF)
    if (tid == 0 && st_get(L, ST_BX) == 0) { unsigned long long* stamps = (unsigned long long*)((((unsigned long long)(unsigned)st_get(L, ST_WS_HI) << 32) | (unsigned)st_get(L, ST_WS_LO)) + WS_CTL + 768 * 1024); stamps[ph + 1] = __builtin_amdgcn_s_memrealtime(); if (ph == 0) stamps[0] = ((volatile LAS unsigned long long*)(L + ST_OFF + 128))[0]; }
#endif
    __syncthreads();
}
struct Args { const void* in[21]; float* out; unsigned char* ws; int ph_lo, ph_hi, region, pad; };
__global__ void __launch_bounds__(NWAVES * 64, 2) yoco_fwd(Args args) {
    extern __shared__ __attribute__((aligned(16))) unsigned char lds[];
    LAS unsigned char* L = (LAS unsigned char*)lds;
    {   const int tid0 = threadIdx.x;
        for (int u = tid0; u < (LDS_BYTES - LDSCTL_OFF) / 4; u += NWAVES * 64) ((LAS unsigned*)(L + LDSCTL_OFF))[u] = 0u;
        __syncthreads();
        if ((tid0 & 63) == 0) ((LAS int*)(L + WAVETAB_OFF))[hw_slot()] = tid0 >> 6;
        if (tid0 == 0) {
            LAS unsigned long long* pt = (LAS unsigned long long*)(L + PTRS_OFF);
#pragma unroll
            for (int i = 0; i < 21; ++i) pt[i] = (unsigned long long)args.in[i];
            pt[I_OUT] = (unsigned long long)args.out;
            LAS int* st = (LAS int*)(L + ST_OFF);
            const int G = gridDim.x, bx = blockIdx.x;
            unsigned* barw = (unsigned*)(args.ws + WS_CTL) + CW_BAR + args.region * XCD_BAR_WORDS;
            st[ST_PH] = 0; st[ST_L] = 0; st[ST_LO] = args.ph_lo; st[ST_HI] = args.ph_hi; st[ST_VCU] = (G % 8 == 0) ? (bx % 8) * (G / 8) + bx / 8 : bx; st[ST_G] = G; st[ST_BX] = bx;
            st[ST_WS_LO] = (int)(unsigned)(unsigned long long)args.ws; st[ST_WS_HI] = (int)(unsigned)((unsigned long long)args.ws >> 32);
            st[ST_BAR_LO] = (int)(unsigned)(unsigned long long)barw; st[ST_BAR_HI] = (int)(unsigned)((unsigned long long)barw >> 32);
            (void)xb_add(&barw[XB_XCNT(xb_xcc_id())], 1u);
#if defined(YK_PROF)
            ((volatile LAS unsigned long long*)(L + ST_OFF + 128))[0] = __builtin_amdgcn_s_memrealtime();
#endif
        }
        __syncthreads();
    }
#ifndef YK_ONLY
#define YK_ONLY -1
#endif
#define EN(k) (YK_ONLY < 0 || YK_ONLY == (k))
#ifndef YK_DUP
#define YK_DUP -1
#endif
#ifndef YK_VAR
#define YK_VAR 0
#endif
#define DUP(k) for (int rep_ = (YK_DUP == (k)) ? 1 : 0; rep_ >= 0; --rep_)
#define PH_ON(k) (EN(k) && ph_on(L))
#define PH_END ph_end(L)
#define HB wsp<bf16>(P, WS_HB)
#define SUBB wsp<bf16>(P, WS_SUB)
#define X wsp<bf16>(P, WS_X)
    if (PH_ON(0)) DUP(0) { Frame P = fresh(L); P.dup = rep_; ph_prologue(P); }
    PH_END;
    if (PH_ON(1)) DUP(1) { Frame P = fresh(L); P.dup = rep_; ph_mod0(P); }
    PH_END;
    for (;;) {
        const int l = st_get(L, ST_L);
        if (l >= DEPTH) break;
        if (l < 2) {
            if (PH_ON(2)) DUP(2) { Frame P = fresh(L); P.dup = rep_; const int bx = st_get(L, ST_BX);
                constexpr int ES = CONV_FP8 ? 1 : 2;
                pg8::Gemm g{CONV_FP8 ? wsp<bf16>(P, WS_HB8) : HB, (const bf16*)(P.ws + WS_WCI + (size_t)l * 3072 * D * ES), T, 3072, D, 0, CONV_FP8 ? wsp<int>(P, WS_IDENT) : nullptr, 0, 127, 127 - (CONV_FP8 ? WSH_QKV : 0)}; pg8::StaticOrder S; S.init(T, 3072, P.G, bx);
                pg8::EpiConvIn E{wsp<bf16>(P, WS_ZB), wsp<bf16>(P, WS_GB)};
                pg8::gemm_phase<pg8::EpiConvIn, pg8::StaticOrder, true, CONV_FP8, CONV_FP8>(P.lds + RING_OFF, g, S, E, P.wave, P.lds + ETAB_OFF);
            }
            PH_END;
            if (PH_ON(3)) DUP(3) { Frame P = fresh(L); P.dup = rep_; ph_conv(P, l); }
            PH_END;
            if (PH_ON(4)) DUP(4) { Frame P = fresh(L); P.dup = rep_; const int bx = st_get(L, ST_BX);
                constexpr int ES = CONV2_FP8 ? 1 : 2;
                pg8::Gemm g{wsp<bf16>(P, WS_YB), (const bf16*)(P.ws + WS_WCO + (size_t)l * D * D * ES), T, D, D, 0, CONV2_FP8 ? wsp<int>(P, WS_IDENT) : nullptr, 0, 127, 127 - (CONV2_FP8 ? WSH_O : 0)}; pg8::StaticOrder S; S.init(T, D, P.G, bx);
                pg8::EpiBf16 E{SUBB, D, nullptr, 0, 0, 0, 1.f, 0};
                pg8::gemm_phase<pg8::EpiBf16, pg8::StaticOrder, true, CONV2_FP8, CONV2_FP8>(P.lds + RING_OFF, g, S, E, P.wave, P.lds + ETAB_OFF);
            }
            PH_END;
        } else {
            if (PH_ON(5)) DUP(5) { Frame P = fresh(L); P.dup = rep_; const int bx = st_get(L, ST_BX);
                if (l == 2) ph_knorm(P);
                constexpr int ES = QKV_FP8 ? 1 : 2;
                pg8::Gemm g{QKV_FP8 ? wsp<bf16>(P, WS_HB8) : HB, (const bf16*)(P.ws + WS_WQ + (size_t)(l - 2) * D * D * ES), T, D, D, 0, wsp<int>(P, WS_IDENT), 0, 127, 127 - (QKV_FP8 ? WSH_QKV : 0)}; pg8::StaticOrder S; S.init(T, D, P.G, bx);
                pg8::EpiBf16 E{wsp<bf16>(P, WS_Q), D, nullptr, 0, D, 0, attn_body::C2, 0};
                pg8::gemm_phase<pg8::EpiBf16, pg8::StaticOrder, true, QKV_FP8, QKV_FP8>(P.lds + RING_OFF, g, S, E, P.wave, P.lds + ETAB_OFF);
            }
            PH_END;
            if (PH_ON(6)) DUP(6) { Frame P = fresh(L); P.dup = rep_; const int bx = st_get(L, ST_BX);
                static_assert(attn_body::ATTN_LDS_BYTES <= RING_BYTES && attn_body::ATTN_PITCH == D, "attention body geometry vs frame");
                const attn_body::AttnTensors AT{(const attn_body::bf16*)wsp<bf16>(P, WS_Q), (const attn_body::bf16*)wsp<bf16>(P, WS_K), (const attn_body::bf16*)wsp<bf16>(P, WS_V), (attn_body::bf16*)wspo<bf16>(P, WS_Q), wsp<float>(P, WS_CS), wsp<float>(P, WS_KMAX), QKV_FP8 ? (P.dup ? wsp<unsigned char>(P, WS_A1 + WS_END) : wsp<unsigned char>(P, WS_O8)) : nullptr};
                const attn_body::StaticOrder S(P.G, bx);
                attn_body::attn_phase<attn_body::StaticOrder>((char*)lds + RING_OFF, AT, S, P.wave);
            }
            PH_END;
            if (PH_ON(7)) DUP(7) { Frame P = fresh(L); P.dup = rep_; const int bx = st_get(L, ST_BX);
                constexpr int ES = QKV_FP8 ? 1 : 2;
                pg8::Gemm g{QKV_FP8 ? wsp<bf16>(P, WS_O8) : wsp<bf16>(P, WS_Q), (const bf16*)(P.ws + WS_WO + (size_t)(l - 2) * D * D * ES), T, D, D, 0, wsp<int>(P, WS_IDENT), 0, 127, 127 - (QKV_FP8 ? WSH_O : 0)}; pg8::StaticOrder S; S.init(T, D, P.G, bx);
                pg8::EpiBf16 E{SUBB, D, nullptr, 0, 0, 0, 1.f, 0};
                pg8::gemm_phase<pg8::EpiBf16, pg8::StaticOrder, true, QKV_FP8, QKV_FP8>(P.lds + RING_OFF, g, S, E, P.wave, P.lds + ETAB_OFF);
            }
            PH_END;
        }
        if (PH_ON(8)) DUP(8) { Frame P = fresh(L); P.dup = rep_; ph_ln0(P, l, l == 0 ? (const void*)inp(P, I_X) : (const void*)X, wspo<bf16>(P, WS_X)); }
        PH_END;
        if (PH_ON(9)) DUP(9) { Frame P = fresh(L); P.dup = rep_; ph_slot(P); }
        PH_END;
        if (PH_ON(10)) DUP(10) { Frame P = fresh(L); P.dup = rep_;
            const pg8::MoeOrder S = moe_order(P, 3);
            constexpr int ES = MOE_FP8 ? 1 : 2;
            pg8::Gemm g{MOE_FP8 ? wsp<bf16>(P, WS_HB8) : HB, (const bf16*)(P.ws + WS_WGU + (size_t)l * NE * 2048 * D * ES), NSLOT_MAX, 2048, D, (size_t)2048 * D * ES, wsp<int>(P, WS_SLOTTOK), P.dup ? YK_VAR : 0, 127, 127 - WSH_GU};
            pg8::EpiSwiGLU<MOE_FP8> E{wspo<bf16>(P, WS_A1), inp(P, I_EXP_B_GU) + (size_t)l * NE * 2048};
            pg8::gemm_phase<pg8::EpiSwiGLU<MOE_FP8>, pg8::MoeOrder, YK_ALIGN1, true, MOE_FP8>(P.lds + RING_OFF, g, S, E, P.wave, P.lds + ETAB_OFF);
        }
        PH_END;
        if (PH_ON(11)) DUP(11) { Frame P = fresh(L); P.dup = rep_;
            const pg8::MoeOrder S = moe_order(P, 2);
            constexpr int ES = MOE_FP8 ? 1 : 2;
            pg8::Gemm g{wsp<bf16>(P, WS_A1), (const bf16*)(P.ws + WS_WD + (size_t)l * NE * D * FF * ES), NSLOT_MAX, D, FF, (size_t)D * FF * ES, wsp<int>(P, WS_IDENT), P.dup ? YK_VAR : 0, 127, 127 - WSH_DN};
            pg8::EpiBias8<Y2_FP8> E{P.dup ? wsp<bf16>(P, WS_A1 + WS_END) : wsp<bf16>(P, WS_Y2), inp(P, I_EXP_B_DOWN) + (size_t)l * NE * D, D};
            pg8::gemm_phase<pg8::EpiBias8<Y2_FP8>, pg8::MoeOrder, true, true, MOE_FP8>(P.lds + RING_OFF, g, S, E, P.wave, P.lds + ETAB_OFF);
        }
        PH_END;
        if (PH_ON(12)) DUP(12) { Frame P = fresh(L); P.dup = rep_; unsigned poison = 0u;
            if (l == DEPTH - 1) { const unsigned* barw = (const unsigned*)(((unsigned long long)(unsigned)st_get(L, ST_BAR_HI) << 32) | (unsigned)st_get(L, ST_BAR_LO)); poison = (__hip_atomic_load((gu32*)(barw + XB_TMO), RLX_AGENT) != 0u) ? 1u : 0u; }
            ph_ln1(P, l, X, (l == DEPTH - 1) ? (P.dup ? (void*)wsp<float>(P, WS_Q + WS_END) : (void*)inp(P, I_OUT)) : (void*)wspo<bf16>(P, WS_X), poison); }
        PH_END;
        if (l == 1) {
            if (PH_ON(13)) DUP(13) { { Frame Pc = fresh(L); Pc.dup = rep_; ph_cumsum(Pc); }
                Frame P = fresh(L); P.dup = rep_; const int bx = st_get(L, ST_BX);
                pg8::Gemm g{wsp<bf16>(P, WS_HKV), wsp<bf16>(P, WS_WKV), T, 2048, D, 0, wsp<int>(P, WS_IDENT), 0, 127, 127 - (QKV_FP8 ? WSH_QKV : 0)}; pg8::StaticOrder S; S.init(T, 2048, P.G, bx);
                pg8::EpiBf16 E{wsp<bf16>(P, WS_K), D, nullptr, 0, D, (size_t)(WS_V - WS_K) / 2, 1.f, 0};
                pg8::gemm_phase<pg8::EpiBf16, pg8::StaticOrder, true, QKV_FP8, QKV_FP8>(P.lds + RING_OFF, g, S, E, P.wave, P.lds + ETAB_OFF);
            }
            PH_END;
        }
        { Frame P = fresh(L); __syncthreads(); if (P.tid == 0) ((volatile LAS int*)(L + ST_OFF))[ST_L] = l + 1; __syncthreads(); }
    }
#undef PH_ON
#undef PH_END
#undef HB
#undef SUBB
#undef X
}
constexpr int N_PHASES = 2 + 2 * 8 + 1 + 2 * 8;

#if defined(YK_CHECK)
__global__ void chk_moe(const float* w_gu, const float* b_gu, const float* w_dn, const float* b_dn, const float* w_r, const float* b_r, unsigned char* ws, float* res) {
    __shared__ float h[1024], gu[2048], a[1024], ys[1024], red[512 * 3];
    const int tid = threadIdx.x; const int t = (blockIdx.x * 509 + 7) % T; const int l = 3;
    const bf16* HB = (const bf16*)(ws + WS_HB); const int* tki = (const int*)(ws + WS_TKI); const float* tkw = (const float*)(ws + WS_TKW); const int* slot_of = (const int*)(ws + WS_SLOTOF); const bf16* Y2 = (const bf16*)(ws + WS_Y2);
    for (int i = tid; i < 1024; i += 512) { h[i] = __builtin_bit_cast(float, (unsigned)HB[(size_t)t * D + i] << 16); ys[i] = 0.f; }
    __syncthreads();
    for (int k = 0; k < 4; ++k) {
        const int e = tki[t * 4 + k]; const float w = tkw[t * 4 + k];
        const float* wg = w_gu + ((size_t)l * NE + e) * D * 2048; const float* bg = b_gu + ((size_t)l * NE + e) * 2048;
        for (int c = tid; c < 2048; c += 512) { float acc = bg[c]; for (int kk = 0; kk < 1024; ++kk) acc += h[kk] * wg[(size_t)kk * 2048 + c]; gu[c] = acc; }
        __syncthreads();
        for (int n = tid; n < 1024; n += 512) { const float g = fminf(gu[n], 7.f), u = fminf(fmaxf(gu[1024 + n], -7.f), 7.f); a[n] = g / (1.f + expf(-1.702f * g)) * (u + 1.f); }
        __syncthreads();
        const float* wd = w_dn + ((size_t)l * NE + e) * FF * D; const float* bd = b_dn + ((size_t)l * NE + e) * D;
        for (int c = tid; c < 1024; c += 512) { float acc = bd[c]; for (int f = 0; f < 1024; ++f) acc += a[f] * wd[(size_t)f * D + c]; ys[c] += w * acc; }
        __syncthreads();
    }
    float dot = 0.f, nm = 0.f, nn = 0.f;
    for (int c = tid; c < 1024; c += 512) { float m = 0.f; for (int k = 0; k < 4; ++k) m += tkw[t * 4 + k] * __builtin_bit_cast(float, (unsigned)Y2[(size_t)slot_of[t * 4 + k] * D + c] << 16);
        dot += m * ys[c]; nm += m * m; nn += ys[c] * ys[c]; }
    red[tid] = dot; red[512 + tid] = nm; red[1024 + tid] = nn; __syncthreads();
    if (tid == 0) { float s0 = 0, s1 = 0, s2 = 0; for (int i = 0; i < 512; ++i) { s0 += red[i]; s1 += red[512 + i]; s2 += red[1024 + i]; } atomicAdd(res + 0, s0); atomicAdd(res + 1, s1); atomicAdd(res + 2, s2); }
    __syncthreads();
    if (tid < 32) { float acc = b_r[l * NE + tid]; for (int kk = 0; kk < 1024; ++kk) acc += h[kk] * w_r[((size_t)l * D + kk) * NE + tid]; gu[tid] = acc; }
    __syncthreads();
    if (tid == 0) { int match = 0; float tmp[32]; for (int i = 0; i < 32; ++i) tmp[i] = gu[i];
        for (int k = 0; k < 4; ++k) { int bi = 0; for (int i = 1; i < 32; ++i) if (tmp[i] > tmp[bi]) bi = i; tmp[bi] = -1e30f; for (int q = 0; q < 4; ++q) if (tki[t * 4 + q] == bi) ++match; }
        atomicAdd(res + 3, (float)match); atomicAdd(res + 4, 4.0f); }
}
__global__ void chk_ln1(const float* ln_g, const float* ln_b, unsigned char* ws, const float* out, float* res) {
    __shared__ float v[1024], red[512 * 3];
    const int tid = threadIdx.x; const int t = (blockIdx.x * 509 + 7) % T; const int l = 3, b = t >> 13;
    const float* Xb = (const float*)(ws + WS_X); const float* MOD = (const float*)(ws + WS_MOD); const float* tkw = (const float*)(ws + WS_TKW); const int* slot_of = (const int*)(ws + WS_SLOTOF); const bf16* Y2 = (const bf16*)(ws + WS_Y2);
    for (int c = tid; c < 1024; c += 512) { float m = 0.f; for (int k = 0; k < 4; ++k) m += tkw[t * 4 + k] * __builtin_bit_cast(float, (unsigned)Y2[(size_t)slot_of[t * 4 + k] * D + c] << 16);
        const float gate = MOD[((size_t)(l * 2 + 1) * 4 + b) * 3072 + 2048 + c]; v[c] = DN_ALPHA * Xb[(size_t)t * D + c] + (1.f + gate) * m; }
    __syncthreads();
    float s = 0.f; for (int c = 0; c < 1024; ++c) s += v[c]; const float mean = s / 1024.f; float q = 0.f; for (int c = 0; c < 1024; ++c) q += (v[c] - mean) * (v[c] - mean); const float rstd = 1.f / sqrtf(q / 1024.f + LN_EPS);
    float dot = 0.f, nm = 0.f, nn = 0.f;
    for (int c = tid; c < 1024; c += 512) { const float y = (v[c] - mean) * rstd * ln_g[(l * 2 + 1) * D + c] + ln_b[(l * 2 + 1) * D + c]; const float m = out[(size_t)t * D + c]; dot += m * y; nm += m * m; nn += y * y; }
    red[tid] = dot; red[512 + tid] = nm; red[1024 + tid] = nn; __syncthreads();
    if (tid == 0) { float s0 = 0, s1 = 0, s2 = 0; for (int i = 0; i < 512; ++i) { s0 += red[i]; s1 += red[512 + i]; s2 += red[1024 + i]; } atomicAdd(res + 8, s0); atomicAdd(res + 9, s1); atomicAdd(res + 10, s2); }
}
__global__ void chk_scale(float* out, const float* res, int n) {
    const float dot = res[0], nm = res[1], nn = res[2];
    float f = 1.f;
    if (YK_CHECK == 1) f = 1.f + dot / nn;
    if (YK_CHECK == 2) f = 1.f + sqrtf(fmaxf(nm - dot * dot / nn, 0.f) / nn);
    if (YK_CHECK == 3) f = 1.f + res[3] / res[4];
    if (YK_CHECK == 4) f = 1.f + sqrtf(fmaxf(res[9] + res[10] - 2.f * res[8], 0.f) / res[10]);
    for (int i = blockIdx.x * blockDim.x + threadIdx.x; i < n; i += gridDim.x * blockDim.x) out[i] *= f;
}
#endif

#if defined(YK_PROF_ENCODE)
__device__ __forceinline__ int ph_type(int ph) {
    if (ph < 2) return ph;
    if (ph < 18) { const int q = (ph - 2) & 7; const int tl[8] = {2, 3, 4, 8, 9, 10, 11, 12}; return tl[q]; }
    if (ph == 18) return 14; if (ph == 19) return 13;
    const int q = (ph - 20) & 7; const int tl[8] = {5, 6, 7, 8, 9, 10, 11, 12}; return tl[q];
}
__global__ void prof_encode(float* out, const unsigned long long* stamps) {
    const double tot = (double)(stamps[N_PHASES] - stamps[0]);
    double sa = 0.0, sb = 0.0;
    for (int p = 0; p < N_PHASES; ++p) { const double d = (double)(stamps[p + 1] - stamps[p]); const int ty = ph_type(p);
#if defined(YK_PROF_LAYER)
        const int ly = p < 2 ? -1 : p < 10 ? 0 : p < 20 ? 1 : p < 28 ? 2 : 3; if (ly != YK_PROF_LAYER) continue;
#endif
        if (ty == YK_PROF_A) sa += d; if (ty == YK_PROF_B) sb += d; }
    float fa = (float)(sa / tot), fb = (float)(sb / tot);
    fa = floorf(fa * 100.f + 0.5f) * 0.01f; fb = floorf(fb * 100.f + 0.5f) * 0.01f;
    const size_t nzero = (size_t)((double)fa * (double)T) * D;
    for (size_t i = (size_t)blockIdx.x * blockDim.x + threadIdx.x; i < nzero; i += (size_t)gridDim.x * blockDim.x) out[i] = 0.f;
    if (blockIdx.x == 0 && threadIdx.x == 0) out[(size_t)T * D - 1] = 10000.f * fb;
}
#endif
#ifndef YK_N_LAUNCHES
#define YK_N_LAUNCHES 1
#endif
extern "C" void kernel_launch(void* const* d_in, const int* in_sizes, int n_in, void* d_out, int out_size, void* d_ws, size_t ws_size, hipStream_t stream) {
    static int grid = 0;
    if (grid == 0) {
        if (n_in != 21 || in_sizes[0] != T * D || out_size != T * D || ws_size < WS_END + (YK_DUP >= 0 ? WS_Y2 : 0)) { fprintf(stderr, "kernel_launch: unexpected problem: n_in %d in0 %d out %d ws %zu (need %zu)\n", n_in, n_in > 0 ? in_sizes[0] : -1, out_size, ws_size, (size_t)WS_END); grid = -1; return; }
        int dev = 0, cus = 0, per_cu = 0;
        if (hipGetDevice(&dev) != hipSuccess || hipDeviceGetAttribute(&cus, hipDeviceAttributeMultiprocessorCount, dev) != hipSuccess) { grid = -1; return; }
        if (hipFuncSetAttribute((const void*)yoco_fwd, hipFuncAttributeMaxDynamicSharedMemorySize, LDS_BYTES) != hipSuccess) { fprintf(stderr, "kernel_launch: hipFuncSetAttribute failed\n"); grid = -1; return; }
        if (hipOccupancyMaxActiveBlocksPerMultiprocessor(&per_cu, (const void*)yoco_fwd, NWAVES * 64, LDS_BYTES) != hipSuccess || per_cu < 1) { fprintf(stderr, "kernel_launch: occupancy query says %d\n", per_cu); }
        (void)hipGetLastError();
        grid = cus;
    }
    if (grid < 0) return;
    (void)hipMemsetAsync((char*)d_ws + WS_CTL, 0, CTL_ZERO_BYTES, stream);
    Args a{};
    for (int i = 0; i < 21; ++i) a.in[i] = d_in[i];
    a.out = (float*)d_out; a.ws = (unsigned char*)d_ws;
#if YK_N_LAUNCHES == 1
    a.ph_lo = 0; a.ph_hi = N_PHASES; a.region = 0; a.pad = 0;
    hipLaunchKernelGGL(yoco_fwd, dim3(grid), dim3(NWAVES * 64), LDS_BYTES, stream, a);
#else
    for (int p = 0; p < N_PHASES; ++p) { a.ph_lo = p; a.ph_hi = p + 1; a.region = p; a.pad = 0;
        hipLaunchKernelGGL(yoco_fwd, dim3(grid), dim3(NWAVES * 64), LDS_BYTES, stream, a); }
#endif
#if defined(YK_CHECK)
    {   float* res = (float*)((char*)d_ws + WS_CTL + 512 * 1024);
        hipLaunchKernelGGL(chk_moe, dim3(64), dim3(512), 0, stream, (const float*)d_in[17], (const float*)d_in[18], (const float*)d_in[19], (const float*)d_in[20], (const float*)d_in[15], (const float*)d_in[16], (unsigned char*)d_ws, res);
        hipLaunchKernelGGL(chk_ln1, dim3(64), dim3(512), 0, stream, (const float*)d_in[13], (const float*)d_in[14], (unsigned char*)d_ws, (const float*)d_out, res);
        hipLaunchKernelGGL(chk_scale, dim3(1024), dim3(256), 0, stream, (float*)d_out, (const float*)res, T * D); }
#endif
#if defined(YK_PROF)
    hipLaunchKernelGGL(prof_encode, dim3(1024), dim3(256), 0, stream, (float*)d_out, (const unsigned long long*)((char*)d_ws + WS_CTL + 768 * 1024));
#endif
    const hipError_t le = hipPeekAtLastError();
    if (le != hipSuccess) fprintf(stderr, "kernel_launch: launch failed: %s\n", hipGetErrorName(le));
}
```
